# Optimizing an MI355X kernel written in HIP

```python
import jax, jax.numpy as jnp
from jax import lax
import numpy as np

D_MODEL = 4096
BATCH = 4
SEQ = 2048
DEPTH = 1

D_MIX = D_MODEL
GLA_HEADS = 8
GLA_DK = D_MODEL // 32
GLA_DV = D_MODEL // 16
GLA_GATE_RANK = 16
GLA_GATE_NORMALIZER = 16.0
GLA_CHUNK = 64
MOBA_HEADS = 16
MOBA_HD = D_MODEL // 32
MOBA_BLOCK = 256
MOBA_TOPK = 3
MOBA_QCHUNK = 16
ROPE_THETA = 500000.0
ROPE_DIMS = MOBA_HD // 4
PEER_HEADS = 8
PEER_NKEYS = 128
PEER_EXPERTS = PEER_NKEYS * PEER_NKEYS
PEER_DQ = 256
PEER_TOPK = 16
PEER_TCHUNK = 128
EPS = 1e-6

GLA_QK_W = GLA_HEADS * GLA_DK
GLA_V_W = GLA_HEADS * GLA_DV
MOBA_W = MOBA_HEADS * MOBA_HD
IN_COLS = 2 * GLA_QK_W + 2 * GLA_V_W + GLA_GATE_RANK + 3 * MOBA_W
SPLIT_POINTS = (GLA_QK_W, 2 * GLA_QK_W, 2 * GLA_QK_W + GLA_V_W, 2 * GLA_QK_W + 2 * GLA_V_W,
                2 * GLA_QK_W + 2 * GLA_V_W + GLA_GATE_RANK,
                2 * GLA_QK_W + 2 * GLA_V_W + GLA_GATE_RANK + MOBA_W,
                2 * GLA_QK_W + 2 * GLA_V_W + GLA_GATE_RANK + 2 * MOBA_W)

kernel_name = "hymba_gla_moba_peer_layer"


def rmsnorm(x, g):
    xf = x.astype(jnp.float32)
    r = lax.rsqrt(jnp.mean(xf * xf, axis=-1, keepdims=True) + EPS)
    return (xf * r).astype(x.dtype) * g


def partial_rope(x, pos):
    half = ROPE_DIMS // 2
    inv = ROPE_THETA ** (-jnp.arange(half, dtype=jnp.float32) / half)
    ang = pos.astype(jnp.float32)[:, None] * inv[None, :]
    cos = jnp.cos(ang).astype(x.dtype)
    sin = jnp.sin(ang).astype(x.dtype)
    x1, x2, xp = x[..., :half], x[..., half:ROPE_DIMS], x[..., ROPE_DIMS:]
    return jnp.concatenate([x1 * cos - x2 * sin, x2 * cos + x1 * sin, xp], axis=-1)


def gla_mixer(q, k, v, g_out, gate_lr, w_gate_up, b_gate, gla_norm_g):
    B, T, _ = q.shape
    H, dk, dv, C = GLA_HEADS, GLA_DK, GLA_DV, GLA_CHUNK
    N = T // C
    f32 = jnp.float32
    log_a = jax.nn.log_sigmoid((gate_lr @ w_gate_up + b_gate).astype(f32)) / GLA_GATE_NORMALIZER

    def chunked(t, d):
        return t.reshape(B, N, C, H, d).transpose(0, 3, 1, 2, 4)

    qc = chunked(q, dk).astype(f32) * (dk ** -0.5)
    kc = chunked(k, dk).astype(f32)
    vc = chunked(v, dv).astype(f32)
    bc = jnp.cumsum(chunked(log_a, dk), axis=3)
    b_last = bc[..., -1:, :]
    q_dec = qc * jnp.exp(bc)
    k_intra = kc * jnp.exp(-bc)
    k_state = kc * jnp.exp(b_last - bc)
    causal = jnp.tril(jnp.ones((C, C), dtype=bool))
    att = jnp.where(causal, jnp.einsum('bhncd,bhnsd->bhncs', q_dec, k_intra), 0.0)
    o_intra = jnp.einsum('bhncs,bhnse->bhnce', att, vc)
    chunk_update = jnp.einsum('bhnsd,bhnse->nbhde', k_state, vc)
    chunk_decay = jnp.exp(b_last[..., 0, :]).transpose(2, 0, 1, 3)

    def step(S, inp):
        dec, upd = inp
        return dec[..., None] * S + upd, S

    S0 = jnp.zeros((B, H, dk, dv), f32)
    _, S_prev = lax.scan(step, S0, (chunk_decay, chunk_update))
    o_inter = jnp.einsum('bhncd,nbhde->bhnce', q_dec, S_prev)
    o = (o_intra + o_inter).transpose(0, 2, 3, 1, 4).reshape(B, T, H, dv)
    o = rmsnorm(o, gla_norm_g) * jax.nn.silu(g_out.reshape(B, T, H, dv).astype(f32))
    return o.reshape(B, T, H * dv).astype(v.dtype)


def moba_mixer(q, k, v, q_norm_g, k_norm_g):
    B, T, _ = q.shape
    H, hd, L, QC = MOBA_HEADS, MOBA_HD, MOBA_BLOCK, MOBA_QCHUNK
    Tp = -(-T // L) * L
    nb = Tp // L
    n_sel = min(MOBA_TOPK, nb)
    f32 = jnp.float32

    def heads(t):
        t = t.reshape(B, T, H, hd)
        t = jnp.pad(t, ((0, 0), (0, Tp - T), (0, 0), (0, 0)))
        return t.transpose(0, 2, 1, 3)

    pos = jnp.arange(Tp)
    qh = partial_rope(rmsnorm(heads(q), q_norm_g), pos) * (hd ** -0.5)
    kh = partial_rope(rmsnorm(heads(k), k_norm_g), pos)
    vh = heads(v)
    kb = kh.reshape(B, H, nb, L, hd)
    vb = vh.reshape(B, H, nb, L, hd)
    k_mean = jnp.mean(kb.astype(f32), axis=3)
    bi = jnp.arange(B)[:, None, None, None]
    hi = jnp.arange(H)[None, :, None, None]
    slot = jnp.arange(n_sel)

    def chunk_fn(c):
        start = c * QC
        blk = start // L
        qc = lax.dynamic_slice_in_dim(qh, start, QC, axis=2)
        gate = jnp.einsum('bhqd,bhnd->bhqn', qc.astype(f32), k_mean)
        gate = jnp.where(jnp.arange(nb) < blk, gate, -jnp.inf)
        _, sel = lax.top_k(gate, n_sel)
        slot_ok = slot < blk
        k_sel = kb[bi, hi, sel]
        v_sel = vb[bi, hi, sel]
        s_sel = jnp.einsum('bhqd,bhqskd->bhqsk', qc, k_sel, preferred_element_type=f32)
        s_sel = jnp.where(slot_ok[:, None], s_sel, -jnp.inf).reshape(B, H, QC, n_sel * L)
        k_own = lax.dynamic_index_in_dim(kb, blk, axis=2, keepdims=False)
        v_own = lax.dynamic_index_in_dim(vb, blk, axis=2, keepdims=False)
        qpos = start + jnp.arange(QC)
        kpos = blk * L + jnp.arange(L)
        s_own = jnp.einsum('bhqd,bhkd->bhqk', qc, k_own, preferred_element_type=f32)
        s_own = jnp.where(kpos[None, :] <= qpos[:, None], s_own, -jnp.inf)
        p = jax.nn.softmax(jnp.concatenate([s_own, s_sel], axis=-1), axis=-1).astype(v.dtype)
        p_own = p[..., :L]
        p_sel = p[..., L:].reshape(B, H, QC, n_sel, L)
        return (jnp.einsum('bhqk,bhkd->bhqd', p_own, v_own)
                + jnp.einsum('bhqsk,bhqskd->bhqd', p_sel, v_sel))

    out = lax.map(chunk_fn, jnp.arange(Tp // QC))
    out = out.transpose(1, 2, 0, 3, 4).reshape(B, H, Tp, hd)[:, :, :T]
    return out.transpose(0, 2, 1, 3).reshape(B, T, H * hd)


def peer_ffn(x, w_pq, peer_keys, peer_u, peer_v):
    B, T, D = x.shape
    H, K, NK, TC = PEER_HEADS, PEER_TOPK, PEER_NKEYS, PEER_TCHUNK
    N = B * T
    f32 = jnp.float32
    xt = x.reshape(N, D)
    q = (xt @ w_pq).reshape(N, H, 2, PEER_DQ // 2)
    s = jnp.einsum('thpd,hpkd->thpk', q.astype(f32), peer_keys.astype(f32))
    s1, i1 = lax.top_k(s[:, :, 0], K)
    s2, i2 = lax.top_k(s[:, :, 1], K)
    cand = (s1[..., :, None] + s2[..., None, :]).reshape(N, H, K * K)
    top_s, top_c = lax.top_k(cand, K)
    expert = (jnp.take_along_axis(i1, top_c // K, axis=-1) * NK
              + jnp.take_along_axis(i2, top_c % K, axis=-1))
    g = jax.nn.softmax(top_s, axis=-1)
    nc = N // TC

    def chunk_fn(inp):
        xc, ec, gc = inp
        ef = ec.reshape(TC, H * K)
        u = peer_u[ef]
        h = jax.nn.gelu(jnp.einsum('td,ted->te', xc, u), approximate=False)
        w = gc.reshape(TC, H * K).astype(xc.dtype) * h
        return jnp.einsum('te,ted->td', w, peer_v[ef])

    out = lax.map(chunk_fn, (xt.reshape(nc, TC, D), expert.reshape(nc, TC, H, K),
                             g.reshape(nc, TC, H, K)))
    return out.reshape(B, T, D)


def setup_inputs(seed: int = 0) -> dict:
    key = jax.random.key(seed)
    ks = jax.random.split(key, 16)
    f32 = jnp.float32

    def w(k, shape, fan_in):
        return jax.random.normal(k, shape, f32) * (fan_in ** -0.5)

    def gain(k, shape):
        return 1.0 + 0.02 * jax.random.normal(k, shape, f32)

    return {
        "x": jax.random.normal(ks[0], (BATCH, SEQ, D_MODEL), f32),
        "norm_mix_g": gain(ks[1], (DEPTH, D_MODEL)),
        "w_in": w(ks[2], (DEPTH, D_MODEL, IN_COLS), D_MODEL),
        "w_gate_up": w(ks[3], (DEPTH, GLA_GATE_RANK, GLA_QK_W), GLA_GATE_RANK),
        "b_gate": 0.1 * jax.random.normal(ks[4], (DEPTH, GLA_QK_W), f32),
        "gla_norm_g": gain(ks[5], (DEPTH, GLA_DV)),
        "q_norm_g": gain(ks[6], (DEPTH, MOBA_HD)),
        "k_norm_g": gain(ks[7], (DEPTH, MOBA_HD)),
        "w_out": w(ks[8], (DEPTH, D_MIX, D_MODEL), D_MIX),
        "norm_ffn_g": gain(ks[9], (DEPTH, D_MODEL)),
        "peer_wq": w(ks[10], (DEPTH, D_MODEL, PEER_HEADS * PEER_DQ), D_MODEL),
        "peer_keys": w(ks[11], (DEPTH, PEER_HEADS, 2, PEER_NKEYS, PEER_DQ // 2), PEER_DQ // 2),
        "peer_u": w(ks[12], (DEPTH, PEER_EXPERTS, D_MODEL), D_MODEL),
        "peer_v": w(ks[13], (DEPTH, PEER_EXPERTS, D_MODEL), PEER_HEADS * PEER_TOPK),
    }


def reference(x, norm_mix_g, w_in, w_gate_up, b_gate, gla_norm_g, q_norm_g, k_norm_g,
              w_out, norm_ffn_g, peer_wq, peer_keys, peer_u, peer_v):
    for l in range(DEPTH):
        h = rmsnorm(x, norm_mix_g[l])
        proj = h @ w_in[l]
        gq, gk, gv, gg, glr, mq, mk, mv = jnp.split(proj, SPLIT_POINTS, axis=-1)
        o_gla = gla_mixer(gq, gk, gv, gg, glr, w_gate_up[l], b_gate[l], gla_norm_g[l])
        o_moba = moba_mixer(mq, mk, mv, q_norm_g[l], k_norm_g[l])
        x = x + jnp.concatenate([o_gla, o_moba], axis=-1) @ w_out[l]
        x = x + peer_ffn(rmsnorm(x, norm_ffn_g[l]), peer_wq[l], peer_keys[l], peer_u[l], peer_v[l])
    return x
```

```cpp
#include <hip/hip_runtime.h>
#include <hip/hip_cooperative_groups.h>
#include <cstdio>
#include <cstdint>
namespace cg = cooperative_groups;
namespace pg8 {
#define PG8_LAS __attribute__((address_space(3)))
typedef unsigned short bf16_t;
typedef short bf16x8 __attribute__((ext_vector_type(8)));
typedef float f32x4 __attribute__((ext_vector_type(4)));
typedef unsigned u32x4 __attribute__((ext_vector_type(4)));
constexpr int BM = 256, BK = 64, HALF = 128, HTB = HALF * BK * 2  , STAGE_BYTES = 8 * HTB, NXCD = 8, WGM = 8;

__host__ __device__ __forceinline__ int lds_byte(int r, int c) { const int st = (r >> 4) * 2 + (c >> 5), rr = r & 15, cc = c & 31, ob = rr * 64 + cc * 2; return st * 1024 + (ob ^ (((ob >> 9) & 1) << 5)); }
__host__ __device__ __forceinline__ void stage_rc(int b, int& R, int& C) { const int st = b / 1024, sb = b % 1024, swz = sb ^ (((sb >> 9) & 1) << 5); R = (st >> 1) * 16 + swz / 64; C = (st & 1) * 32 + (swz % 64) / 2; }
__host__ __device__ __forceinline__ int perm32(int rho) { const int n = rho >> 4, i = rho & 15; return 8 * (i >> 2) + 4 * n + (i & 3); }

struct Unit { int pm, pn; };
struct Gemm { const bf16_t* A; const bf16_t* Bt; int M, N, K; };

struct StaticOrder {
    int nM, nN, nwg, G, c;
    __host__ __device__ void init(int M, int N, int G_, int c_) { nM = M / BM; nN = N / BM; nwg = nM * nN; G = G_; c = c_; }
    __host__ __device__ bool next(int i, Unit& u) const {
        const long L = (long)i * G + c; if (L >= nwg) return false;
        int wgid = (int)L; { const int q = nwg / NXCD, r = nwg % NXCD, xcd = wgid % NXCD, off = wgid / NXCD; wgid = (xcd < r ? xcd * (q + 1) : r * (q + 1) + (xcd - r) * q) + off; }
        const int nig = WGM * nN, gid = wgid / nig, fm = gid * WGM, gsz = (nM - fm) < WGM ? (nM - fm) : WGM;
        u.pm = fm + ((wgid % nig) % gsz); u.pn = (wgid % nig) / gsz; return true;
    }
    __device__ __forceinline__ void a_ready(const Unit&) const {}
    __device__ __forceinline__ void done(const Unit&) const {}
};
typedef __bf16 bf16x2_t __attribute__((ext_vector_type(2)));
typedef float f32x2c_t __attribute__((ext_vector_type(2)));
__device__ __forceinline__ unsigned cvt_pk_bf16(float lo, float hi) { f32x2c_t v = {lo, hi}; bf16x2_t b = __builtin_convertvector(v, bf16x2_t); return __builtin_bit_cast(unsigned, b); }
typedef float f32x2 __attribute__((ext_vector_type(2)));
__device__ __forceinline__ f32x2 gelu_pk(f32x2 v) {
    const f32x2 av = __builtin_elementwise_abs(v), d = av * 0.2316418882f + 1.0f;
    f32x2 t; t.x = __builtin_amdgcn_rcpf(d.x); t.y = __builtin_amdgcn_rcpf(d.y);
    f32x2 q = t * 0.5307027145f + (-0.7265760135f); q = q * t + 0.7107068705f; q = q * t + (-0.142248368f); q = q * t + 0.127414796f; q = q * t;
    const f32x2 s = (v * v) * (-0.72134752044f);
    f32x2 e; e.x = __builtin_amdgcn_exp2f(s.x); e.y = __builtin_amdgcn_exp2f(s.y);
    const f32x2 m = v * (q * e), r = v - m;
    f32x2 o; o.x = v.x < 0.f ? m.x : r.x; o.y = v.y < 0.f ? m.y : r.y; return o;
}

template <class Epi, class Sched, bool STAMP = false>
__device__ __forceinline__ void gemm_phase(PG8_LAS unsigned char* lds, const Gemm g, const Sched& S, const Epi& E, unsigned long long* stamps) {
    const int tid = threadIdx.x, wid = __builtin_amdgcn_readfirstlane(tid >> 6), lane = tid & 63, wr = wid >> 2, wc = wid & 3, fr = lane & 15, fq = lane >> 4;
    const int K = g.K, nt = K / BK;
    int ts_lo = 0, ts_hi = 0, nts = 0; const unsigned long long rt_entry = STAMP ? (unsigned long long)wall_clock64() : 0ull;
#define PG8_STAMP() do { if (STAMP && wid == 0 && nts < 64) { const unsigned long long _c = (unsigned long long)clock64(); \
        ts_lo = (lane == nts) ? (int)(unsigned)_c : ts_lo; ts_hi = (lane == nts) ? (int)(unsigned)(_c >> 32) : ts_hi; ++nts; } } while (0)
    PG8_STAMP();
    unsigned voffA[2], voffB[2];
#pragma unroll
    for (int i = 0; i < 2; ++i) { int R, C; stage_rc(tid * 16 + i * 8192, R, C); const int Rb = Epi::PERM ? ((R & ~31) + perm32(R & 31)) : R;
        voffA[i] = (unsigned)(R * K + C) * 2u; voffB[i] = (unsigned)(Rb * K + C) * 2u; }
    const size_t kstep = (size_t)(BK * 2);
    const size_t hstep = (size_t)HALF * K * 2;
    const size_t tstep = 2 * hstep;
    const unsigned ldsw = (unsigned)wid * 1024u;
    const int aoff = lds_byte(wr * 64 + fr, fq * 8), boff = lds_byte(wc * 32 + fr, fq * 8);
#define PG8_SA(b, h) (((b) * 2 + (h)) * HTB)
#define PG8_SB(b, h) ((4 + (b) * 2 + (h)) * HTB)
#define PG8_STAGE(bufoff, gbase, voff) do { _Pragma("unroll") for (int _i = 0; _i < 2; ++_i) \
        __builtin_amdgcn_global_load_lds((const unsigned*)((const char*)(gbase) + (voff)[_i]), (PG8_LAS unsigned*)(lds + (bufoff) + ldsw + _i * 8192), 16, 0, 0); } while (0)
#define PG8_LDA(dst, b, h) do { _Pragma("unroll") for (int m = 0; m < 4; ++m) _Pragma("unroll") for (int k = 0; k < 2; ++k) dst[m][k] = *(const PG8_LAS bf16x8*)(lds + PG8_SA(b, h) + aoff + m * 2048 + k * 1024); } while (0)
#define PG8_LDB(dst, b, h) do { _Pragma("unroll") for (int n = 0; n < 2; ++n) _Pragma("unroll") for (int k = 0; k < 2; ++k) dst[n][k] = *(const PG8_LAS bf16x8*)(lds + PG8_SB(b, h) + boff + n * 2048 + k * 1024); } while (0)
#define PG8_MMA(ai, bj, At, Bt) do { __builtin_amdgcn_s_setprio(1); _Pragma("unroll") for (int m = 0; m < 4; ++m) _Pragma("unroll") for (int n = 0; n < 2; ++n) _Pragma("unroll") for (int k = 0; k < 2; ++k) \
        acc[ai][bj][m][n] = __builtin_amdgcn_mfma_f32_16x16x32_bf16(Bt[n][k], At[m][k], acc[ai][bj][m][n], 0, 0, 0); __builtin_amdgcn_s_setprio(0); } while (0)
#define PG8_WAIT_V(n) asm volatile("s_waitcnt vmcnt(" #n ")" ::: "memory")
#define PG8_WAIT_L(n) asm volatile("s_waitcnt lgkmcnt(" #n ")" ::: "memory")
#define PG8_BAR __builtin_amdgcn_s_barrier()
#define PG8_SCHED __builtin_amdgcn_sched_barrier(0)
    Unit cur, nxt; int ui = 0;
    if (!S.next(0, cur)) return;
    f32x4 acc[2][2][4][2];
#pragma unroll
    for (int a = 0; a < 2; ++a)
#pragma unroll
        for (int b = 0; b < 2; ++b)
#pragma unroll
            for (int m = 0; m < 4; ++m)
#pragma unroll
                for (int n = 0; n < 2; ++n) acc[a][b][m][n] = (f32x4){0.f, 0.f, 0.f, 0.f};
    bf16x8 At[4][2], B0[2][2], B1[2][2];
    const char* cA = (const char*)g.A + (size_t)cur.pm * tstep; const char* cB = (const char*)g.Bt + (size_t)cur.pn * tstep;
    S.a_ready(cur);
    PG8_STAGE(PG8_SB(0, 0), cB, voffB); PG8_STAGE(PG8_SA(0, 0), cA, voffA); PG8_STAGE(PG8_SB(0, 1), cB + hstep, voffB); PG8_STAGE(PG8_SA(0, 1), cA + hstep, voffA);
    if (wr == 1) PG8_BAR;
    PG8_WAIT_V(4); PG8_BAR;
    PG8_STAGE(PG8_SB(1, 0), cB + kstep, voffB); PG8_STAGE(PG8_SA(1, 0), cA + kstep, voffA); PG8_STAGE(PG8_SB(1, 1), cB + hstep + kstep, voffB);
    PG8_WAIT_V(6); PG8_BAR;
    PG8_STAMP();
    for (;;) {
        const bool has_next = S.next(ui + 1, nxt);
        const char* nA = has_next ? (const char*)g.A + (size_t)nxt.pm * tstep : cA; const char* nB = has_next ? (const char*)g.Bt + (size_t)nxt.pn * tstep : cB;
        for (int t = 0; t < nt; t += 2) {
            const bool last = (t == nt - 2);
            const char* a1 = cA + (size_t)(t + 1) * kstep;
            const char* a2 = last ? nA : cA + (size_t)(t + 2) * kstep; const char* b2 = last ? nB : cB + (size_t)(t + 2) * kstep;
            const char* a3 = a2 + kstep; const char* b3 = b2 + kstep;
            if (last && has_next) S.a_ready(nxt);
            PG8_LDB(B0, 0, 0); PG8_SCHED; PG8_LDA(At, 0, 0); PG8_STAGE(PG8_SA(1, 1), a1 + hstep, voffA);
            PG8_WAIT_L(8); PG8_BAR; PG8_WAIT_L(0); PG8_MMA(0, 0, At, B0); PG8_BAR; PG8_SCHED;
            PG8_LDB(B1, 0, 1); PG8_STAGE(PG8_SB(0, 0), b2, voffB);
            PG8_BAR; PG8_WAIT_L(0); PG8_MMA(0, 1, At, B1); PG8_BAR;
            PG8_LDA(At, 0, 1); PG8_STAGE(PG8_SA(0, 0), a2, voffA);
            PG8_BAR; PG8_WAIT_L(0); PG8_MMA(1, 0, At, B0); PG8_BAR; PG8_SCHED;
            PG8_STAGE(PG8_SB(0, 1), b2 + hstep, voffB);
            PG8_WAIT_V(6); PG8_BAR; PG8_MMA(1, 1, At, B1); PG8_BAR;
            PG8_LDB(B0, 1, 0); PG8_SCHED; PG8_LDA(At, 1, 0); PG8_STAGE(PG8_SA(0, 1), a2 + hstep, voffA);
            PG8_WAIT_L(8); PG8_BAR; PG8_WAIT_L(0); PG8_MMA(0, 0, At, B0); PG8_BAR; PG8_SCHED;
            PG8_LDB(B1, 1, 1); PG8_STAGE(PG8_SB(1, 0), b3, voffB);
            PG8_BAR; PG8_WAIT_L(0); PG8_MMA(0, 1, At, B1); PG8_BAR;
            PG8_LDA(At, 1, 1); PG8_STAGE(PG8_SA(1, 0), a3, voffA);
            PG8_BAR; PG8_WAIT_L(0); PG8_MMA(1, 0, At, B0); PG8_BAR; PG8_SCHED;
            PG8_STAGE(PG8_SB(1, 1), b3 + hstep, voffB);
            PG8_WAIT_V(6); PG8_BAR; PG8_MMA(1, 1, At, B1); PG8_BAR;
        }
        PG8_STAMP();
        if constexpr (!Epi::AFTER_DRAIN) { E(acc, cur, wr, wc, fr, fq); S.done(cur); }
        PG8_STAMP();
        if (!has_next) break;
#pragma unroll
        for (int a = 0; a < 2; ++a)
#pragma unroll
            for (int b = 0; b < 2; ++b)
#pragma unroll
                for (int m = 0; m < 4; ++m)
#pragma unroll
                    for (int n = 0; n < 2; ++n) acc[a][b][m][n] = (f32x4){0.f, 0.f, 0.f, 0.f};
        cur = nxt; cA = nA; cB = nB; ++ui;
    }
    PG8_WAIT_V(0);
    if (wr == 0) PG8_BAR;
    PG8_BAR;
    if constexpr (Epi::AFTER_DRAIN) { E.fused(acc, cur, wr, wc, fr, fq, lds, wid, lane); S.done(cur); }
    PG8_STAMP();
    if (STAMP && wid == 0) { stamps[lane] = lane < nts ? (((unsigned long long)(unsigned)ts_hi << 32) | (unsigned)ts_lo) : 0ull;
        if (lane == 62) stamps[62] = rt_entry; if (lane == 63) stamps[63] = (unsigned long long)wall_clock64(); }
#undef PG8_STAMP
#undef PG8_SA
#undef PG8_SB
#undef PG8_STAGE
#undef PG8_LDA
#undef PG8_LDB
#undef PG8_MMA
#undef PG8_WAIT_V
#undef PG8_WAIT_L
#undef PG8_BAR
#undef PG8_SCHED
}
}

using pg8::bf16_t; using pg8::bf16x8; using pg8::f32x4; using pg8::f32x2; using pg8::cvt_pk_bf16; using pg8::Unit;
typedef unsigned long long u64;

constexpr int NTOK = 8192, DM = 4096, SEQL = 2048;
constexpr int NIN = 12304, NINP = 12544, PROJW = 12288;
constexpr int NEXP = 16384;
constexpr size_t MiB = 1024ull * 1024ull;
constexpr size_t WS_CTRL = 0, WS_KM = 1 * MiB, WS_GLR = 2 * MiB, WS_WINT = 4 * MiB, WS_WOUTT = 102 * MiB, WS_WPQT = 134 * MiB, WS_UB = 150 * MiB, WS_VTB = 278 * MiB,
                 WS_HB = 406 * MiB, WS_MIX = 470 * MiB, WS_OG = 534 * MiB, WS_PROJ = 598 * MiB, WS_QN = 790 * MiB, WS_KN = 822 * MiB, WS_VTM = 854 * MiB, WS_END = 886 * MiB;
constexpr size_t WS_W = WS_PROJ;
constexpr size_t WS_Q = WS_OG;
constexpr int LDS_BYTES = 131072 + 16;
constexpr int NPHASE = 11;

struct Params {
    const float *x, *g1, *win, *wgu, *bg, *glang, *qng, *kng, *wout, *g2, *wpq, *pkeys, *pu, *pv;
    float* out; unsigned char* ws; int ph_lo, ph_hi;
};

__device__ __forceinline__ float bf2f(unsigned short b) { return __uint_as_float(((unsigned)b) << 16); }
__device__ __forceinline__ unsigned short f2bf(float f) { unsigned u = __float_as_uint(f); u += 0x7FFFu + ((u >> 16) & 1u); return (unsigned short)(u >> 16); }
__device__ __forceinline__ float wave_sum(float v) {
#pragma unroll
    for (int o = 1; o < 64; o <<= 1) v += __shfl_xor(v, o);
    return v;
}
#define LDS_WAIT() asm volatile("s_waitcnt lgkmcnt(0)" ::: "memory")
#define MFMA16(a, b, c) __builtin_amdgcn_mfma_f32_16x16x32_bf16((a), (b), (c), 0, 0, 0)

__device__ __forceinline__ int win_remap(int n) { return n < 6144 ? n : (n < 6160 ? 12288 + (n - 6144) : n - 16); }
__device__ __forceinline__ void transpose_item(const float* __restrict__ W, int K, int N, bf16_t* WT, float* scr, int item, int lane, bool remap) {
    const int nblk = (N + 31) >> 5, kb = item / nblk, nb = item - kb * nblk, k0 = 64 * kb, n0 = 32 * nb;
    const int nn = n0 + (lane & 31); const bool ok = nn < N;
#pragma unroll 8
    for (int i = 0; i < 32; ++i) { const int kk = 2 * i + (lane >> 5); scr[kk * 33 + (lane & 31)] = ok ? W[(size_t)(k0 + kk) * N + nn] : 0.f; }
    LDS_WAIT();
    const int c = lane & 7;
#pragma unroll
    for (int j = 0; j < 4; ++j) { const int n = (lane >> 3) + 8 * j; const int ns = n0 + n; const float* s = scr + (8 * c) * 33 + n;
        uint4 o; o.x = cvt_pk_bf16(s[0], s[33]); o.y = cvt_pk_bf16(s[66], s[99]); o.z = cvt_pk_bf16(s[132], s[165]); o.w = cvt_pk_bf16(s[198], s[231]);
        if (ns < N) { const int nd = remap ? win_remap(ns) : ns; *(uint4*)(WT + (size_t)nd * K + k0 + 8 * c) = o; } }
    LDS_WAIT();
}
__device__ __forceinline__ void rms_row(const float* __restrict__ xrow, const float* __restrict__ g, bf16_t* orow, int lane) {
    const float4* xr = (const float4*)xrow + lane; float4 v[16]; float s = 0.f;
#pragma unroll
    for (int j = 0; j < 16; ++j) { v[j] = xr[64 * j]; s += (v[j].x * v[j].x + v[j].y * v[j].y) + (v[j].z * v[j].z + v[j].w * v[j].w); }
    const float r = rsqrtf(wave_sum(s) * (1.f / DM) + 1e-6f);
    const float4* gr = (const float4*)g + lane; uint2* o8 = (uint2*)orow + lane;
#pragma unroll
    for (int j = 0; j < 16; ++j) { const float4 gg = gr[64 * j]; uint2 o; o.x = cvt_pk_bf16((v[j].x * r) * gg.x, (v[j].y * r) * gg.y); o.y = cvt_pk_bf16((v[j].z * r) * gg.z, (v[j].w * r) * gg.w); o8[64 * j] = o; }
}
__device__ __forceinline__ void phase_prep(const Params& p, unsigned char* sm) {
    const int tid = threadIdx.x, lane = tid & 63, w = tid >> 6;
    float* scr = (float*)(sm + w * 8704);
    const int gw = blockIdx.x * 8 + w, NGW = gridDim.x * 8;
    constexpr int I_WIN = 64 * 385, I_WOUT = 64 * 128, I_WPQ = 64 * 64, I_PV = 256 * 128, I_PU = NEXP, I_X = NTOK;
    constexpr int NITEMS = I_WIN + I_WOUT + I_WPQ + I_PV + I_PU + I_X;
    bf16_t* WinT = (bf16_t*)(p.ws + WS_WINT); bf16_t* WoutT = (bf16_t*)(p.ws + WS_WOUTT); bf16_t* WpqT = (bf16_t*)(p.ws + WS_WPQT);
    bf16_t* UB = (bf16_t*)(p.ws + WS_UB); bf16_t* VTB = (bf16_t*)(p.ws + WS_VTB); bf16_t* HB = (bf16_t*)(p.ws + WS_HB);
    for (int it = gw; it < NITEMS; it += NGW) {
        int r = it;
        if (r < I_X) { rms_row(p.x + (size_t)r * DM, p.g1, HB + (size_t)r * DM, lane); continue; } r -= I_X;
        if (r < I_WIN) { transpose_item(p.win, DM, NIN, WinT, scr, r, lane, true); continue; } r -= I_WIN;
        if (r < I_WOUT) { transpose_item(p.wout, DM, DM, WoutT, scr, r, lane, false); continue; } r -= I_WOUT;
        if (r < I_WPQ) { transpose_item(p.wpq, DM, 2048, WpqT, scr, r, lane, false); continue; } r -= I_WPQ;
        if (r < I_PV) { transpose_item(p.pv, NEXP, DM, VTB, scr, r, lane, false); continue; } r -= I_PV;
        { const float4* src = (const float4*)(p.pu + (size_t)r * DM) + lane; uint2* dst = (uint2*)(UB + (size_t)r * DM) + lane;
#pragma unroll 4
          for (int j = 0; j < 16; ++j) { const float4 v = src[64 * j]; uint2 o; o.x = cvt_pk_bf16(v.x, v.y); o.y = cvt_pk_bf16(v.z, v.w); dst[64 * j] = o; } }
    }
}

struct EpiProj {
    static constexpr bool PERM = true, AFTER_DRAIN = false;
    bf16_t* P; float* glr;
    __device__ __forceinline__ void operator()(const f32x4 (&acc)[2][2][4][2], const Unit& u, int wr, int wc, int fr, int fq) const {
        const int row0 = u.pm * 256 + wr * 64 + fr;
        if (u.pn < 48) {
            const int col0 = u.pn * 256 + wc * 32 + 8 * fq;
#pragma unroll
            for (int ai = 0; ai < 2; ++ai)
#pragma unroll
                for (int m = 0; m < 4; ++m) { bf16_t* rowp = P + (size_t)(row0 + ai * 128 + m * 16) * PROJW + col0;
#pragma unroll
                    for (int bj = 0; bj < 2; ++bj) { const f32x4 v0 = acc[ai][bj][m][0], v1 = acc[ai][bj][m][1];
                        uint4 o; o.x = cvt_pk_bf16(v0[0], v0[1]); o.y = cvt_pk_bf16(v0[2], v0[3]); o.z = cvt_pk_bf16(v1[0], v1[1]); o.w = cvt_pk_bf16(v1[2], v1[3]);
                        *(uint4*)(rowp + bj * 128) = o; } }
        } else if (wc == 0 && fq < 2) {
#pragma unroll
            for (int ai = 0; ai < 2; ++ai)
#pragma unroll
                for (int m = 0; m < 4; ++m) { float* rowp = glr + (size_t)(row0 + ai * 128 + m * 16) * 16 + 8 * fq;
                    *(f32x4*)(rowp) = acc[ai][0][m][0]; *(f32x4*)(rowp + 4) = acc[ai][0][m][1]; }
        }
    }
};
struct EpiRes {
    static constexpr bool PERM = false, AFTER_DRAIN = false;
    float* C; const float* R; int ldc;
    __device__ __forceinline__ void operator()(const f32x4 (&acc)[2][2][4][2], const Unit& u, int wr, int wc, int fr, int fq) const {
        const int row0 = u.pm * 256 + wr * 64 + fr, col0 = u.pn * 256 + wc * 32 + 4 * fq;
#pragma unroll
        for (int ai = 0; ai < 2; ++ai)
#pragma unroll
            for (int m = 0; m < 4; ++m) { const size_t ro = (size_t)(row0 + ai * 128 + m * 16) * ldc + col0;
#pragma unroll
                for (int bj = 0; bj < 2; ++bj)
#pragma unroll
                    for (int n = 0; n < 2; ++n) { const f32x4 r = *(const f32x4*)(R + ro + bj * 128 + n * 16); *(f32x4*)(C + ro + bj * 128 + n * 16) = r + acc[ai][bj][m][n]; } }
    }
};
struct EpiF32 {
    static constexpr bool PERM = false, AFTER_DRAIN = false;
    float* C; int ldc;
    __device__ __forceinline__ void operator()(const f32x4 (&acc)[2][2][4][2], const Unit& u, int wr, int wc, int fr, int fq) const {
        const int row0 = u.pm * 256 + wr * 64 + fr, col0 = u.pn * 256 + wc * 32 + 4 * fq;
#pragma unroll
        for (int ai = 0; ai < 2; ++ai)
#pragma unroll
            for (int m = 0; m < 4; ++m) { float* rowp = C + (size_t)(row0 + ai * 128 + m * 16) * ldc + col0;
#pragma unroll
                for (int bj = 0; bj < 2; ++bj)
#pragma unroll
                    for (int n = 0; n < 2; ++n) *(f32x4*)(rowp + bj * 128 + n * 16) = acc[ai][bj][m][n]; }
    }
};
struct EpiPeerW {
    static constexpr bool PERM = true, AFTER_DRAIN = false;
    bf16_t* W;
    __device__ __forceinline__ void operator()(const f32x4 (&acc)[2][2][4][2], const Unit& u, int wr, int wc, int fr, int fq) const {
        const int row0 = u.pm * 256 + wr * 64 + fr, col0 = u.pn * 256 + wc * 32 + 8 * fq;
#pragma unroll
        for (int ai = 0; ai < 2; ++ai)
#pragma unroll
            for (int m = 0; m < 4; ++m) { bf16_t* rowp = W + (size_t)(row0 + ai * 128 + m * 16) * NEXP + col0;
#pragma unroll
                for (int bj = 0; bj < 2; ++bj) { uint4 gv = *(const uint4*)(rowp + bj * 128);
                    if ((gv.x | gv.y | gv.z | gv.w) == 0u) continue;
                    const f32x4 v0 = acc[ai][bj][m][0], v1 = acc[ai][bj][m][1];
                    const f32x2 a = pg8::gelu_pk((f32x2){v0[0], v0[1]}), b = pg8::gelu_pk((f32x2){v0[2], v0[3]}), c = pg8::gelu_pk((f32x2){v1[0], v1[1]}), d = pg8::gelu_pk((f32x2){v1[2], v1[3]});
                    uint4 o;
                    o.x = cvt_pk_bf16(a.x * bf2f(gv.x & 0xffff), a.y * bf2f(gv.x >> 16)); o.y = cvt_pk_bf16(b.x * bf2f(gv.y & 0xffff), b.y * bf2f(gv.y >> 16));
                    o.z = cvt_pk_bf16(c.x * bf2f(gv.z & 0xffff), c.y * bf2f(gv.z >> 16)); o.w = cvt_pk_bf16(d.x * bf2f(gv.w & 0xffff), d.y * bf2f(gv.w >> 16));
                    *(uint4*)(rowp + bj * 128) = o; } }
    }
};

__device__ __forceinline__ void moba_prep_item(const Params& p, unsigned char* sm, int item) {
    const int tid = threadIdx.x, lane = tid & 63, w = tid >> 6;
    const int blk = item & 7, h = (item >> 3) & 15, b = item >> 7, bh = b * 16 + h;
    const bf16_t* proj = (const bf16_t*)(p.ws + WS_PROJ);
    bf16_t* QN = (bf16_t*)(p.ws + WS_QN); bf16_t* KN = (bf16_t*)(p.ws + WS_KN); bf16_t* VTM = (bf16_t*)(p.ws + WS_VTM); float* KM = (float*)(p.ws + WS_KM);
    bf16_t* VL = (bf16_t*)sm;
    float* KMS = (float*)(sm + 67584);
    const int d0 = 2 * lane;
    const float gq0 = p.qng[d0], gq1 = p.qng[d0 + 1], gk0 = p.kng[d0], gk1 = p.kng[d0 + 1];
    const int fi = d0 & 15;
    const float inv0 = exp2f(-(float)fi * (18.931568569324174f / 16.f)), inv1 = exp2f(-(float)(fi + 1) * (18.931568569324174f / 16.f));
    float km0 = 0.f, km1 = 0.f;
    __syncthreads();
    for (int tt = w; tt < 256; tt += 8) {
        const int pos = blk * 256 + tt; const size_t row = (size_t)b * SEQL + pos;
        const bf16_t* pr = proj + row * PROJW;
        const unsigned qv = *(const unsigned*)(pr + 6144 + h * 128 + d0), kv = *(const unsigned*)(pr + 8192 + h * 128 + d0), vv = *(const unsigned*)(pr + 10240 + h * 128 + d0);
        float q0 = bf2f(qv & 0xffff), q1 = bf2f(qv >> 16), k0 = bf2f(kv & 0xffff), k1 = bf2f(kv >> 16);
        const float rq = rsqrtf(wave_sum(q0 * q0 + q1 * q1) * (1.f / 128.f) + 1e-6f), rk = rsqrtf(wave_sum(k0 * k0 + k1 * k1) * (1.f / 128.f) + 1e-6f);
        q0 = (q0 * rq) * gq0; q1 = (q1 * rq) * gq1; k0 = (k0 * rk) * gk0; k1 = (k1 * rk) * gk1;
        const float pq0 = __shfl_xor(q0, 8), pq1 = __shfl_xor(q1, 8), pk0 = __shfl_xor(k0, 8), pk1 = __shfl_xor(k1, 8);
        if (lane < 16) {
            float a0 = (float)pos * inv0, a1 = (float)pos * inv1;
            float n0 = rintf(a0 * 0.15915494309189535f), n1 = rintf(a1 * 0.15915494309189535f);
            a0 = fmaf(-n0, 6.2831854820251465f, a0); a0 = fmaf(-n0, -1.7484555e-7f, a0);
            a1 = fmaf(-n1, 6.2831854820251465f, a1); a1 = fmaf(-n1, -1.7484555e-7f, a1);
            const float c0 = __cosf(a0), s0 = __sinf(a0), c1 = __cosf(a1), s1 = __sinf(a1);
            if (lane < 8) { q0 = q0 * c0 - pq0 * s0; q1 = q1 * c1 - pq1 * s1; k0 = k0 * c0 - pk0 * s0; k1 = k1 * c1 - pk1 * s1; }
            else          { q0 = q0 * c0 + pq0 * s0; q1 = q1 * c1 + pq1 * s1; k0 = k0 * c0 + pk0 * s0; k1 = k1 * c1 + pk1 * s1; }
        }
        km0 += k0; km1 += k1;
        const size_t o = ((size_t)bh * SEQL + pos) * 128 + d0;
        *(unsigned*)(QN + o) = cvt_pk_bf16(q0 * 0.08838834764831845f, q1 * 0.08838834764831845f);
        *(unsigned*)(KN + o) = cvt_pk_bf16(k0, k1);
        VL[d0 * 264 + tt] = (bf16_t)(vv & 0xffff); VL[(d0 + 1) * 264 + tt] = (bf16_t)(vv >> 16);
    }
    KMS[w * 128 + d0] = km0; KMS[w * 128 + d0 + 1] = km1;
    __syncthreads();
    if (tid < 128) { float s = 0.f;
#pragma unroll
        for (int i = 0; i < 8; ++i) s += KMS[i * 128 + tid];
        KM[((size_t)bh * 8 + blk) * 128 + tid] = s * (1.f / 256.f); }
    for (int c = tid; c < 128 * 32; c += 512) { const int d = c >> 5, c8 = (c & 31) * 8;
        *(uint4*)(VTM + ((size_t)bh * 128 + d) * SEQL + blk * 256 + c8) = *(const uint4*)(VL + d * 264 + c8); }
}

constexpr int GL_QD = 0, GL_KI = 17408, GL_KST = 34816, GL_VT = 53248, GL_ATT = 62464, GL_ST = 71680, GL_BC = 89088, GL_TOT = 121856, GL_GLR = GL_QD;
__device__ __forceinline__ void gla_item(const Params& p, unsigned char* sm, int item) {
    const int tid = threadIdx.x, lane = tid & 63, w = tid >> 6, fr = lane & 15, fq = lane >> 4;
    const int dvs = item & 3, h = (item >> 2) & 7, b = item >> 5;
    bf16_t* QD = (bf16_t*)(sm + GL_QD); bf16_t* KI = (bf16_t*)(sm + GL_KI); bf16_t* KST = (bf16_t*)(sm + GL_KST); bf16_t* VT = (bf16_t*)(sm + GL_VT);
    bf16_t* ATT = (bf16_t*)(sm + GL_ATT); bf16_t* ST = (bf16_t*)(sm + GL_ST);
    float* BC = (float*)(sm + GL_BC); float* GLR = (float*)(sm + GL_GLR); float* TOT = (float*)(sm + GL_TOT);
    const bf16_t* proj = (const bf16_t*)(p.ws + WS_PROJ); const float* glr = (const float*)(p.ws + WS_GLR); float* OG = (float*)(p.ws + WS_OG);
    __syncthreads();
    float wcol[16];
#pragma unroll
    for (int r = 0; r < 16; ++r) wcol[r] = p.wgu[r * 1024 + h * 128 + (tid & 127)];
    const float bias = p.bg[h * 128 + (tid & 127)];
    for (int i = tid; i < 64 * 136 / 2; i += 512) ((unsigned*)ST)[i] = 0u;
    f32x4 Sacc[4];
#pragma unroll
    for (int i = 0; i < 4; ++i) Sacc[i] = (f32x4){0.f, 0.f, 0.f, 0.f};
    for (int n = 0; n < 32; ++n) {
        const int t0 = b * SEQL + n * 64;
        if (tid < 256) ((float4*)GLR)[tid] = ((const float4*)(glr + (size_t)t0 * 16))[tid];
        __syncthreads();
        {
            const int d = tid & 127, part = tid >> 7;
            float la[16]; float run = 0.f;
#pragma unroll
            for (int i = 0; i < 16; ++i) { const float* gr = GLR + (part * 16 + i) * 16; float z = bias;
#pragma unroll
                for (int r = 0; r < 16; ++r) z = fmaf(gr[r], wcol[r], z);
                const float ls = fminf(z, 0.f) - __logf(1.f + __expf(-fabsf(z)));
                run += ls * (1.f / 16.f); la[i] = run; }
            TOT[part * 128 + d] = run;
            __syncthreads();
            float off = 0.f;
            for (int pp = 0; pp < part; ++pp) off += TOT[pp * 128 + d];
#pragma unroll
            for (int i = 0; i < 16; ++i) BC[(part * 16 + i) * 128 + d] = la[i] + off;
        }
        __syncthreads();
        for (int c = tid; c < 1024; c += 512) { const int s = c >> 4, dd = (c & 15) * 8;
            const bf16_t* pr = proj + (size_t)(t0 + s) * PROJW + h * 128 + dd;
            const uint4 qv = *(const uint4*)pr, kv = *(const uint4*)(pr + 1024);
            const unsigned qa[4] = {qv.x, qv.y, qv.z, qv.w}, ka[4] = {kv.x, kv.y, kv.z, kv.w};
            unsigned qo[4], ko[4];
#pragma unroll
            for (int i = 0; i < 4; ++i) {
                const float bc0 = BC[s * 128 + dd + 2 * i], bc1 = BC[s * 128 + dd + 2 * i + 1], bl0 = BC[63 * 128 + dd + 2 * i], bl1 = BC[63 * 128 + dd + 2 * i + 1];
                const float q0 = bf2f(qa[i] & 0xffff), q1 = bf2f(qa[i] >> 16), k0 = bf2f(ka[i] & 0xffff), k1 = bf2f(ka[i] >> 16);
                qo[i] = cvt_pk_bf16(q0 * 0.08838834764831845f * __expf(bc0), q1 * 0.08838834764831845f * __expf(bc1));
                ko[i] = cvt_pk_bf16(k0 * __expf(-bc0), k1 * __expf(-bc1));
                KST[(dd + 2 * i) * 72 + s] = f2bf(k0 * __expf(bl0 - bc0)); KST[(dd + 2 * i + 1) * 72 + s] = f2bf(k1 * __expf(bl1 - bc1)); }
            *(uint4*)(QD + s * 136 + dd) = make_uint4(qo[0], qo[1], qo[2], qo[3]); *(uint4*)(KI + s * 136 + dd) = make_uint4(ko[0], ko[1], ko[2], ko[3]); }
        { const int s = tid >> 3, e0 = (tid & 7) * 8;
          const uint4 vv = *(const uint4*)(proj + (size_t)(t0 + s) * PROJW + 2048 + h * 256 + dvs * 64 + e0);
          const unsigned va[4] = {vv.x, vv.y, vv.z, vv.w};
#pragma unroll
          for (int i = 0; i < 4; ++i) { VT[(e0 + 2 * i) * 72 + s] = (bf16_t)(va[i] & 0xffff); VT[(e0 + 2 * i + 1) * 72 + s] = (bf16_t)(va[i] >> 16); } }
        __syncthreads();
        f32x4 oacc[2];
#pragma unroll
        for (int ti = 0; ti < 2; ++ti) { const int tile = 2 * w + ti, qt = tile >> 2, xt = tile & 3;
            f32x4 a = (f32x4){0.f, 0.f, 0.f, 0.f}, o = (f32x4){0.f, 0.f, 0.f, 0.f};
#pragma unroll
            for (int ks = 0; ks < 4; ++ks) { const bf16x8 af = *(const bf16x8*)(QD + (qt * 16 + fr) * 136 + ks * 32 + fq * 8);
                const bf16x8 bk = *(const bf16x8*)(KI + (xt * 16 + fr) * 136 + ks * 32 + fq * 8), bs = *(const bf16x8*)(ST + (xt * 16 + fr) * 136 + ks * 32 + fq * 8);
                a = MFMA16(af, bk, a); o = MFMA16(af, bs, o); }
#pragma unroll
            for (int j = 0; j < 4; ++j) { const int qq = qt * 16 + fq * 4 + j, ss = xt * 16 + fr; ATT[qq * 72 + ss] = f2bf(ss <= qq ? a[j] : 0.f); }
            oacc[ti] = o; }
        __syncthreads();
#pragma unroll
        for (int ti = 0; ti < 2; ++ti) { const int tile = 2 * w + ti, qt = tile >> 2, et = tile & 3; f32x4 o = oacc[ti];
#pragma unroll
            for (int ks = 0; ks < 2; ++ks) { const bf16x8 af = *(const bf16x8*)(ATT + (qt * 16 + fr) * 72 + ks * 32 + fq * 8), bv = *(const bf16x8*)(VT + (et * 16 + fr) * 72 + ks * 32 + fq * 8); o = MFMA16(af, bv, o); }
#pragma unroll
            for (int j = 0; j < 4; ++j) OG[(size_t)(t0 + qt * 16 + fq * 4 + j) * 2048 + h * 256 + dvs * 64 + et * 16 + fr] = o[j]; }
        float dec[4];
#pragma unroll
        for (int j = 0; j < 4; ++j) dec[j] = __expf(BC[63 * 128 + w * 16 + fq * 4 + j]);
#pragma unroll
        for (int et = 0; et < 4; ++et) { f32x4 s = Sacc[et];
#pragma unroll
            for (int j = 0; j < 4; ++j) s[j] *= dec[j];
#pragma unroll
            for (int ks = 0; ks < 2; ++ks) { const bf16x8 af = *(const bf16x8*)(KST + (w * 16 + fr) * 72 + ks * 32 + fq * 8), bv = *(const bf16x8*)(VT + (et * 16 + fr) * 72 + ks * 32 + fq * 8); s = MFMA16(af, bv, s); }
            Sacc[et] = s;
            uint2 pk; pk.x = cvt_pk_bf16(s[0], s[1]); pk.y = cvt_pk_bf16(s[2], s[3]);
            *(uint2*)(ST + (et * 16 + fr) * 136 + w * 16 + fq * 4) = pk; }
    }
}

constexpr int MB_KT = 0, MB_VT = 17408, MB_P = 35840, MB_MISC = 54272;
__device__ __forceinline__ void moba_item(const Params& p, unsigned char* sm, int item) {
    const int tid = threadIdx.x, lane = tid & 63, w = tid >> 6, fr = lane & 15, fq = lane >> 4;
    const int qt = 15 - (item >> 6), bh = item & 63, b = bh >> 4, h = bh & 15, q0 = qt * 128, blk = qt >> 1;
    const bf16_t* QNp = (const bf16_t*)(p.ws + WS_QN) + (size_t)bh * SEQL * 128; const bf16_t* KNp = (const bf16_t*)(p.ws + WS_KN) + (size_t)bh * SEQL * 128;
    const bf16_t* VTp = (const bf16_t*)(p.ws + WS_VTM) + (size_t)bh * 128 * SEQL; const float* KMp = (const float*)(p.ws + WS_KM) + (size_t)bh * 8 * 128;
    bf16_t* MIX = (bf16_t*)(p.ws + WS_MIX);
    bf16_t* KT = (bf16_t*)(sm + MB_KT); bf16_t* VT = (bf16_t*)(sm + MB_VT); bf16_t* Pw = (bf16_t*)(sm + MB_P) + w * 16 * 72; unsigned* bm = (unsigned*)(sm + MB_MISC);
    bf16x8 qf[4];
    { const bf16_t* qrow = QNp + (size_t)(q0 + w * 16 + fr) * 128;
#pragma unroll
      for (int ks = 0; ks < 4; ++ks) qf[ks] = *(const bf16x8*)(qrow + ks * 32 + fq * 8); }
    unsigned mask = 0u;
    { float g1 = -INFINITY, g2 = -INFINITY, g3 = -INFINITY; int i1 = -1, i2 = -1, i3 = -1;
      for (int n = 0; n < blk; ++n) { float part = 0.f;
#pragma unroll
          for (int ks = 0; ks < 4; ++ks) { const float* km = KMp + n * 128 + ks * 32 + fq * 8;
#pragma unroll
              for (int i = 0; i < 8; ++i) part = fmaf(bf2f((unsigned short)qf[ks][i]), km[i], part); }
          part += __shfl_xor(part, 16); part += __shfl_xor(part, 32);
          if (part > g1) { g3 = g2; i3 = i2; g2 = g1; i2 = i1; g1 = part; i1 = n; } else if (part > g2) { g3 = g2; i3 = i2; g2 = part; i2 = n; } else if (part > g3) { g3 = part; i3 = n; } }
      if (i1 >= 0) mask |= 1u << i1; if (i2 >= 0) mask |= 1u << i2; if (i3 >= 0) mask |= 1u << i3; }
    unsigned rm[4];
#pragma unroll
    for (int j = 0; j < 4; ++j) rm[j] = (unsigned)__shfl((int)mask, fq * 4 + j);
    __syncthreads();
    if (tid == 0) *bm = 0u;
    __syncthreads();
    { unsigned wm = mask;
#pragma unroll
      for (int o = 1; o < 16; o <<= 1) wm |= (unsigned)__shfl_xor((int)wm, o);
      if (lane == 0) atomicOr(bm, wm); }
    __syncthreads();
    const unsigned anym = *bm;
    f32x4 oacc[8];
#pragma unroll
    for (int i = 0; i < 8; ++i) oacc[i] = (f32x4){0.f, 0.f, 0.f, 0.f};
    float mrow[4] = {-1e30f, -1e30f, -1e30f, -1e30f}, lrow[4] = {0.f, 0.f, 0.f, 0.f};
    const int ntile = (q0 + 128) >> 6;
    for (int kt = 0; kt < ntile; ++kt) {
        const int kb = kt >> 2;
        if (kb < blk && !((anym >> kb) & 1u)) continue;
        for (int c = tid; c < 1024; c += 512) { const int r = c >> 4, c8 = (c & 15) * 8; *(uint4*)(KT + r * 136 + c8) = *(const uint4*)(KNp + (size_t)(kt * 64 + r) * 128 + c8); }
        for (int c = tid; c < 1024; c += 512) { const int d = c >> 3, c8 = (c & 7) * 8; *(uint4*)(VT + d * 72 + c8) = *(const uint4*)(VTp + (size_t)d * SEQL + kt * 64 + c8); }
        __syncthreads();
        f32x4 s[4];
#pragma unroll
        for (int g = 0; g < 4; ++g) { s[g] = (f32x4){0.f, 0.f, 0.f, 0.f};
#pragma unroll
            for (int ks = 0; ks < 4; ++ks) { const bf16x8 bk = *(const bf16x8*)(KT + (g * 16 + fr) * 136 + ks * 32 + fq * 8); s[g] = MFMA16(qf[ks], bk, s[g]); } }
#pragma unroll
        for (int j = 0; j < 4; ++j) { const int qpos = q0 + w * 16 + fq * 4 + j; const bool past = kb < blk; const bool rowok = past ? (((rm[j] >> kb) & 1u) != 0u) : true;
            float mx = -1e30f;
#pragma unroll
            for (int g = 0; g < 4; ++g) { const int kpos = kt * 64 + g * 16 + fr; const bool ok = rowok && (past || kpos <= qpos); const float sv = ok ? s[g][j] : -1e30f; s[g][j] = sv; mx = fmaxf(mx, sv); }
#pragma unroll
            for (int o = 1; o < 16; o <<= 1) mx = fmaxf(mx, __shfl_xor(mx, o));
            const float mnew = fmaxf(mrow[j], mx), alpha = __expf(mrow[j] - mnew); mrow[j] = mnew;
            float rs = 0.f;
#pragma unroll
            for (int g = 0; g < 4; ++g) { const float pv = (s[g][j] > -1e29f) ? __expf(s[g][j] - mnew) : 0.f; s[g][j] = pv; rs += pv; }
            lrow[j] = lrow[j] * alpha + rs;
#pragma unroll
            for (int dt = 0; dt < 8; ++dt) oacc[dt][j] *= alpha; }
#pragma unroll
        for (int g = 0; g < 4; ++g)
#pragma unroll
            for (int j = 0; j < 4; ++j) Pw[(fq * 4 + j) * 72 + g * 16 + fr] = f2bf(s[g][j]);
        LDS_WAIT();
        bf16x8 pf[2];
#pragma unroll
        for (int ks = 0; ks < 2; ++ks) pf[ks] = *(const bf16x8*)(Pw + fr * 72 + ks * 32 + fq * 8);
#pragma unroll
        for (int dt = 0; dt < 8; ++dt)
#pragma unroll
            for (int ks = 0; ks < 2; ++ks) { const bf16x8 bv = *(const bf16x8*)(VT + (dt * 16 + fr) * 72 + ks * 32 + fq * 8); oacc[dt] = MFMA16(pf[ks], bv, oacc[dt]); }
        __syncthreads();
    }
    float inv[4];
#pragma unroll
    for (int j = 0; j < 4; ++j) { float l = lrow[j];
#pragma unroll
        for (int o = 1; o < 16; o <<= 1) l += __shfl_xor(l, o);
        inv[j] = 1.f / l; }
#pragma unroll
    for (int dt = 0; dt < 8; ++dt)
#pragma unroll
        for (int j = 0; j < 4; ++j) MIX[(size_t)(b * SEQL + q0 + w * 16 + fq * 4 + j) * DM + 2048 + h * 128 + dt * 16 + fr] = f2bf(oacc[dt][j] * inv[j]);
}

__device__ __forceinline__ void gla_final(const Params& p) {
    const int tid = threadIdx.x, lane = tid & 63, w = tid >> 6;
    const float* OG = (const float*)(p.ws + WS_OG); const bf16_t* proj = (const bf16_t*)(p.ws + WS_PROJ); bf16_t* MIX = (bf16_t*)(p.ws + WS_MIX);
    const float4 gn = ((const float4*)p.glang)[lane];
    for (int it = blockIdx.x * 8 + w; it < NTOK * 8; it += gridDim.x * 8) { const int t = it >> 3, h = it & 7;
        const float4 o = ((const float4*)(OG + (size_t)t * 2048 + h * 256))[lane];
        const float r = rsqrtf(wave_sum((o.x * o.x + o.y * o.y) + (o.z * o.z + o.w * o.w)) * (1.f / 256.f) + 1e-6f);
        const uint2 gv = ((const uint2*)(proj + (size_t)t * PROJW + 4096 + h * 256))[lane];
        const float g0 = bf2f(gv.x & 0xffff), g1 = bf2f(gv.x >> 16), g2 = bf2f(gv.y & 0xffff), g3 = bf2f(gv.y >> 16);
        const float y0 = ((o.x * r) * gn.x) * (g0 / (1.f + __expf(-g0))), y1 = ((o.y * r) * gn.y) * (g1 / (1.f + __expf(-g1)));
        const float y2 = ((o.z * r) * gn.z) * (g2 / (1.f + __expf(-g2))), y3 = ((o.w * r) * gn.w) * (g3 / (1.f + __expf(-g3)));
        uint2 ov; ov.x = cvt_pk_bf16(y0, y1); ov.y = cvt_pk_bf16(y2, y3);
        ((uint2*)(MIX + (size_t)t * DM + h * 256))[lane] = ov; }
}

constexpr int PE_QS = 0, PE_KS = 16896, PE_SC = 84480, PE_SEL = 117248;
template <int NV> __device__ __forceinline__ void select16(const float (&v)[NV], bool (&sel)[NV], int lane) {
    unsigned key[NV];
#pragma unroll
    for (int i = 0; i < NV; ++i) { const unsigned u = __float_as_uint(v[i]); key[i] = (u & 0x80000000u) ? ~u : (u | 0x80000000u); }
    unsigned prefix = 0u;
    for (int bit = 31; bit >= 0; --bit) { const unsigned cand = prefix | (1u << bit); int cnt = 0;
#pragma unroll
        for (int i = 0; i < NV; ++i) cnt += __popcll(__ballot(key[i] >= cand));
        if (cnt >= 16) prefix = cand; }
    int ngt = 0;
#pragma unroll
    for (int i = 0; i < NV; ++i) ngt += __popcll(__ballot(key[i] > prefix));
    const int need = 16 - ngt; int eqb = 0; const u64 lt = (1ull << lane) - 1ull;
#pragma unroll
    for (int i = 0; i < NV; ++i) { const bool eq = key[i] == prefix; const u64 m = __ballot(eq); const int rank = eqb + __popcll(m & lt); sel[i] = (key[i] > prefix) || (eq && rank < need); eqb += __popcll(m); }
}
__device__ __forceinline__ void atomic_add_bf16(bf16_t* base, size_t idx, float g) {
    unsigned* wp = (unsigned*)base + (idx >> 1); const int sh = (int)(idx & 1) * 16;
    unsigned old = __hip_atomic_load(wp, __ATOMIC_RELAXED, __HIP_MEMORY_SCOPE_AGENT), assumed;
    do { assumed = old; const float f = bf2f((unsigned short)((assumed >> sh) & 0xffffu)) + g;
         const unsigned nw = (assumed & ~(0xffffu << sh)) | ((unsigned)f2bf(f) << sh);
         old = atomicCAS(wp, assumed, nw); } while (old != assumed);
}
__device__ __forceinline__ void peer_item(const Params& p, unsigned char* sm, int item) {
    const int tid = threadIdx.x, lane = tid & 63, w = tid >> 6;
    const int h = item & 7, t0 = (item >> 3) * 32;
    float* QS = (float*)(sm + PE_QS); float* KS = (float*)(sm + PE_KS); float* SC = (float*)(sm + PE_SC);
    float* s1 = (float*)(sm + PE_SEL + w * 256); float* s2 = s1 + 16; int* i1 = (int*)(s1 + 32); int* i2 = i1 + 16;
    const float* Q = (const float*)(p.ws + WS_Q); bf16_t* W = (bf16_t*)(p.ws + WS_W);
    for (int pp = 0; pp < 2; ++pp) {
        __syncthreads();
        for (int c = tid; c < 32 * 32; c += 512) { const int t = c >> 5, d4 = (c & 31) * 4; *(float4*)(QS + t * 132 + d4) = *(const float4*)(Q + (size_t)(t0 + t) * 2048 + h * 256 + pp * 128 + d4); }
        for (int c = tid; c < 128 * 32; c += 512) { const int k = c >> 5, d4 = (c & 31) * 4; *(float4*)(KS + k * 132 + d4) = *(const float4*)(p.pkeys + ((size_t)(h * 2 + pp) * 128 + k) * 128 + d4); }
        __syncthreads();
        const int tg = tid >> 5, kg = tid & 31;
        float acc[2][4] = {{0.f, 0.f, 0.f, 0.f}, {0.f, 0.f, 0.f, 0.f}};
#pragma unroll 4
        for (int d = 0; d < 128; d += 4) { const float4 qa = *(const float4*)(QS + (tg * 2) * 132 + d), qb = *(const float4*)(QS + (tg * 2 + 1) * 132 + d);
#pragma unroll
            for (int i = 0; i < 4; ++i) { const float4 kv = *(const float4*)(KS + (kg + 32 * i) * 132 + d);
                acc[0][i] = fmaf(qa.x, kv.x, fmaf(qa.y, kv.y, fmaf(qa.z, kv.z, fmaf(qa.w, kv.w, acc[0][i]))));
                acc[1][i] = fmaf(qb.x, kv.x, fmaf(qb.y, kv.y, fmaf(qb.z, kv.z, fmaf(qb.w, kv.w, acc[1][i])))); } }
#pragma unroll
        for (int a = 0; a < 2; ++a)
#pragma unroll
            for (int i = 0; i < 4; ++i) SC[(pp * 32 + tg * 2 + a) * 128 + kg + 32 * i] = acc[a][i];
    }
    __syncthreads();
    const u64 lt = (1ull << lane) - 1ull;
    for (int ti = 0; ti < 4; ++ti) { const int t = w * 4 + ti;
#pragma unroll
        for (int pp = 0; pp < 2; ++pp) { float v[2] = {SC[(pp * 32 + t) * 128 + lane], SC[(pp * 32 + t) * 128 + lane + 64]}; bool sel[2]; select16<2>(v, sel, lane);
            float* so = pp ? s2 : s1; int* io = pp ? i2 : i1; int base = 0;
#pragma unroll
            for (int i = 0; i < 2; ++i) { const u64 m = __ballot(sel[i]); if (sel[i]) { const int pos = base + __popcll(m & lt); so[pos] = v[i]; io[pos] = lane + 64 * i; } base += __popcll(m); } }
        LDS_WAIT();
        float cv[4]; bool cs[4];
#pragma unroll
        for (int i = 0; i < 4; ++i) { const int c = lane + 64 * i; cv[i] = s1[c >> 4] + s2[c & 15]; }
        select16<4>(cv, cs, lane);
        float myS = 0.f; int myE = 0; int base = 0;
        float* ts = (float*)(sm + PE_SEL + 2048 + w * 128); int* te = (int*)(ts + 16);
#pragma unroll
        for (int i = 0; i < 4; ++i) { const u64 m = __ballot(cs[i]); if (cs[i]) { const int pos = base + __popcll(m & lt); const int c = lane + 64 * i; ts[pos] = cv[i]; te[pos] = i1[c >> 4] * 128 + i2[c & 15]; } base += __popcll(m); }
        LDS_WAIT();
        if (lane < 16) { myS = ts[lane]; myE = te[lane]; }
        float mx = lane < 16 ? myS : -INFINITY;
#pragma unroll
        for (int o = 1; o < 16; o <<= 1) mx = fmaxf(mx, __shfl_xor(mx, o));
        float ex = lane < 16 ? __expf(myS - mx) : 0.f, sum = ex;
#pragma unroll
        for (int o = 1; o < 16; o <<= 1) sum += __shfl_xor(sum, o);
        if (lane < 16) atomic_add_bf16(W, (size_t)(t0 + t) * NEXP + myE, ex / sum);
        LDS_WAIT();
    }
}

__global__ void __launch_bounds__(512, 2) hymba_fwd(Params p) {
    extern __shared__ __attribute__((aligned(16))) unsigned char smem[];
    cg::grid_group grid = cg::this_grid();
    volatile int& s_item = *(volatile int*)(smem + 131072);
    const int tid = threadIdx.x, lane = tid & 63, w = tid >> 6;
    const int G = gridDim.x, c = blockIdx.x;
    unsigned* ctrl = (unsigned*)(p.ws + WS_CTRL);
#define PH_ON(n) (p.ph_lo <= (n) && (n) < p.ph_hi)
#define PH_SYNC(n) if ((n) > p.ph_lo && (n) < p.ph_hi) grid.sync()
    if (PH_ON(0)) phase_prep(p, smem);
    PH_SYNC(1);
    if (PH_ON(1)) { pg8::Gemm g{(const bf16_t*)(p.ws + WS_HB), (const bf16_t*)(p.ws + WS_WINT), NTOK, NINP, DM}; pg8::StaticOrder S; S.init(NTOK, NINP, G, c);
        EpiProj E{(bf16_t*)(p.ws + WS_PROJ), (float*)(p.ws + WS_GLR)}; pg8::gemm_phase<EpiProj, pg8::StaticOrder, false>((PG8_LAS unsigned char*)smem, g, S, E, nullptr); }
    PH_SYNC(2);
    if (PH_ON(2)) for (int it = c; it < 512; it += G) moba_prep_item(p, smem, it);
    PH_SYNC(3);
    if (PH_ON(3)) { if (c < 128) gla_item(p, smem, c); else for (int it = c - 128; it < 1024; it += G - 128) moba_item(p, smem, it); }
    PH_SYNC(4);
    if (PH_ON(4)) gla_final(p);
    PH_SYNC(5);
    if (PH_ON(5)) { pg8::Gemm g{(const bf16_t*)(p.ws + WS_MIX), (const bf16_t*)(p.ws + WS_WOUTT), NTOK, DM, DM}; pg8::StaticOrder S; S.init(NTOK, DM, G, c);
        EpiRes E{p.out, p.x, DM}; pg8::gemm_phase<EpiRes, pg8::StaticOrder, false>((PG8_LAS unsigned char*)smem, g, S, E, nullptr); }
    PH_SYNC(6);
    if (PH_ON(6)) { bf16_t* HB = (bf16_t*)(p.ws + WS_HB);
        for (int r = c * 8 + w; r < NTOK; r += G * 8) rms_row(p.out + (size_t)r * DM, p.g2, HB + (size_t)r * DM, lane);
        uint4* Wz = (uint4*)(p.ws + WS_W); const uint4 z = make_uint4(0u, 0u, 0u, 0u);
        for (size_t i = (size_t)c * 512 + tid; i < (size_t)NTOK * NEXP / 8; i += (size_t)G * 512) Wz[i] = z; }
    PH_SYNC(7);
    if (PH_ON(7)) { pg8::Gemm g{(const bf16_t*)(p.ws + WS_HB), (const bf16_t*)(p.ws + WS_WPQT), NTOK, 2048, DM}; pg8::StaticOrder S; S.init(NTOK, 2048, G, c);
        EpiF32 E{(float*)(p.ws + WS_Q), 2048}; pg8::gemm_phase<EpiF32, pg8::StaticOrder, false>((PG8_LAS unsigned char*)smem, g, S, E, nullptr); }
    PH_SYNC(8);
    if (PH_ON(8)) for (int it = c; it < 2048; it += G) peer_item(p, smem, it);
    PH_SYNC(9);
    if (PH_ON(9)) { pg8::Gemm g{(const bf16_t*)(p.ws + WS_HB), (const bf16_t*)(p.ws + WS_UB), NTOK, NEXP, DM}; pg8::StaticOrder S; S.init(NTOK, NEXP, G, c);
        EpiPeerW E{(bf16_t*)(p.ws + WS_W)}; pg8::gemm_phase<EpiPeerW, pg8::StaticOrder, false>((PG8_LAS unsigned char*)smem, g, S, E, nullptr); }
    PH_SYNC(10);
    if (PH_ON(10)) { pg8::Gemm g{(const bf16_t*)(p.ws + WS_W), (const bf16_t*)(p.ws + WS_VTB), NTOK, DM, NEXP}; pg8::StaticOrder S; S.init(NTOK, DM, G, c);
        EpiRes E{p.out, p.out, DM}; pg8::gemm_phase<EpiRes, pg8::StaticOrder, false>((PG8_LAS unsigned char*)smem, g, S, E, nullptr); }
}

#ifndef MK_PER_PHASE
#define MK_PER_PHASE 0
#endif
extern "C" void kernel_launch(void* const* d_in, const int* in_sizes, int n_in, void* d_out, int out_size, void* d_ws, size_t ws_size, hipStream_t stream) {
    static int grid = 0;
    if (grid == 0) {
        if (n_in != 14 || out_size != NTOK * DM || ws_size < WS_END) { fprintf(stderr, "kernel_launch: unexpected shapes (n_in %d out %d ws %zu)\n", n_in, out_size, ws_size); grid = -1; return; }
        int dev = 0, cus = 0, per_cu = 0;
        hipGetDevice(&dev); hipDeviceGetAttribute(&cus, hipDeviceAttributeMultiprocessorCount, dev);
        if (hipFuncSetAttribute((const void*)hymba_fwd, hipFuncAttributeMaxDynamicSharedMemorySize, LDS_BYTES) != hipSuccess) { fprintf(stderr, "kernel_launch: hipFuncSetAttribute failed\n"); grid = -1; return; }
        if (hipOccupancyMaxActiveBlocksPerMultiprocessor(&per_cu, (const void*)hymba_fwd, 512, LDS_BYTES) != hipSuccess || per_cu < 1) { fprintf(stderr, "kernel_launch: occupancy query failed (%d)\n", per_cu); grid = -1; return; }
        grid = cus * (per_cu > 1 ? 1 : per_cu);
        fprintf(stderr, "kernel_launch: %d CUs, %d blocks/CU by query, grid %d\n", cus, per_cu, grid);
    }
    if (grid < 0) return;
    hipMemsetAsync((char*)d_ws + WS_CTRL, 0, 4096, stream);
    Params p{};
    p.x = (const float*)d_in[0]; p.g1 = (const float*)d_in[1]; p.win = (const float*)d_in[2]; p.wgu = (const float*)d_in[3]; p.bg = (const float*)d_in[4]; p.glang = (const float*)d_in[5];
    p.qng = (const float*)d_in[6]; p.kng = (const float*)d_in[7]; p.wout = (const float*)d_in[8]; p.g2 = (const float*)d_in[9]; p.wpq = (const float*)d_in[10]; p.pkeys = (const float*)d_in[11];
    p.pu = (const float*)d_in[12]; p.pv = (const float*)d_in[13]; p.out = (float*)d_out; p.ws = (unsigned char*)d_ws;
#if MK_PER_PHASE
    for (int ph = 0; ph < NPHASE; ++ph) { p.ph_lo = ph; p.ph_hi = ph + 1; void* args[] = {&p};
        hipError_t e = hipLaunchCooperativeKernel((const void*)hymba_fwd, dim3(grid), dim3(512), args, LDS_BYTES, stream);
        if (e != hipSuccess) { fprintf(stderr, "cooperative launch failed: %s\n", hipGetErrorString(e)); break; } }
#else
    p.ph_lo = 0; p.ph_hi = NPHASE; void* args[] = {&p};
    hipError_t e = hipLaunchCooperativeKernel((const void*)hymba_fwd, dim3(grid), dim3(512), args, LDS_BYTES, stream);
    if (e != hipSuccess) fprintf(stderr, "cooperative launch failed: %s (grid %d)\n", hipGetErrorString(e), grid);
#endif
}
```

```cpp
#include <hip/hip_runtime.h>
#include <hip/hip_cooperative_groups.h>
#include <cstdio>
#include <cstdint>
namespace cg = cooperative_groups;
namespace pg8 {
#define PG8_LAS __attribute__((address_space(3)))
typedef unsigned short bf16_t;
typedef short bf16x8 __attribute__((ext_vector_type(8)));
typedef float f32x4 __attribute__((ext_vector_type(4)));
typedef unsigned u32x4 __attribute__((ext_vector_type(4)));
constexpr int BM = 256, BK = 64, HALF = 128, HTB = HALF * BK * 2  , STAGE_BYTES = 8 * HTB, NXCD = 8, WGM = 8;

__host__ __device__ __forceinline__ int lds_byte(int r, int c) { const int st = (r >> 4) * 2 + (c >> 5), rr = r & 15, cc = c & 31, ob = rr * 64 + cc * 2; return st * 1024 + (ob ^ (((ob >> 9) & 1) << 5)); }
__host__ __device__ __forceinline__ void stage_rc(int b, int& R, int& C) { const int st = b / 1024, sb = b % 1024, swz = sb ^ (((sb >> 9) & 1) << 5); R = (st >> 1) * 16 + swz / 64; C = (st & 1) * 32 + (swz % 64) / 2; }
__host__ __device__ __forceinline__ int perm32(int rho) { const int n = rho >> 4, i = rho & 15; return 8 * (i >> 2) + 4 * n + (i & 3); }

struct Unit { int pm, pn; };
struct Gemm { const bf16_t* A; const bf16_t* Bt; int M, N, K; };

struct StaticOrder {
    int nM, nN, nwg, G, c;
    __host__ __device__ void init(int M, int N, int G_, int c_) { nM = M / BM; nN = N / BM; nwg = nM * nN; G = G_; c = c_; }
    __host__ __device__ bool next(int i, Unit& u) const {
        const long L = (long)i * G + c; if (L >= nwg) return false;
        int wgid = (int)L; { const int q = nwg / NXCD, r = nwg % NXCD, xcd = wgid % NXCD, off = wgid / NXCD; wgid = (xcd < r ? xcd * (q + 1) : r * (q + 1) + (xcd - r) * q) + off; }
        const int nig = WGM * nN, gid = wgid / nig, fm = gid * WGM, gsz = (nM - fm) < WGM ? (nM - fm) : WGM;
        u.pm = fm + ((wgid % nig) % gsz); u.pn = (wgid % nig) / gsz; return true;
    }
    __device__ __forceinline__ void a_ready(const Unit&) const {}
    __device__ __forceinline__ void done(const Unit&) const {}
};
typedef __bf16 bf16x2_t __attribute__((ext_vector_type(2)));
typedef float f32x2c_t __attribute__((ext_vector_type(2)));
__device__ __forceinline__ unsigned cvt_pk_bf16(float lo, float hi) { f32x2c_t v = {lo, hi}; bf16x2_t b = __builtin_convertvector(v, bf16x2_t); return __builtin_bit_cast(unsigned, b); }
typedef float f32x2 __attribute__((ext_vector_type(2)));
__device__ __forceinline__ f32x2 gelu_pk(f32x2 v) {
    const f32x2 av = __builtin_elementwise_abs(v), d = av * 0.2316418882f + 1.0f;
    f32x2 t; t.x = __builtin_amdgcn_rcpf(d.x); t.y = __builtin_amdgcn_rcpf(d.y);
    f32x2 q = t * 0.5307027145f + (-0.7265760135f); q = q * t + 0.7107068705f; q = q * t + (-0.142248368f); q = q * t + 0.127414796f; q = q * t;
    const f32x2 s = (v * v) * (-0.72134752044f);
    f32x2 e; e.x = __builtin_amdgcn_exp2f(s.x); e.y = __builtin_amdgcn_exp2f(s.y);
    const f32x2 m = v * (q * e), r = v - m;
    f32x2 o; o.x = v.x < 0.f ? m.x : r.x; o.y = v.y < 0.f ? m.y : r.y; return o;
}

typedef int i32x4 __attribute__((ext_vector_type(4)));
typedef int i32x8 __attribute__((ext_vector_type(8)));
__device__ __forceinline__ i32x8 cat16(const bf16x8 a, const bf16x8 b) { const i32x4 lo = __builtin_bit_cast(i32x4, a), hi = __builtin_bit_cast(i32x4, b); return __builtin_shufflevector(lo, hi, 0, 1, 2, 3, 4, 5, 6, 7); }
template <bool F8> __device__ __forceinline__ void mma_block(f32x4 (&accb)[4][2], const bf16x8 (&At)[4][2], const bf16x8 (&Bt)[2][2], const i32x8 (&At8)[4], const i32x8 (&Bt8)[2]) {
    if constexpr (F8) {
#pragma unroll
        for (int m = 0; m < 4; ++m)
#pragma unroll
            for (int n = 0; n < 2; ++n) asm volatile("v_mfma_f32_16x16x128_f8f6f4 %0, %1, %2, %0" : "+v"(accb[m][n]) : "v"(Bt8[n]), "v"(At8[m]));
    } else {
#pragma unroll
        for (int m = 0; m < 4; ++m)
#pragma unroll
            for (int n = 0; n < 2; ++n)
#pragma unroll
                for (int k = 0; k < 2; ++k) accb[m][n] = __builtin_amdgcn_mfma_f32_16x16x32_bf16(Bt[n][k], At[m][k], accb[m][n], 0, 0, 0);
    }
}
template <class Epi, class Sched, bool STAMP = false, bool F8 = false>
__device__ __forceinline__ void gemm_phase(PG8_LAS unsigned char* lds, const Gemm g, const Sched& S, const Epi& E, unsigned long long* stamps) {
    const int tid = threadIdx.x, wid = __builtin_amdgcn_readfirstlane(tid >> 6), lane = tid & 63, wr = wid >> 2, wc = wid & 3, fr = lane & 15, fq = lane >> 4;
    const int K = g.K, nt = K / BK;
    int ts_lo = 0, ts_hi = 0, nts = 0; const unsigned long long rt_entry = STAMP ? (unsigned long long)wall_clock64() : 0ull;
#define PG8_STAMP() do { if (STAMP && wid == 0 && nts < 64) { const unsigned long long _c = (unsigned long long)clock64(); \
        ts_lo = (lane == nts) ? (int)(unsigned)_c : ts_lo; ts_hi = (lane == nts) ? (int)(unsigned)(_c >> 32) : ts_hi; ++nts; } } while (0)
    PG8_STAMP();
    unsigned voffA[2], voffB[2];
#pragma unroll
    for (int i = 0; i < 2; ++i) { int R, C; stage_rc(tid * 16 + i * 8192, R, C); const int Rb = Epi::PERM ? ((R & ~31) + perm32(R & 31)) : R;
        voffA[i] = (unsigned)(R * K + C) * 2u; voffB[i] = (unsigned)(Rb * K + C) * 2u; }
    const size_t kstep = (size_t)(BK * 2);
    const size_t hstep = (size_t)HALF * K * 2;
    const size_t tstep = 2 * hstep;
    const unsigned ldsw = (unsigned)wid * 1024u;
    const int aoff = lds_byte(wr * 64 + fr, fq * 8), boff = lds_byte(wc * 32 + fr, fq * 8);
#define PG8_SA(b, h) (((b) * 2 + (h)) * HTB)
#define PG8_SB(b, h) ((4 + (b) * 2 + (h)) * HTB)
#define PG8_STAGE(bufoff, gbase, voff) do { _Pragma("unroll") for (int _i = 0; _i < 2; ++_i) \
        __builtin_amdgcn_global_load_lds((const unsigned*)((const char*)(gbase) + (voff)[_i]), (PG8_LAS unsigned*)(lds + (bufoff) + ldsw + _i * 8192), 16, 0, 0); } while (0)
#define PG8_LDA(dst, b, h) do { _Pragma("unroll") for (int m = 0; m < 4; ++m) { if constexpr (F8) dst##8[m] = cat16(*(const PG8_LAS bf16x8*)(lds + PG8_SA(b, h) + aoff + m * 2048), *(const PG8_LAS bf16x8*)(lds + PG8_SA(b, h) + aoff + m * 2048 + 1024)); else { _Pragma("unroll") for (int k = 0; k < 2; ++k) dst[m][k] = *(const PG8_LAS bf16x8*)(lds + PG8_SA(b, h) + aoff + m * 2048 + k * 1024); } } } while (0)
#define PG8_LDB(dst, b, h) do { _Pragma("unroll") for (int n = 0; n < 2; ++n) { if constexpr (F8) dst##8[n] = cat16(*(const PG8_LAS bf16x8*)(lds + PG8_SB(b, h) + boff + n * 2048), *(const PG8_LAS bf16x8*)(lds + PG8_SB(b, h) + boff + n * 2048 + 1024)); else { _Pragma("unroll") for (int k = 0; k < 2; ++k) dst[n][k] = *(const PG8_LAS bf16x8*)(lds + PG8_SB(b, h) + boff + n * 2048 + k * 1024); } } } while (0)
#define PG8_MMA(ai, bj, At, Bt) do { __builtin_amdgcn_s_setprio(1); mma_block<F8>(acc[ai][bj], At, Bt, At##8, Bt##8); __builtin_amdgcn_s_setprio(0); } while (0)
#define PG8_WAIT_V(n) asm volatile("s_waitcnt vmcnt(" #n ")" ::: "memory")
#define PG8_WAIT_L(n) asm volatile("s_waitcnt lgkmcnt(" #n ")" ::: "memory")
#define PG8_BAR __builtin_amdgcn_s_barrier()
#define PG8_SCHED __builtin_amdgcn_sched_barrier(0)
    Unit cur, nxt; int ui = 0;
    if (!S.next(0, cur)) return;
    f32x4 acc[2][2][4][2];
#pragma unroll
    for (int a = 0; a < 2; ++a)
#pragma unroll
        for (int b = 0; b < 2; ++b)
#pragma unroll
            for (int m = 0; m < 4; ++m)
#pragma unroll
                for (int n = 0; n < 2; ++n) acc[a][b][m][n] = (f32x4){0.f, 0.f, 0.f, 0.f};
    bf16x8 At[4][2], B0[2][2], B1[2][2]; i32x8 At8[4], B08[2], B18[2];
    const char* cA = (const char*)g.A + (size_t)cur.pm * tstep; const char* cB = (const char*)g.Bt + (size_t)cur.pn * tstep;
    S.a_ready(cur);
    PG8_STAGE(PG8_SB(0, 0), cB, voffB); PG8_STAGE(PG8_SA(0, 0), cA, voffA); PG8_STAGE(PG8_SB(0, 1), cB + hstep, voffB); PG8_STAGE(PG8_SA(0, 1), cA + hstep, voffA);
    if (wr == 1) PG8_BAR;
    PG8_WAIT_V(4); PG8_BAR;
    PG8_STAGE(PG8_SB(1, 0), cB + kstep, voffB); PG8_STAGE(PG8_SA(1, 0), cA + kstep, voffA); PG8_STAGE(PG8_SB(1, 1), cB + hstep + kstep, voffB);
    PG8_WAIT_V(6); PG8_BAR;
    PG8_STAMP();
    for (;;) {
        const bool has_next = S.next(ui + 1, nxt);
        const char* nA = has_next ? (const char*)g.A + (size_t)nxt.pm * tstep : cA; const char* nB = has_next ? (const char*)g.Bt + (size_t)nxt.pn * tstep : cB;
        for (int t = 0; t < nt; t += 2) {
            const bool last = (t == nt - 2);
            const char* a1 = cA + (size_t)(t + 1) * kstep;
            const char* a2 = last ? nA : cA + (size_t)(t + 2) * kstep; const char* b2 = last ? nB : cB + (size_t)(t + 2) * kstep;
            const char* a3 = a2 + kstep; const char* b3 = b2 + kstep;
            if (last && has_next) S.a_ready(nxt);
            PG8_LDB(B0, 0, 0); PG8_SCHED; PG8_LDA(At, 0, 0); PG8_STAGE(PG8_SA(1, 1), a1 + hstep, voffA);
            PG8_WAIT_L(8); PG8_BAR; PG8_WAIT_L(0); PG8_MMA(0, 0, At, B0); PG8_BAR; PG8_SCHED;
            PG8_LDB(B1, 0, 1); PG8_STAGE(PG8_SB(0, 0), b2, voffB);
            PG8_BAR; PG8_WAIT_L(0); PG8_MMA(0, 1, At, B1); PG8_BAR;
            PG8_LDA(At, 0, 1); PG8_STAGE(PG8_SA(0, 0), a2, voffA);
            PG8_BAR; PG8_WAIT_L(0); PG8_MMA(1, 0, At, B0); PG8_BAR; PG8_SCHED;
            PG8_STAGE(PG8_SB(0, 1), b2 + hstep, voffB);
            PG8_WAIT_V(6); PG8_BAR; PG8_MMA(1, 1, At, B1); PG8_BAR;
            PG8_LDB(B0, 1, 0); PG8_SCHED; PG8_LDA(At, 1, 0); PG8_STAGE(PG8_SA(0, 1), a2 + hstep, voffA);
            PG8_WAIT_L(8); PG8_BAR; PG8_WAIT_L(0); PG8_MMA(0, 0, At, B0); PG8_BAR; PG8_SCHED;
            PG8_LDB(B1, 1, 1); PG8_STAGE(PG8_SB(1, 0), b3, voffB);
            PG8_BAR; PG8_WAIT_L(0); PG8_MMA(0, 1, At, B1); PG8_BAR;
            PG8_LDA(At, 1, 1); PG8_STAGE(PG8_SA(1, 0), a3, voffA);
            PG8_BAR; PG8_WAIT_L(0); PG8_MMA(1, 0, At, B0); PG8_BAR; PG8_SCHED;
            PG8_STAGE(PG8_SB(1, 1), b3 + hstep, voffB);
            PG8_WAIT_V(6); PG8_BAR; PG8_MMA(1, 1, At, B1); PG8_BAR;
        }
        PG8_STAMP();
        if constexpr (!Epi::AFTER_DRAIN) { E(acc, cur, wr, wc, fr, fq); S.done(cur); }
        PG8_STAMP();
        if (!has_next) break;
#pragma unroll
        for (int a = 0; a < 2; ++a)
#pragma unroll
            for (int b = 0; b < 2; ++b)
#pragma unroll
                for (int m = 0; m < 4; ++m)
#pragma unroll
                    for (int n = 0; n < 2; ++n) acc[a][b][m][n] = (f32x4){0.f, 0.f, 0.f, 0.f};
        cur = nxt; cA = nA; cB = nB; ++ui;
    }
    PG8_WAIT_V(0);
    if (wr == 0) PG8_BAR;
    PG8_BAR;
    if constexpr (Epi::AFTER_DRAIN) { E.fused(acc, cur, wr, wc, fr, fq, lds, wid, lane); S.done(cur); }
    PG8_STAMP();
    if (STAMP && wid == 0) { stamps[lane] = lane < nts ? (((unsigned long long)(unsigned)ts_hi << 32) | (unsigned)ts_lo) : 0ull;
        if (lane == 62) stamps[62] = rt_entry; if (lane == 63) stamps[63] = (unsigned long long)wall_clock64(); }
#undef PG8_STAMP
#undef PG8_SA
#undef PG8_SB
#undef PG8_STAGE
#undef PG8_LDA
#undef PG8_LDB
#undef PG8_MMA
#undef PG8_WAIT_V
#undef PG8_WAIT_L
#undef PG8_BAR
#undef PG8_SCHED
}
}

using pg8::bf16_t; using pg8::bf16x8; using pg8::f32x4; using pg8::f32x2; using pg8::cvt_pk_bf16; using pg8::Unit;
typedef unsigned long long u64;

constexpr int NTOK = 8192, DM = 4096, SEQL = 2048;
constexpr int NIN = 12304, NINP = 12544, PROJW = 12288;
constexpr int NEXP = 16384;
constexpr size_t MiB = 1024ull * 1024ull;
constexpr size_t WS_CTRL = 0, WS_KM = 1 * MiB, WS_GLR = 2 * MiB, WS_WINT = 4 * MiB, WS_WOUTT = 102 * MiB, WS_WPQT = 134 * MiB, WS_UB = 150 * MiB, WS_VTB = 278 * MiB,
                 WS_HB = 406 * MiB, WS_MIX = 470 * MiB, WS_OG = 534 * MiB, WS_PROJ = 598 * MiB, WS_QN = 790 * MiB, WS_KN = 822 * MiB, WS_VTM = 854 * MiB, WS_HB8 = 886 * MiB, WS_END = 918 * MiB;
constexpr size_t WS_W = WS_PROJ;
constexpr size_t WS_W8 = WS_MIX;
constexpr size_t WS_WINT8 = WS_UB + 64 * MiB;
constexpr size_t WS_KH = 2 * MiB + 512 * 1024, WS_KL = 3 * MiB;
constexpr size_t WS_Q = WS_OG;
constexpr int LDS_BYTES = 131072 + 16;
constexpr int NPHASE = 11;

struct Params {
    const float *x, *g1, *win, *wgu, *bg, *glang, *qng, *kng, *wout, *g2, *wpq, *pkeys, *pu, *pv;
    float* out; unsigned char* ws; int ph_lo, ph_hi;
};

__device__ __forceinline__ float bf2f(unsigned short b) { return __uint_as_float(((unsigned)b) << 16); }
__device__ __forceinline__ unsigned short f2bf(float f) { unsigned u = __float_as_uint(f); u += 0x7FFFu + ((u >> 16) & 1u); return (unsigned short)(u >> 16); }
constexpr float SC_X = 16.f, SC_U = 1024.f, SC_W = 64.f, SC_V = 128.f;
__device__ __forceinline__ float clamp_f8(float x) { return __builtin_fminf(__builtin_fmaxf(x, -448.f), 448.f); }
__device__ __forceinline__ unsigned pk4_fp8(float a, float b, float c, float d) {
    int r = __builtin_amdgcn_cvt_pk_fp8_f32(clamp_f8(a), clamp_f8(b), 0, false); r = __builtin_amdgcn_cvt_pk_fp8_f32(clamp_f8(c), clamp_f8(d), r, true); return (unsigned)r; }
__device__ __forceinline__ float row16_max(float v) {
    v = fmaxf(v, __builtin_bit_cast(float, __builtin_amdgcn_update_dpp(0, __builtin_bit_cast(int, v), 0xB1, 0xF, 0xF, true)));
    v = fmaxf(v, __builtin_bit_cast(float, __builtin_amdgcn_update_dpp(0, __builtin_bit_cast(int, v), 0x4E, 0xF, 0xF, true)));
    v = fmaxf(v, __builtin_bit_cast(float, __builtin_amdgcn_update_dpp(0, __builtin_bit_cast(int, v), 0x141, 0xF, 0xF, true)));
    v = fmaxf(v, __builtin_bit_cast(float, __builtin_amdgcn_update_dpp(0, __builtin_bit_cast(int, v), 0x140, 0xF, 0xF, true)));
    return v;
}
__device__ __forceinline__ float row16_sum(float v) {
    v += __builtin_bit_cast(float, __builtin_amdgcn_update_dpp(0, __builtin_bit_cast(int, v), 0xB1, 0xF, 0xF, true));
    v += __builtin_bit_cast(float, __builtin_amdgcn_update_dpp(0, __builtin_bit_cast(int, v), 0x4E, 0xF, 0xF, true));
    v += __builtin_bit_cast(float, __builtin_amdgcn_update_dpp(0, __builtin_bit_cast(int, v), 0x141, 0xF, 0xF, true));
    v += __builtin_bit_cast(float, __builtin_amdgcn_update_dpp(0, __builtin_bit_cast(int, v), 0x140, 0xF, 0xF, true));
    return v;
}
__device__ __forceinline__ float wave_sum(float v) { v = row16_sum(v); v += __shfl_xor(v, 16); v += __shfl_xor(v, 32); return v; }
#define LDS_WAIT() asm volatile("s_waitcnt lgkmcnt(0)" ::: "memory")
#define MFMA16(a, b, c) __builtin_amdgcn_mfma_f32_16x16x32_bf16((a), (b), (c), 0, 0, 0)

__device__ __forceinline__ int win_remap(int n) { return n < 6144 ? n : (n < 6160 ? 12288 + (n - 6144) : n - 16); }
__device__ __forceinline__ void transpose_item(const float* W, int K, int N, int ld, bf16_t* WT, unsigned* T, int item, int lane, bool remap) {
    const int nblk = (N + 63) >> 6, kb = item / nblk, nb = item - kb * nblk, k0 = 64 * kb, n0 = 64 * nb;
    const int r4 = lane >> 4, cc = lane & 15, nn = n0 + 4 * cc; const bool ok = nn < N;
    float4 v[16];
#pragma unroll
    for (int jj = 0; jj < 8; ++jj)
#pragma unroll
        for (int bb = 0; bb < 2; ++bb) { const int kk = 8 * jj + 2 * r4 + bb; v[2 * jj + bb] = ok ? *(const float4*)(W + (size_t)(k0 + kk) * ld + nn) : make_float4(0.f, 0.f, 0.f, 0.f); }
#pragma unroll
    for (int jj = 0; jj < 8; ++jj) { const float4 a = v[2 * jj], bq = v[2 * jj + 1]; const int kw = 4 * jj + r4;
        T[(4 * cc + 0) * 33 + kw] = cvt_pk_bf16(a.x, bq.x); T[(4 * cc + 1) * 33 + kw] = cvt_pk_bf16(a.y, bq.y);
        T[(4 * cc + 2) * 33 + kw] = cvt_pk_bf16(a.z, bq.z); T[(4 * cc + 3) * 33 + kw] = cvt_pk_bf16(a.w, bq.w); }
    LDS_WAIT();
    const int kc = lane & 7;
#pragma unroll
    for (int jr = 0; jr < 8; ++jr) { const int n = (lane >> 3) + 8 * jr, ns = n0 + n; const unsigned* tp = T + n * 33 + 4 * kc;
        uint4 o; o.x = tp[0]; o.y = tp[1]; o.z = tp[2]; o.w = tp[3];
        if (ns < N) { const int nd = remap ? win_remap(ns) : ns; *(uint4*)(WT + (size_t)nd * K + k0 + 8 * kc) = o; } }
    LDS_WAIT();
}
__device__ __forceinline__ void transpose_item8(const float* W, int K, int N, int ld, unsigned char* WT, unsigned* T, int item, int lane, float sc) {
    const int nblk = (N + 63) >> 6, kb = item / nblk, nb = item - kb * nblk, k0 = 64 * kb, n0 = 64 * nb;
    const int r4 = lane >> 4, cc = lane & 15, nn = n0 + 4 * cc;
    float4 v[16];
#pragma unroll
    for (int jj = 0; jj < 4; ++jj)
#pragma unroll
        for (int bb = 0; bb < 4; ++bb) { const int kk = 16 * jj + 4 * r4 + bb; v[4 * jj + bb] = *(const float4*)(W + (size_t)(k0 + kk) * ld + nn); }
#pragma unroll
    for (int jj = 0; jj < 4; ++jj) { const float4 a = v[4 * jj], b = v[4 * jj + 1], c = v[4 * jj + 2], d = v[4 * jj + 3]; const int kw = 4 * jj + r4;
        T[(4 * cc + 0) * 17 + kw] = pk4_fp8(a.x * sc, b.x * sc, c.x * sc, d.x * sc); T[(4 * cc + 1) * 17 + kw] = pk4_fp8(a.y * sc, b.y * sc, c.y * sc, d.y * sc);
        T[(4 * cc + 2) * 17 + kw] = pk4_fp8(a.z * sc, b.z * sc, c.z * sc, d.z * sc); T[(4 * cc + 3) * 17 + kw] = pk4_fp8(a.w * sc, b.w * sc, c.w * sc, d.w * sc); }
    LDS_WAIT();
    const int kc = lane & 3;
#pragma unroll
    for (int jr = 0; jr < 4; ++jr) { const int n = (lane >> 2) + 16 * jr; const unsigned* tp = T + n * 17 + 4 * kc;
        uint4 o; o.x = tp[0]; o.y = tp[1]; o.z = tp[2]; o.w = tp[3];
        *(uint4*)(WT + (size_t)(n0 + n) * K + k0 + 16 * kc) = o; }
    LDS_WAIT();
}
template <bool F8OUT> __device__ __forceinline__ void rms_row(const float* xrow, const float* g, bf16_t* orow, unsigned* orow8, int lane) {
    const float4* xr = (const float4*)xrow + lane; float4 v[16]; float s = 0.f;
#pragma unroll
    for (int j = 0; j < 16; ++j) { v[j] = xr[64 * j]; s += (v[j].x * v[j].x + v[j].y * v[j].y) + (v[j].z * v[j].z + v[j].w * v[j].w); }
    const float r = rsqrtf(wave_sum(s) * (1.f / DM) + 1e-6f);
    const float4* gr = (const float4*)g + lane; uint2* o8 = (uint2*)orow + lane;
#pragma unroll
    for (int j = 0; j < 16; ++j) { const float4 gg = gr[64 * j]; const float y0 = (v[j].x * r) * gg.x, y1 = (v[j].y * r) * gg.y, y2 = (v[j].z * r) * gg.z, y3 = (v[j].w * r) * gg.w;
        uint2 o; o.x = cvt_pk_bf16(y0, y1); o.y = cvt_pk_bf16(y2, y3); o8[64 * j] = o;
        if (F8OUT) orow8[64 * j + lane] = pk4_fp8(y0 * SC_X, y1 * SC_X, y2 * SC_X, y3 * SC_X); }
}
__device__ __forceinline__ void phase_prep(const Params& p, unsigned char* sm) {
    const int tid = threadIdx.x, lane = tid & 63, w = tid >> 6;
    unsigned* scr = (unsigned*)(sm + w * 8704);
    const int gw = blockIdx.x * 8 + w, NGW = gridDim.x * 8;
    constexpr int I_WIN = 64 * 97, I_WIN8 = 64 * 96, I_WOUT = 64 * 64, I_WPQ = 64 * 32, I_PV = 256 * 64, I_PU = NEXP, I_X = NTOK;
    constexpr int NITEMS = I_WIN + I_WIN8 + I_WOUT + I_WPQ + I_PV + I_PU + I_X;
    bf16_t* WinT = (bf16_t*)(p.ws + WS_WINT); bf16_t* WoutT = (bf16_t*)(p.ws + WS_WOUTT); bf16_t* WpqT = (bf16_t*)(p.ws + WS_WPQT);
    unsigned* UB8 = (unsigned*)(p.ws + WS_UB); unsigned char* VTB8 = p.ws + WS_VTB; bf16_t* HB = (bf16_t*)(p.ws + WS_HB);
    { unsigned* KH = (unsigned*)(p.ws + WS_KH); unsigned* KL = (unsigned*)(p.ws + WS_KL);
      for (int i = blockIdx.x * 512 + tid; i < 8 * 2 * 128 * 128 / 2; i += gridDim.x * 512) { const float2 v = ((const float2*)p.pkeys)[i];
          const unsigned h = cvt_pk_bf16(v.x, v.y); KH[i] = h; KL[i] = cvt_pk_bf16(v.x - bf2f(h & 0xffff), v.y - bf2f(h >> 16)); } }
    for (int it = gw; it < NITEMS; it += NGW) {
        int r = it;
        if (r < I_X) { rms_row<true>(p.x + (size_t)r * DM, p.g1, HB + (size_t)r * DM, (unsigned*)(p.ws + WS_HB8) + (size_t)r * (DM / 4), lane); continue; } r -= I_X;
        if (r < I_WIN) { transpose_item(p.win, DM, 6160, NIN, WinT, scr, r, lane, true); continue; } r -= I_WIN;
        if (r < I_WIN8) { transpose_item8(p.win + 6160, DM, 6144, NIN, p.ws + WS_WINT8, scr, r, lane, SC_U); continue; } r -= I_WIN8;
        if (r < I_WOUT) { transpose_item(p.wout, DM, DM, DM, WoutT, scr, r, lane, false); continue; } r -= I_WOUT;
        if (r < I_WPQ) { transpose_item(p.wpq, DM, 2048, 2048, WpqT, scr, r, lane, false); continue; } r -= I_WPQ;
        if (r < I_PV) { transpose_item8(p.pv, NEXP, DM, DM, VTB8, scr, r, lane, SC_V); continue; } r -= I_PV;
        { const float4* src = (const float4*)(p.pu + (size_t)r * DM) + lane; unsigned* dst = UB8 + (size_t)r * (DM / 4) + lane;
          float4 v[16];
#pragma unroll
          for (int j = 0; j < 16; ++j) v[j] = src[64 * j];
#pragma unroll
          for (int j = 0; j < 16; ++j) dst[64 * j] = pk4_fp8(v[j].x * SC_U, v[j].y * SC_U, v[j].z * SC_U, v[j].w * SC_U); }
    }
}

struct EpiProj {
    static constexpr bool PERM = true, AFTER_DRAIN = false;
    bf16_t* P; int coff; float sc;
    __device__ __forceinline__ void operator()(const f32x4 (&acc)[2][2][4][2], const Unit& u, int wr, int wc, int fr, int fq) const {
        const int row0 = u.pm * 256 + wr * 64 + fr, col0 = coff + u.pn * 256 + wc * 32 + 8 * fq;
#pragma unroll
        for (int ai = 0; ai < 2; ++ai)
#pragma unroll
            for (int m = 0; m < 4; ++m) { bf16_t* rowp = P + (size_t)(row0 + ai * 128 + m * 16) * PROJW + col0;
#pragma unroll
                for (int bj = 0; bj < 2; ++bj) { const f32x4 v0 = acc[ai][bj][m][0] * sc, v1 = acc[ai][bj][m][1] * sc;
                    uint4 o; o.x = cvt_pk_bf16(v0[0], v0[1]); o.y = cvt_pk_bf16(v0[2], v0[3]); o.z = cvt_pk_bf16(v1[0], v1[1]); o.w = cvt_pk_bf16(v1[2], v1[3]);
                    *(uint4*)(rowp + bj * 128) = o; } }
    }
};
struct EpiRes {
    static constexpr bool PERM = false, AFTER_DRAIN = false;
    float* C; const float* R; int ldc;
    __device__ __forceinline__ void operator()(const f32x4 (&acc)[2][2][4][2], const Unit& u, int wr, int wc, int fr, int fq) const {
        const int row0 = u.pm * 256 + wr * 64 + fr, col0 = u.pn * 256 + wc * 32 + 4 * fq;
#pragma unroll
        for (int ai = 0; ai < 2; ++ai)
#pragma unroll
            for (int m = 0; m < 4; ++m) { const size_t ro = (size_t)(row0 + ai * 128 + m * 16) * ldc + col0;
#pragma unroll
                for (int bj = 0; bj < 2; ++bj)
#pragma unroll
                    for (int n = 0; n < 2; ++n) { const f32x4 r = *(const f32x4*)(R + ro + bj * 128 + n * 16); *(f32x4*)(C + ro + bj * 128 + n * 16) = r + acc[ai][bj][m][n]; } }
    }
};
struct EpiF32 {
    static constexpr bool PERM = false, AFTER_DRAIN = false;
    float* C; int ldc;
    __device__ __forceinline__ void operator()(const f32x4 (&acc)[2][2][4][2], const Unit& u, int wr, int wc, int fr, int fq) const {
        const int row0 = u.pm * 256 + wr * 64 + fr, col0 = u.pn * 256 + wc * 32 + 4 * fq;
#pragma unroll
        for (int ai = 0; ai < 2; ++ai)
#pragma unroll
            for (int m = 0; m < 4; ++m) { float* rowp = C + (size_t)(row0 + ai * 128 + m * 16) * ldc + col0;
#pragma unroll
                for (int bj = 0; bj < 2; ++bj)
#pragma unroll
                    for (int n = 0; n < 2; ++n) *(f32x4*)(rowp + bj * 128 + n * 16) = acc[ai][bj][m][n]; }
    }
};
struct EpiResSc {
    static constexpr bool PERM = false, AFTER_DRAIN = false;
    float* C; const float* R; int ldc; float sc;
    __device__ __forceinline__ void operator()(const f32x4 (&acc)[2][2][4][2], const Unit& u, int wr, int wc, int fr, int fq) const {
        const int row0 = u.pm * 256 + wr * 64 + fr, col0 = u.pn * 256 + wc * 32 + 4 * fq;
#pragma unroll
        for (int ai = 0; ai < 2; ++ai)
#pragma unroll
            for (int m = 0; m < 4; ++m) { const size_t ro = (size_t)(row0 + ai * 128 + m * 16) * ldc + col0;
#pragma unroll
                for (int bj = 0; bj < 2; ++bj)
#pragma unroll
                    for (int n = 0; n < 2; ++n) { const f32x4 r = *(const f32x4*)(R + ro + bj * 128 + n * 16); *(f32x4*)(C + ro + bj * 128 + n * 16) = r + acc[ai][bj][m][n] * sc; } }
    }
};
constexpr float SC_G = 128.f;
struct EpiPeerW8 {
    static constexpr bool PERM = true, AFTER_DRAIN = false;
    const unsigned char* Gw; unsigned char* W8;
    __device__ __forceinline__ void operator()(const f32x4 (&acc)[2][2][4][2], const Unit& u, int wr, int wc, int fr, int fq) const {
        const int row0 = u.pm * 256 + wr * 64 + fr, col0 = u.pn * 256 + wc * 32 + 8 * fq; constexpr float isc = 1.f / (SC_X * SC_U), gsc = SC_W / SC_G;
#pragma unroll
        for (int ai = 0; ai < 2; ++ai)
#pragma unroll
            for (int m = 0; m < 4; ++m) { const size_t ro = (size_t)(row0 + ai * 128 + m * 16) * NEXP + col0;
#pragma unroll
                for (int bj = 0; bj < 2; ++bj) { const uint2 gv = *(const uint2*)(Gw + ro + bj * 128); uint2 o = make_uint2(0u, 0u);
                    if ((gv.x | gv.y) != 0u) {
                        const f32x4 v0 = acc[ai][bj][m][0] * isc, v1 = acc[ai][bj][m][1] * isc;
                        const f32x2 a = pg8::gelu_pk((f32x2){v0[0], v0[1]}), b = pg8::gelu_pk((f32x2){v0[2], v0[3]}), c = pg8::gelu_pk((f32x2){v1[0], v1[1]}), d = pg8::gelu_pk((f32x2){v1[2], v1[3]});
                        const int gx = (int)gv.x, gy = (int)gv.y;
                        o.x = pk4_fp8(a.x * __builtin_amdgcn_cvt_f32_fp8(gx, 0) * gsc, a.y * __builtin_amdgcn_cvt_f32_fp8(gx, 1) * gsc, b.x * __builtin_amdgcn_cvt_f32_fp8(gx, 2) * gsc, b.y * __builtin_amdgcn_cvt_f32_fp8(gx, 3) * gsc);
                        o.y = pk4_fp8(c.x * __builtin_amdgcn_cvt_f32_fp8(gy, 0) * gsc, c.y * __builtin_amdgcn_cvt_f32_fp8(gy, 1) * gsc, d.x * __builtin_amdgcn_cvt_f32_fp8(gy, 2) * gsc, d.y * __builtin_amdgcn_cvt_f32_fp8(gy, 3) * gsc); }
                    *(uint2*)(W8 + ro + bj * 128) = o; } }
    }
};

constexpr float QSCALE = 0.08838834764831845f * 1.4426950408889634f;
__device__ __forceinline__ void moba_prep_item(const Params& p, unsigned char* sm, int item) {
    const int tid = threadIdx.x, lane = tid & 63, w = tid >> 6;
    const int blk = item & 7, h = (item >> 3) & 15, b = item >> 7, bh = b * 16 + h;
    const bf16_t* proj = (const bf16_t*)(p.ws + WS_PROJ);
    bf16_t* QN = (bf16_t*)(p.ws + WS_QN); bf16_t* KN = (bf16_t*)(p.ws + WS_KN); bf16_t* VTM = (bf16_t*)(p.ws + WS_VTM); float* KM = (float*)(p.ws + WS_KM);
    bf16_t* VL = (bf16_t*)sm;
    float* KMS = (float*)(sm + 67584);
    const int d0 = 2 * lane;
    const float gq0 = p.qng[d0], gq1 = p.qng[d0 + 1], gk0 = p.kng[d0], gk1 = p.kng[d0 + 1];
    const int fi = d0 & 15;
    const float inv0 = exp2f(-(float)fi * (18.931568569324174f / 16.f)), inv1 = exp2f(-(float)(fi + 1) * (18.931568569324174f / 16.f));
    float km0 = 0.f, km1 = 0.f;
    __syncthreads();
    for (int t4 = 0; t4 < 32; t4 += 4) {
        unsigned qva[4], kva[4], vva[4];
#pragma unroll
        for (int u = 0; u < 4; ++u) { const int tt = w + 8 * (t4 + u); const bf16_t* pr = proj + ((size_t)b * SEQL + blk * 256 + tt) * PROJW;
            qva[u] = *(const unsigned*)(pr + 6144 + h * 128 + d0); kva[u] = *(const unsigned*)(pr + 8192 + h * 128 + d0); vva[u] = *(const unsigned*)(pr + 10240 + h * 128 + d0); }
#pragma unroll
        for (int u = 0; u < 4; ++u) { const int tt = w + 8 * (t4 + u); const int pos = blk * 256 + tt; const unsigned qv = qva[u], kv = kva[u], vv = vva[u];
        float q0 = bf2f(qv & 0xffff), q1 = bf2f(qv >> 16), k0 = bf2f(kv & 0xffff), k1 = bf2f(kv >> 16);
        const float rq = rsqrtf(wave_sum(q0 * q0 + q1 * q1) * (1.f / 128.f) + 1e-6f), rk = rsqrtf(wave_sum(k0 * k0 + k1 * k1) * (1.f / 128.f) + 1e-6f);
        q0 = (q0 * rq) * gq0; q1 = (q1 * rq) * gq1; k0 = (k0 * rk) * gk0; k1 = (k1 * rk) * gk1;
        const float pq0 = __shfl_xor(q0, 8), pq1 = __shfl_xor(q1, 8), pk0 = __shfl_xor(k0, 8), pk1 = __shfl_xor(k1, 8);
        if (lane < 16) {
            float a0 = (float)pos * inv0, a1 = (float)pos * inv1;
            float n0 = rintf(a0 * 0.15915494309189535f), n1 = rintf(a1 * 0.15915494309189535f);
            a0 = fmaf(-n0, 6.2831854820251465f, a0); a0 = fmaf(-n0, -1.7484555e-7f, a0);
            a1 = fmaf(-n1, 6.2831854820251465f, a1); a1 = fmaf(-n1, -1.7484555e-7f, a1);
            const float c0 = __cosf(a0), s0 = __sinf(a0), c1 = __cosf(a1), s1 = __sinf(a1);
            if (lane < 8) { q0 = q0 * c0 - pq0 * s0; q1 = q1 * c1 - pq1 * s1; k0 = k0 * c0 - pk0 * s0; k1 = k1 * c1 - pk1 * s1; }
            else          { q0 = q0 * c0 + pq0 * s0; q1 = q1 * c1 + pq1 * s1; k0 = k0 * c0 + pk0 * s0; k1 = k1 * c1 + pk1 * s1; }
        }
        km0 += k0; km1 += k1;
        const size_t o = ((size_t)bh * SEQL + pos) * 128 + d0;
        *(unsigned*)(QN + o) = cvt_pk_bf16(q0 * QSCALE, q1 * QSCALE);
        *(unsigned*)(KN + o) = cvt_pk_bf16(k0, k1);
        VL[d0 * 264 + tt] = (bf16_t)(vv & 0xffff); VL[(d0 + 1) * 264 + tt] = (bf16_t)(vv >> 16);
        } }
    KMS[w * 128 + d0] = km0; KMS[w * 128 + d0 + 1] = km1;
    __syncthreads();
    if (tid < 128) { float s = 0.f;
#pragma unroll
        for (int i = 0; i < 8; ++i) s += KMS[i * 128 + tid];
        KM[((size_t)bh * 8 + blk) * 128 + tid] = s * (1.f / 256.f); }
    for (int c = tid; c < 128 * 32; c += 512) { const int d = c >> 5, c8 = (c & 31) * 8;
        *(uint4*)(VTM + ((size_t)bh * 128 + d) * SEQL + blk * 256 + c8) = *(const uint4*)(VL + d * 264 + c8); }
}

__device__ __forceinline__ void glr_job(const Params& p, int job, int lane) {
    const int fr = lane & 15, fq = lane >> 4;
    const bf16_t* a = (const bf16_t*)(p.ws + WS_HB) + (size_t)(job * 16 + fr) * DM + fq * 8;
    const bf16_t* b = (const bf16_t*)(p.ws + WS_WINT) + (size_t)(12288 + fr) * DM + fq * 8;
    f32x4 acc0 = (f32x4){0.f, 0.f, 0.f, 0.f}, acc1 = acc0;
#pragma unroll 4
    for (int ks = 0; ks < 128; ks += 2) { const bf16x8 a0 = *(const bf16x8*)(a + ks * 32), b0 = *(const bf16x8*)(b + ks * 32), a1 = *(const bf16x8*)(a + ks * 32 + 32), b1 = *(const bf16x8*)(b + ks * 32 + 32);
        acc0 = MFMA16(a0, b0, acc0); acc1 = MFMA16(a1, b1, acc1); }
    float* glr = (float*)(p.ws + WS_GLR);
#pragma unroll
    for (int j = 0; j < 4; ++j) glr[(size_t)(job * 16 + fq * 4 + j) * 16 + fr] = acc0[j] + acc1[j];
}

constexpr size_t WS_GQD = WS_VTB + 64 * MiB, WS_GKI = WS_GQD + 16 * MiB, WS_GKST = WS_GKI + 16 * MiB, WS_GDEC = WS_GKST + 16 * MiB, WS_GVT = WS_HB8;
constexpr int GP_BC = 0, GP_GLR = 32768, GP_TOT = 36864, GP_KST = 38912, GP_VT = 57344;
__device__ __forceinline__ void gla_prep_item(const Params& p, unsigned char* sm, int item) {
    const int tid = threadIdx.x;
    const int h = item & 7, ch = item >> 3, t0 = ch * 64;
    float* BC = (float*)(sm + GP_BC); float* GLR = (float*)(sm + GP_GLR); float* TOT = (float*)(sm + GP_TOT); bf16_t* KST = (bf16_t*)(sm + GP_KST); bf16_t* VT = (bf16_t*)(sm + GP_VT);
    const bf16_t* proj = (const bf16_t*)(p.ws + WS_PROJ); const float* glr = (const float*)(p.ws + WS_GLR);
    bf16_t* QDg = (bf16_t*)(p.ws + WS_GQD) + (size_t)item * 8192; bf16_t* KIg = (bf16_t*)(p.ws + WS_GKI) + (size_t)item * 8192;
    bf16_t* KSTg = (bf16_t*)(p.ws + WS_GKST) + (size_t)item * 8192; bf16_t* VTg = (bf16_t*)(p.ws + WS_GVT) + (size_t)item * 16384; float* DECg = (float*)(p.ws + WS_GDEC) + (size_t)item * 128;
    __syncthreads();
    if (tid < 256) ((float4*)GLR)[tid] = ((const float4*)(glr + (size_t)t0 * 16))[tid];
    float wcol[16];
#pragma unroll
    for (int r = 0; r < 16; ++r) wcol[r] = p.wgu[r * 1024 + h * 128 + (tid & 127)];
    const float bias = p.bg[h * 128 + (tid & 127)];
    __syncthreads();
    {   const int d = tid & 127, part = tid >> 7; float la[16]; float run = 0.f;
#pragma unroll
        for (int i = 0; i < 16; ++i) { const float* gr = GLR + (part * 16 + i) * 16; float z = bias;
#pragma unroll
            for (int r = 0; r < 16; ++r) z = fmaf(gr[r], wcol[r], z);
            const float ls = fminf(z, 0.f) - __logf(1.f + __expf(-fabsf(z)));
            run += ls * (1.f / 16.f); la[i] = run; }
        TOT[part * 128 + d] = run;
        __syncthreads();
        float off = 0.f;
        for (int pp = 0; pp < part; ++pp) off += TOT[pp * 128 + d];
#pragma unroll
        for (int i = 0; i < 16; ++i) BC[(part * 16 + i) * 128 + d] = la[i] + off;
    }
    __syncthreads();
    if (tid < 128) DECg[tid] = __expf(BC[63 * 128 + tid]);
    for (int c = tid; c < 1024; c += 512) { const int s = c >> 4, dd = (c & 15) * 8;
        const bf16_t* pr = proj + (size_t)(t0 + s) * PROJW + h * 128 + dd;
        const uint4 qv = *(const uint4*)pr, kv = *(const uint4*)(pr + 1024);
        const unsigned qa[4] = {qv.x, qv.y, qv.z, qv.w}, ka[4] = {kv.x, kv.y, kv.z, kv.w};
        unsigned qo[4], ko[4];
#pragma unroll
        for (int i = 0; i < 4; ++i) {
            const float bc0 = BC[s * 128 + dd + 2 * i], bc1 = BC[s * 128 + dd + 2 * i + 1], bl0 = BC[63 * 128 + dd + 2 * i], bl1 = BC[63 * 128 + dd + 2 * i + 1];
            const float q0 = bf2f(qa[i] & 0xffff), q1 = bf2f(qa[i] >> 16), k0 = bf2f(ka[i] & 0xffff), k1 = bf2f(ka[i] >> 16);
            qo[i] = cvt_pk_bf16(q0 * 0.08838834764831845f * __expf(bc0), q1 * 0.08838834764831845f * __expf(bc1));
            ko[i] = cvt_pk_bf16(k0 * __expf(-bc0), k1 * __expf(-bc1));
            KST[(dd + 2 * i) * 72 + s] = f2bf(k0 * __expf(bl0 - bc0)); KST[(dd + 2 * i + 1) * 72 + s] = f2bf(k1 * __expf(bl1 - bc1)); }
        *(uint4*)(QDg + s * 128 + dd) = make_uint4(qo[0], qo[1], qo[2], qo[3]); *(uint4*)(KIg + s * 128 + dd) = make_uint4(ko[0], ko[1], ko[2], ko[3]); }
    for (int c = tid; c < 2048; c += 512) { const int s = c >> 5, e0 = (c & 31) * 8;
        const uint4 vv = *(const uint4*)(proj + (size_t)(t0 + s) * PROJW + 2048 + h * 256 + e0);
        const unsigned va[4] = {vv.x, vv.y, vv.z, vv.w};
#pragma unroll
        for (int i = 0; i < 4; ++i) { VT[(e0 + 2 * i) * 72 + s] = (bf16_t)(va[i] & 0xffff); VT[(e0 + 2 * i + 1) * 72 + s] = (bf16_t)(va[i] >> 16); } }
    __syncthreads();
    for (int c = tid; c < 1024; c += 512) { const int d = c >> 3, c8 = (c & 7) * 8; *(uint4*)(KSTg + d * 64 + c8) = *(const uint4*)(KST + d * 72 + c8); }
    for (int c = tid; c < 2048; c += 512) { const int e = c >> 3, c8 = (c & 7) * 8; *(uint4*)(VTg + e * 64 + c8) = *(const uint4*)(VT + e * 72 + c8); }
}
constexpr int GL_QD = 0, GL_KI = 17408, GL_KST = 34816, GL_VT = 53248, GL_ATT = 62464, GL_ST = 71680;
__device__ __forceinline__ void gla_item(const Params& p, unsigned char* sm, int item) {
    const int tid = threadIdx.x, lane = tid & 63, w = tid >> 6, fr = lane & 15, fq = lane >> 4;
    const int dvs = item & 3, h = (item >> 2) & 7, b = item >> 5;
    bf16_t* QD = (bf16_t*)(sm + GL_QD); bf16_t* KI = (bf16_t*)(sm + GL_KI); bf16_t* KST = (bf16_t*)(sm + GL_KST); bf16_t* VT = (bf16_t*)(sm + GL_VT);
    bf16_t* ATT = (bf16_t*)(sm + GL_ATT); bf16_t* ST = (bf16_t*)(sm + GL_ST);
    float* OG = (float*)(p.ws + WS_OG);
    const bf16_t* QDg = (const bf16_t*)(p.ws + WS_GQD); const bf16_t* KIg = (const bf16_t*)(p.ws + WS_GKI); const bf16_t* KSTg = (const bf16_t*)(p.ws + WS_GKST);
    const bf16_t* VTg = (const bf16_t*)(p.ws + WS_GVT); const float* DECg = (const float*)(p.ws + WS_GDEC);
    __syncthreads();
    for (int i = tid; i < 64 * 136 / 2; i += 512) ((unsigned*)ST)[i] = 0u;
    f32x4 Sacc[4];
#pragma unroll
    for (int i = 0; i < 4; ++i) Sacc[i] = (f32x4){0.f, 0.f, 0.f, 0.f};
    uint4 rq0, rq1, rk0, rk1, rs0, rs1, rv; float rd0, rd1, rd2, rd3;
#define GLA_FETCH(n_) do { const size_t it_ = (size_t)((b * 32 + (n_)) * 8 + h); \
        rq0 = *(const uint4*)(QDg + it_ * 8192 + tid * 8); rq1 = *(const uint4*)(QDg + it_ * 8192 + (tid + 512) * 8); \
        rk0 = *(const uint4*)(KIg + it_ * 8192 + tid * 8); rk1 = *(const uint4*)(KIg + it_ * 8192 + (tid + 512) * 8); \
        rs0 = *(const uint4*)(KSTg + it_ * 8192 + tid * 8); rs1 = *(const uint4*)(KSTg + it_ * 8192 + (tid + 512) * 8); \
        rv = *(const uint4*)(VTg + it_ * 16384 + (size_t)(dvs * 64) * 64 + tid * 8); \
        const float* dp_ = DECg + it_ * 128 + w * 16 + fq * 4; rd0 = dp_[0]; rd1 = dp_[1]; rd2 = dp_[2]; rd3 = dp_[3]; } while (0)
    GLA_FETCH(0);
    for (int n = 0; n < 32; ++n) {
        const int t0 = b * SEQL + n * 64;
        __syncthreads();
        { const int c0 = tid, c1 = tid + 512;
          *(uint4*)(QD + (c0 >> 4) * 136 + (c0 & 15) * 8) = rq0; *(uint4*)(QD + (c1 >> 4) * 136 + (c1 & 15) * 8) = rq1;
          *(uint4*)(KI + (c0 >> 4) * 136 + (c0 & 15) * 8) = rk0; *(uint4*)(KI + (c1 >> 4) * 136 + (c1 & 15) * 8) = rk1;
          *(uint4*)(KST + (c0 >> 3) * 72 + (c0 & 7) * 8) = rs0; *(uint4*)(KST + (c1 >> 3) * 72 + (c1 & 7) * 8) = rs1;
          *(uint4*)(VT + (tid >> 3) * 72 + (tid & 7) * 8) = rv; }
        const float dec[4] = {rd0, rd1, rd2, rd3};
        __syncthreads();
        if (n + 1 < 32) GLA_FETCH(n + 1);
        f32x4 oacc[2];
#pragma unroll
        for (int ti = 0; ti < 2; ++ti) { const int tile = 2 * w + ti, qt = tile >> 2, xt = tile & 3;
            f32x4 a = (f32x4){0.f, 0.f, 0.f, 0.f}, o = (f32x4){0.f, 0.f, 0.f, 0.f};
#pragma unroll
            for (int ks = 0; ks < 4; ++ks) { const bf16x8 af = *(const bf16x8*)(QD + (qt * 16 + fr) * 136 + ks * 32 + fq * 8);
                const bf16x8 bk = *(const bf16x8*)(KI + (xt * 16 + fr) * 136 + ks * 32 + fq * 8), bs = *(const bf16x8*)(ST + (xt * 16 + fr) * 136 + ks * 32 + fq * 8);
                a = MFMA16(af, bk, a); o = MFMA16(af, bs, o); }
#pragma unroll
            for (int j = 0; j < 4; ++j) { const int qq = qt * 16 + fq * 4 + j, ss = xt * 16 + fr; ATT[qq * 72 + ss] = f2bf(ss <= qq ? a[j] : 0.f); }
            oacc[ti] = o; }
        __syncthreads();
#pragma unroll
        for (int ti = 0; ti < 2; ++ti) { const int tile = 2 * w + ti, qt = tile >> 2, et = tile & 3; f32x4 o = oacc[ti];
#pragma unroll
            for (int ks = 0; ks < 2; ++ks) { const bf16x8 af = *(const bf16x8*)(ATT + (qt * 16 + fr) * 72 + ks * 32 + fq * 8), bv = *(const bf16x8*)(VT + (et * 16 + fr) * 72 + ks * 32 + fq * 8); o = MFMA16(af, bv, o); }
#pragma unroll
            for (int j = 0; j < 4; ++j) OG[(size_t)(t0 + qt * 16 + fq * 4 + j) * 2048 + h * 256 + dvs * 64 + et * 16 + fr] = o[j]; }
#pragma unroll
        for (int et = 0; et < 4; ++et) { f32x4 sv = Sacc[et];
#pragma unroll
            for (int j = 0; j < 4; ++j) sv[j] *= dec[j];
#pragma unroll
            for (int ks = 0; ks < 2; ++ks) { const bf16x8 af = *(const bf16x8*)(KST + (w * 16 + fr) * 72 + ks * 32 + fq * 8), bv = *(const bf16x8*)(VT + (et * 16 + fr) * 72 + ks * 32 + fq * 8); sv = MFMA16(af, bv, sv); }
            Sacc[et] = sv;
            uint2 pk; pk.x = cvt_pk_bf16(sv[0], sv[1]); pk.y = cvt_pk_bf16(sv[2], sv[3]);
            *(uint2*)(ST + (et * 16 + fr) * 136 + w * 16 + fq * 4) = pk; }
    }
}

constexpr int MB_KT = 0, MB_VT = 17408, MB_P = 35840, MB_MISC = 54272;
__device__ __forceinline__ void moba_item(const Params& p, unsigned char* sm, int item) {
    const int tid = threadIdx.x, lane = tid & 63, w = tid >> 6, fr = lane & 15, fq = lane >> 4;
    const int qt = 15 - (item >> 6), bh = item & 63, b = bh >> 4, h = bh & 15, q0 = qt * 128, blk = qt >> 1;
    const bf16_t* QNp = (const bf16_t*)(p.ws + WS_QN) + (size_t)bh * SEQL * 128; const bf16_t* KNp = (const bf16_t*)(p.ws + WS_KN) + (size_t)bh * SEQL * 128;
    const bf16_t* VTp = (const bf16_t*)(p.ws + WS_VTM) + (size_t)bh * 128 * SEQL; const float* KMp = (const float*)(p.ws + WS_KM) + (size_t)bh * 8 * 128;
    bf16_t* MIX = (bf16_t*)(p.ws + WS_MIX);
    bf16_t* KT = (bf16_t*)(sm + MB_KT); bf16_t* VT = (bf16_t*)(sm + MB_VT); bf16_t* Pw = (bf16_t*)(sm + MB_P) + w * 16 * 72; unsigned* bm = (unsigned*)(sm + MB_MISC);
    float* KMS = (float*)(sm + MB_MISC + 1024);
    __syncthreads();
    if (tid < blk * 32) ((float4*)KMS)[tid] = ((const float4*)KMp)[tid];
    if (tid == 0) *bm = 0u;
    __syncthreads();
    bf16x8 qf[4];
    { const bf16_t* qrow = QNp + (size_t)(q0 + w * 16 + fr) * 128;
#pragma unroll
      for (int ks = 0; ks < 4; ++ks) qf[ks] = *(const bf16x8*)(qrow + ks * 32 + fq * 8); }
    unsigned mask = 0u;
    { float g1 = -INFINITY, g2 = -INFINITY, g3 = -INFINITY; int i1 = -1, i2 = -1, i3 = -1;
      for (int n = 0; n < blk; ++n) { float part = 0.f;
#pragma unroll
          for (int ks = 0; ks < 4; ++ks) { const float* km = KMS + n * 128 + ks * 32 + fq * 8;
#pragma unroll
              for (int i = 0; i < 8; ++i) part = fmaf(bf2f((unsigned short)qf[ks][i]), km[i], part); }
          part += __shfl_xor(part, 16); part += __shfl_xor(part, 32);
          if (part > g1) { g3 = g2; i3 = i2; g2 = g1; i2 = i1; g1 = part; i1 = n; } else if (part > g2) { g3 = g2; i3 = i2; g2 = part; i2 = n; } else if (part > g3) { g3 = part; i3 = n; } }
      if (i1 >= 0) mask |= 1u << i1; if (i2 >= 0) mask |= 1u << i2; if (i3 >= 0) mask |= 1u << i3; }
    unsigned rm[4];
#pragma unroll
    for (int j = 0; j < 4; ++j) rm[j] = (unsigned)__shfl((int)mask, fq * 4 + j);
    { unsigned wm = mask;
#pragma unroll
      for (int o = 1; o < 16; o <<= 1) wm |= (unsigned)__shfl_xor((int)wm, o);
      if (lane == 0) atomicOr(bm, wm); }
    __syncthreads();
    const unsigned anym = *bm;
    f32x4 oacc[8];
#pragma unroll
    for (int i = 0; i < 8; ++i) oacc[i] = (f32x4){0.f, 0.f, 0.f, 0.f};
    float mrow[4] = {-1e30f, -1e30f, -1e30f, -1e30f}, lrow[4] = {0.f, 0.f, 0.f, 0.f};
    const int ntile = (q0 + 128) >> 6;
#define MB_NEXT(k_) do { while ((k_) < ntile && ((k_) >> 2) < blk && !((anym >> ((k_) >> 2)) & 1u)) ++(k_); } while (0)
    uint4 rka, rkb, rva, rvb;
#define MB_FETCH(k_) do { const int c0 = tid, c1 = tid + 512; \
        rka = *(const uint4*)(KNp + (size_t)((k_) * 64 + (c0 >> 4)) * 128 + (c0 & 15) * 8); rkb = *(const uint4*)(KNp + (size_t)((k_) * 64 + (c1 >> 4)) * 128 + (c1 & 15) * 8); \
        rva = *(const uint4*)(VTp + (size_t)(c0 >> 3) * SEQL + (k_) * 64 + (c0 & 7) * 8); rvb = *(const uint4*)(VTp + (size_t)(c1 >> 3) * SEQL + (k_) * 64 + (c1 & 7) * 8); } while (0)
    int kt = 0; MB_NEXT(kt);
    MB_FETCH(kt);
    while (kt < ntile) {
        const int kb = kt >> 2;
        __syncthreads();
        { const int c0 = tid, c1 = tid + 512, r0 = c0 >> 4, r1 = c1 >> 4;
          *(uint4*)(KT + ((r0 & 3) * 16 + (r0 >> 2)) * 136 + (c0 & 15) * 8) = rka; *(uint4*)(KT + ((r1 & 3) * 16 + (r1 >> 2)) * 136 + (c1 & 15) * 8) = rkb;
          *(uint4*)(VT + (c0 >> 3) * 72 + (c0 & 7) * 8) = rva; *(uint4*)(VT + (c1 >> 3) * 72 + (c1 & 7) * 8) = rvb; }
        __syncthreads();
        int nk = kt + 1; MB_NEXT(nk);
        if (nk < ntile) MB_FETCH(nk);
        f32x4 s[4];
#pragma unroll
        for (int g = 0; g < 4; ++g) { s[g] = (f32x4){0.f, 0.f, 0.f, 0.f};
#pragma unroll
            for (int ks = 0; ks < 4; ++ks) { const bf16x8 bk = *(const bf16x8*)(KT + (g * 16 + fr) * 136 + ks * 32 + fq * 8); s[g] = MFMA16(qf[ks], bk, s[g]); } }
        float alpha[4]; bool resc = false;
#pragma unroll
        for (int j = 0; j < 4; ++j) { const int qpos = q0 + w * 16 + fq * 4 + j; const bool past = kb < blk; const bool rowok = past ? (((rm[j] >> kb) & 1u) != 0u) : true;
            float mx = -1e30f;
#pragma unroll
            for (int g = 0; g < 4; ++g) { const int kpos = kt * 64 + 4 * fr + g; const bool ok = rowok && (past || kpos <= qpos); const float sv = ok ? s[g][j] : -1e30f; s[g][j] = sv; mx = fmaxf(mx, sv); }
            mx = row16_max(mx);
            const float mnew = fmaxf(mrow[j], mx); alpha[j] = __builtin_amdgcn_exp2f(mrow[j] - mnew); resc = resc || (mnew != mrow[j]); mrow[j] = mnew;
            float rs = 0.f;
#pragma unroll
            for (int g = 0; g < 4; ++g) { const float pv = __builtin_amdgcn_exp2f(s[g][j] - mnew); s[g][j] = pv; rs += pv; }
            lrow[j] = lrow[j] * alpha[j] + rs;
            uint2 pk; pk.x = cvt_pk_bf16(s[0][j], s[1][j]); pk.y = cvt_pk_bf16(s[2][j], s[3][j]);
            *(uint2*)(Pw + (fq * 4 + j) * 72 + 4 * fr) = pk; }
        if (__ballot(resc)) {
#pragma unroll
            for (int j = 0; j < 4; ++j)
#pragma unroll
                for (int dt = 0; dt < 8; ++dt) oacc[dt][j] *= alpha[j]; }
        LDS_WAIT();
        bf16x8 pf[2];
#pragma unroll
        for (int ks = 0; ks < 2; ++ks) pf[ks] = *(const bf16x8*)(Pw + fr * 72 + ks * 32 + fq * 8);
#pragma unroll
        for (int dt = 0; dt < 8; ++dt)
#pragma unroll
            for (int ks = 0; ks < 2; ++ks) { const bf16x8 bv = *(const bf16x8*)(VT + (dt * 16 + fr) * 72 + ks * 32 + fq * 8); oacc[dt] = MFMA16(pf[ks], bv, oacc[dt]); }
        kt = nk;
    }
    float inv[4];
#pragma unroll
    for (int j = 0; j < 4; ++j) inv[j] = 1.f / row16_sum(lrow[j]);
#pragma unroll
    for (int dt = 0; dt < 8; ++dt)
#pragma unroll
        for (int j = 0; j < 4; ++j) MIX[(size_t)(b * SEQL + q0 + w * 16 + fq * 4 + j) * DM + 2048 + h * 128 + dt * 16 + fr] = f2bf(oacc[dt][j] * inv[j]);
}

__device__ __forceinline__ void gla_final(const Params& p) {
    const int tid = threadIdx.x, lane = tid & 63, w = tid >> 6;
    const float* OG = (const float*)(p.ws + WS_OG); const bf16_t* proj = (const bf16_t*)(p.ws + WS_PROJ); bf16_t* MIX = (bf16_t*)(p.ws + WS_MIX);
    const float4 gn = ((const float4*)p.glang)[lane];
    for (int it = blockIdx.x * 8 + w; it < NTOK * 8; it += gridDim.x * 8) { const int t = it >> 3, h = it & 7;
        const float4 o = ((const float4*)(OG + (size_t)t * 2048 + h * 256))[lane];
        const float r = rsqrtf(wave_sum((o.x * o.x + o.y * o.y) + (o.z * o.z + o.w * o.w)) * (1.f / 256.f) + 1e-6f);
        const uint2 gv = ((const uint2*)(proj + (size_t)t * PROJW + 4096 + h * 256))[lane];
        const float g0 = bf2f(gv.x & 0xffff), g1 = bf2f(gv.x >> 16), g2 = bf2f(gv.y & 0xffff), g3 = bf2f(gv.y >> 16);
        const float y0 = ((o.x * r) * gn.x) * (g0 / (1.f + __expf(-g0))), y1 = ((o.y * r) * gn.y) * (g1 / (1.f + __expf(-g1)));
        const float y2 = ((o.z * r) * gn.z) * (g2 / (1.f + __expf(-g2))), y3 = ((o.w * r) * gn.w) * (g3 / (1.f + __expf(-g3)));
        uint2 ov; ov.x = cvt_pk_bf16(y0, y1); ov.y = cvt_pk_bf16(y2, y3);
        ((uint2*)(MIX + (size_t)t * DM + h * 256))[lane] = ov; }
}

template <int N> __device__ __forceinline__ void bitonic_desc(unsigned (&x)[N]) {
#pragma unroll
    for (int k = 2; k <= N; k <<= 1)
#pragma unroll
        for (int j = k >> 1; j > 0; j >>= 1)
#pragma unroll
            for (int i = 0; i < N; ++i) { const int l = i ^ j;
                if (l > i) { const unsigned a = x[i], b = x[l], mx = a > b ? a : b, mn = a > b ? b : a;
                    if ((i & k) == 0) { x[i] = mx; x[l] = mn; } else { x[i] = mn; x[l] = mx; } } }
}
__device__ __forceinline__ void merge16(unsigned (&x)[16], int mask) {
    unsigned y[16];
#pragma unroll
    for (int i = 0; i < 16; ++i) y[i] = (unsigned)__shfl_xor((int)x[15 - i], mask);
#pragma unroll
    for (int i = 0; i < 16; ++i) x[i] = x[i] > y[i] ? x[i] : y[i];
    bitonic_desc<16>(x);
}
__device__ __forceinline__ unsigned mono(float f) { const unsigned u = __float_as_uint(f); return (u & 0x80000000u) ? ~u : (u | 0x80000000u); }
__device__ __forceinline__ float unmono(unsigned k) { return __uint_as_float((k & 0x80000000u) ? (k & 0x7fffffffu) : ~k); }
__device__ __forceinline__ void split_bf16(const float4 a, const float4 b, bf16x8& hi, bf16x8& lo) {
    const float x[8] = {a.x, a.y, a.z, a.w, b.x, b.y, b.z, b.w}; unsigned h[4], l[4];
#pragma unroll
    for (int i = 0; i < 4; ++i) { h[i] = cvt_pk_bf16(x[2 * i], x[2 * i + 1]); l[i] = cvt_pk_bf16(x[2 * i] - bf2f(h[i] & 0xffff), x[2 * i + 1] - bf2f(h[i] >> 16)); }
    hi = __builtin_bit_cast(bf16x8, make_uint4(h[0], h[1], h[2], h[3])); lo = __builtin_bit_cast(bf16x8, make_uint4(l[0], l[1], l[2], l[3]));
}
struct PairTab { int n; int i[64], j[64]; };
constexpr PairTab make_pairs() { PairTab t{}; t.n = 0; for (int a = 0; a < 16; ++a) for (int b = 0; b < 16; ++b) if ((a + 1) * (b + 1) <= 16) { t.i[t.n] = a; t.j[t.n] = b; ++t.n; } return t; }
__device__ __forceinline__ void peer_head(const Params& p, unsigned char* sm, int t0, int h, int lane, unsigned char* ibuf, int* LE, float* LG) {
    const int fr = lane & 15, fq = lane >> 4;
    const float* Q = (const float*)(p.ws + WS_Q); const bf16_t* KH = (const bf16_t*)(p.ws + WS_KH); const bf16_t* KL = (const bf16_t*)(p.ws + WS_KL);
    unsigned kk[2][16];
#pragma unroll
    for (int pp = 0; pp < 2; ++pp) {
        bf16x8 qh[4], ql[4];
        { const float* qr = Q + (size_t)(t0 + fr) * 2048 + h * 256 + pp * 128 + fq * 8;
#pragma unroll
          for (int ks = 0; ks < 4; ++ks) split_bf16(*(const float4*)(qr + ks * 32), *(const float4*)(qr + ks * 32 + 4), qh[ks], ql[ks]); }
        unsigned x[32];
#pragma unroll
        for (int n = 0; n < 8; ++n) { const size_t ko = ((size_t)(h * 2 + pp) * 128 + n * 16 + fr) * 128 + fq * 8; f32x4 acc = (f32x4){0.f, 0.f, 0.f, 0.f};
#pragma unroll
            for (int ks = 0; ks < 4; ++ks) { const bf16x8 kh = *(const bf16x8*)(KH + ko + ks * 32), kl = *(const bf16x8*)(KL + ko + ks * 32);
                acc = MFMA16(kh, qh[ks], acc); acc = MFMA16(kl, qh[ks], acc); acc = MFMA16(kh, ql[ks], acc); }
#pragma unroll
            for (int j = 0; j < 4; ++j) x[n * 4 + j] = (mono(acc[j]) & ~0x7Fu) | (unsigned)(n * 16 + fq * 4 + j); }
        bitonic_desc<32>(x);
#pragma unroll
        for (int i = 0; i < 16; ++i) kk[pp][i] = x[i];
        merge16(kk[pp], 16); merge16(kk[pp], 32);
    }
    constexpr PairTab PT = make_pairs();
    float v1[16], v2[16];
#pragma unroll
    for (int i = 0; i < 16; ++i) { v1[i] = unmono(kk[0][i] & ~0x7Fu); v2[i] = unmono(kk[1][i] & ~0x7Fu); }
    unsigned y[16];
#pragma unroll
    for (int c = 0; c < 16; ++c) { unsigned cand = 0u;
#pragma unroll
        for (int q = 0; q < 4; ++q) { const int idx = 4 * c + q;
            if (idx < PT.n) { const unsigned key = (mono(v1[PT.i[idx]] + v2[PT.j[idx]]) & ~0xFFu) | (unsigned)(PT.i[idx] * 16 + PT.j[idx]); cand = (fq == q) ? key : cand; } }
        y[c] = cand; }
    bitonic_desc<16>(y); merge16(y, 16); merge16(y, 32);
    if (fq == 0) {
#pragma unroll
        for (int c4 = 0; c4 < 4; ++c4) { unsigned w1 = 0u, w2 = 0u;
#pragma unroll
            for (int b = 0; b < 4; ++b) { w1 |= (kk[0][c4 * 4 + b] & 0x7Fu) << (8 * b); w2 |= (kk[1][c4 * 4 + b] & 0x7Fu) << (8 * b); }
            ((unsigned*)ibuf)[fr * 8 + c4] = w1; ((unsigned*)ibuf)[fr * 8 + 4 + c4] = w2; }
    }
    LDS_WAIT();
    if (fq == 0) { const float s0 = unmono(y[0] & ~0xFFu); float ex[16], sum = 0.f;
#pragma unroll
        for (int c = 0; c < 16; ++c) { ex[c] = __expf(unmono(y[c] & ~0xFFu) - s0); sum += ex[c]; }
        const float inv = 1.f / sum;
#pragma unroll
        for (int c = 0; c < 16; ++c) { const unsigned code = y[c] & 0xFFu; const int e = (int)ibuf[fr * 32 + (code >> 4)] * 128 + (int)ibuf[fr * 32 + 16 + (code & 15u)];
            LE[fr * 128 + h * 16 + c] = e; LG[fr * 128 + h * 16 + c] = ex[c] * inv; }
    }
}
constexpr int PE_IB = 0, PE_LE = 4096, PE_LG = 12288;
__device__ __forceinline__ void peer_item(const Params& p, unsigned char* sm, int item) {
    const int tid = threadIdx.x, lane = tid & 63, w = tid >> 6;
    const int t0 = item * 16;
    int* LE = (int*)(sm + PE_LE); float* LG = (float*)(sm + PE_LG); unsigned char* W = p.ws + WS_W;
    __syncthreads();
    { uint4* gz = (uint4*)(W + (size_t)t0 * NEXP) + tid; const uint4 z = make_uint4(0u, 0u, 0u, 0u);
#pragma unroll 8
      for (int i = 0; i < 32; ++i) gz[i * 512] = z; }
    peer_head(p, sm, t0, w, lane, sm + PE_IB + w * 512, LE, LG);
    asm volatile("s_waitcnt vmcnt(0)" ::: "memory");
    __syncthreads();
#pragma unroll
    for (int ti = 0; ti < 2; ++ti) { const int t = w * 2 + ti; const int* le = LE + t * 128; const float* lg = LG + t * 128;
        const int e0 = le[lane], e1 = le[lane + 64]; float g0 = 0.f, g1 = 0.f; bool f0 = true, f1 = true;
#pragma unroll 4
        for (int j4 = 0; j4 < 128; j4 += 4) { const int4 ev = *(const int4*)(le + j4); const float4 gv = *(const float4*)(lg + j4);
            const int ea[4] = {ev.x, ev.y, ev.z, ev.w}; const float ga[4] = {gv.x, gv.y, gv.z, gv.w};
#pragma unroll
            for (int q = 0; q < 4; ++q) { const int j = j4 + q;
                if (ea[q] == e0) { g0 += ga[q]; f0 = f0 && (j >= lane); }
                if (ea[q] == e1) { g1 += ga[q]; f1 = f1 && (j >= lane + 64); } } }
        unsigned char* wr = W + (size_t)(t0 + t) * NEXP;
        if (f0) wr[e0] = (unsigned char)(pk4_fp8(g0 * SC_G, 0.f, 0.f, 0.f) & 0xffu);
        if (f1) wr[e1] = (unsigned char)(pk4_fp8(g1 * SC_G, 0.f, 0.f, 0.f) & 0xffu); }
}

#define XB_TMO      128
#define XB_XCNT(j)  (256  + 64 * (j))
#define XB_XSUB(j)  (1280 + 64 * (j))
#define XB_XGEN(j)  (2304 + 64 * (j))
#define XB_TOP      3328
#define XB_TOPGEN   3392
#define XCD_BAR_WORDS 3456
#define XB_SPIN_CAP (1u << 18)
#define LAS __attribute__((address_space(3)))

__device__ __forceinline__ unsigned xb_ld(unsigned* p)              { return __hip_atomic_load(p, __ATOMIC_RELAXED, __HIP_MEMORY_SCOPE_AGENT); }
__device__ __forceinline__ unsigned xb_add(unsigned* p, unsigned v) { return __hip_atomic_fetch_add(p, v, __ATOMIC_RELAXED, __HIP_MEMORY_SCOPE_AGENT); }
__device__ __forceinline__ unsigned xb_xcc_id() { return (unsigned)__builtin_amdgcn_s_getreg((3 << 11) | 20) & 0xFu; }
#define XB_SPIN(cond, bar) do { unsigned _sp = 0; while (cond) { __builtin_amdgcn_s_sleep(1); \
    if ((++_sp & 255u) == 0u) { if (xb_ld(&(bar)[XB_TMO])) break; if (_sp > XB_SPIN_CAP) { atomicAdd(&(bar)[XB_TMO], 1u); break; } } } } while (0)

struct XcdBarrier {
    unsigned* bar; unsigned x;
    volatile LAS unsigned* st;
};

__device__ __forceinline__ XcdBarrier xcd_barrier_post(unsigned* bar, volatile LAS unsigned* st) {
    XcdBarrier b; b.bar = bar; b.x = xb_xcc_id(); b.st = st;
    if (threadIdx.x == 0) (void)xb_add(&bar[XB_XCNT(b.x)], 1u);
    return b;
}
__device__ __forceinline__ void xcd_barrier_complete(unsigned* bar, unsigned x, unsigned& nloc, unsigned& nx) {
    const unsigned G = gridDim.x * gridDim.y * gridDim.z;
    unsigned sum, cnt, mine, sp = 0u;
    for (;;) {
        sum = 0u; cnt = 0u; mine = 0u;
#pragma unroll
        for (unsigned j = 0; j < 16; ++j) { const unsigned c = xb_ld(&bar[XB_XCNT(j)]); sum += c; cnt += (c > 0u) ? 1u : 0u; mine = (j == x) ? c : mine; }
        if (sum == G) break;
        __builtin_amdgcn_s_sleep(1);
        if ((++sp & 255u) == 0u) { if (xb_ld(&bar[XB_TMO])) break; if (sp > XB_SPIN_CAP) { atomicAdd(&bar[XB_TMO], 1u); break; } }
    }
    nloc = mine > 0u ? mine : 1u; nx = cnt > 0u ? cnt : 1u;
}

__device__ __forceinline__ void xcd_barrier(const XcdBarrier& b) {
    asm volatile("s_waitcnt vmcnt(0)" ::: "memory");
    __syncthreads();
    if (threadIdx.x == 0) {
        unsigned* bar = b.bar;
        __builtin_amdgcn_s_waitcnt(0);
        unsigned nloc = b.st[0], nx = b.st[1];
        if (nloc == 0u) { xcd_barrier_complete(bar, b.x, nloc, nx); b.st[0] = nloc; b.st[1] = nx; }
        const unsigned old = xb_add(&bar[XB_XSUB(b.x)], 1u);
        const unsigned gen = old / nloc;
        if (old + 1u == (gen + 1u) * nloc) {
            __builtin_amdgcn_fence(__ATOMIC_RELEASE, "agent");
            asm volatile("s_waitcnt vmcnt(0)" ::: "memory");
            const unsigned og = xb_add(&bar[XB_TOP], 1u);
            const unsigned tg = og / nx;
            if (og + 1u == (tg + 1u) * nx) xb_add(&bar[XB_TOPGEN], 1u);
            else XB_SPIN(xb_ld(&bar[XB_TOPGEN]) == tg, bar);
            __builtin_amdgcn_fence(__ATOMIC_ACQUIRE, "agent");
            xb_add(&bar[XB_XGEN(b.x)], 1u);
            asm volatile("s_waitcnt vmcnt(0)" ::: "memory");
        } else {
            XB_SPIN(xb_ld(&bar[XB_XGEN(b.x)]) == gen, bar);
            __builtin_amdgcn_fence(__ATOMIC_ACQUIRE, "agent");
            asm volatile("s_waitcnt vmcnt(0)" ::: "memory");
        }
    }
    __syncthreads();
}

__global__ void __launch_bounds__(512, 2) hymba_fwd(Params p) {
    extern __shared__ __attribute__((aligned(16))) unsigned char smem[];
    cg::grid_group grid = cg::this_grid();
    volatile int& s_item = *(volatile int*)(smem + 131072);
    volatile LAS unsigned* bst = (volatile LAS unsigned*)(smem + 131072 + 8);
    if (threadIdx.x == 0) { bst[0] = 0u; bst[1] = 0u; }
    __syncthreads();
    const XcdBarrier xb = xcd_barrier_post((unsigned*)(p.ws + WS_CTRL), bst);
    const int tid = threadIdx.x, lane = tid & 63, w = tid >> 6;
    const int G = gridDim.x, c = blockIdx.x;
    unsigned* ctrl = (unsigned*)(p.ws + WS_CTRL) + 3584;
#define PH_ON(n) (p.ph_lo <= (n) && (n) < p.ph_hi)
#define PH_SYNC(n) if ((n) > p.ph_lo && (n) < p.ph_hi) { if ((n) == 1) grid.sync(); else xcd_barrier(xb); }
    if (PH_ON(0)) phase_prep(p, smem);
    PH_SYNC(1);
    if (PH_ON(1)) {
        { pg8::Gemm g{(const bf16_t*)(p.ws + WS_HB), (const bf16_t*)(p.ws + WS_WINT), NTOK, 6144, DM}; pg8::StaticOrder S; S.init(NTOK, 6144, G, c);
          EpiProj E{(bf16_t*)(p.ws + WS_PROJ), 0, 1.f}; pg8::gemm_phase<EpiProj, pg8::StaticOrder, false>((PG8_LAS unsigned char*)smem, g, S, E, nullptr); }
        { pg8::Gemm g{(const bf16_t*)(p.ws + WS_HB8), (const bf16_t*)(p.ws + WS_WINT8), NTOK, 6144, DM / 2}; pg8::StaticOrder S; S.init(NTOK, 6144, G, c);
          EpiProj E{(bf16_t*)(p.ws + WS_PROJ), 6144, 1.f / (SC_X * SC_U)}; pg8::gemm_phase<EpiProj, pg8::StaticOrder, false, true>((PG8_LAS unsigned char*)smem, g, S, E, nullptr); }
        for (int j = c * 8 + w; j < NTOK / 16; j += G * 8) glr_job(p, j, lane); }
    PH_SYNC(2);
    if (PH_ON(2)) { for (int it = c; it < 512; it += G) moba_prep_item(p, smem, it);
        for (int it = c; it < 1024; it += G) gla_prep_item(p, smem, it); }
    PH_SYNC(3);
    if (PH_ON(3)) for (;;) { __syncthreads(); if (tid == 0) s_item = (int)atomicAdd(ctrl, 1u); __syncthreads(); const int it = s_item; if (it >= 128 + 1024) break;
        if (it < 128) gla_item(p, smem, it); else moba_item(p, smem, it - 128); }
    PH_SYNC(4);
    if (PH_ON(4)) gla_final(p);
    PH_SYNC(5);
    if (PH_ON(5)) { pg8::Gemm g{(const bf16_t*)(p.ws + WS_MIX), (const bf16_t*)(p.ws + WS_WOUTT), NTOK, DM, DM}; pg8::StaticOrder S; S.init(NTOK, DM, G, c);
        EpiRes E{p.out, p.x, DM}; pg8::gemm_phase<EpiRes, pg8::StaticOrder, false>((PG8_LAS unsigned char*)smem, g, S, E, nullptr); }
    PH_SYNC(6);
    if (PH_ON(6)) { bf16_t* HB = (bf16_t*)(p.ws + WS_HB);
        for (int r = c * 8 + w; r < NTOK; r += G * 8) rms_row<true>(p.out + (size_t)r * DM, p.g2, HB + (size_t)r * DM, (unsigned*)(p.ws + WS_HB8) + (size_t)r * (DM / 4), lane);
        (void)0; }
    PH_SYNC(7);
    if (PH_ON(7)) { pg8::Gemm g{(const bf16_t*)(p.ws + WS_HB), (const bf16_t*)(p.ws + WS_WPQT), NTOK, 2048, DM}; pg8::StaticOrder S; S.init(NTOK, 2048, G, c);
        EpiF32 E{(float*)(p.ws + WS_Q), 2048}; pg8::gemm_phase<EpiF32, pg8::StaticOrder, false>((PG8_LAS unsigned char*)smem, g, S, E, nullptr); }
    PH_SYNC(8);
    if (PH_ON(8)) for (int it = c; it < NTOK / 16; it += G) peer_item(p, smem, it);
    PH_SYNC(9);
    if (PH_ON(9)) { pg8::Gemm g{(const bf16_t*)(p.ws + WS_HB8), (const bf16_t*)(p.ws + WS_UB), NTOK, NEXP, DM / 2}; pg8::StaticOrder S; S.init(NTOK, NEXP, G, c);
        EpiPeerW8 E{p.ws + WS_W, p.ws + WS_W8}; pg8::gemm_phase<EpiPeerW8, pg8::StaticOrder, false, true>((PG8_LAS unsigned char*)smem, g, S, E, nullptr); }
    PH_SYNC(10);
    if (PH_ON(10)) { pg8::Gemm g{(const bf16_t*)(p.ws + WS_W8), (const bf16_t*)(p.ws + WS_VTB), NTOK, DM, NEXP / 2}; pg8::StaticOrder S; S.init(NTOK, DM, G, c);
        EpiResSc E{p.out, p.out, DM, 1.f / (SC_W * SC_V)}; pg8::gemm_phase<EpiResSc, pg8::StaticOrder, false, true>((PG8_LAS unsigned char*)smem, g, S, E, nullptr); }
}

#ifndef MK_PER_PHASE
#define MK_PER_PHASE 0
#endif
extern "C" void kernel_launch(void* const* d_in, const int* in_sizes, int n_in, void* d_out, int out_size, void* d_ws, size_t ws_size, hipStream_t stream) {
    static int grid = 0;
    if (grid == 0) {
        if (n_in != 14 || out_size != NTOK * DM || ws_size < WS_END) { fprintf(stderr, "kernel_launch: unexpected shapes (n_in %d out %d ws %zu)\n", n_in, out_size, ws_size); grid = -1; return; }
        int dev = 0, cus = 0, per_cu = 0;
        hipGetDevice(&dev); hipDeviceGetAttribute(&cus, hipDeviceAttributeMultiprocessorCount, dev);
        if (hipFuncSetAttribute((const void*)hymba_fwd, hipFuncAttributeMaxDynamicSharedMemorySize, LDS_BYTES) != hipSuccess) { fprintf(stderr, "kernel_launch: hipFuncSetAttribute failed\n"); grid = -1; return; }
        if (hipOccupancyMaxActiveBlocksPerMultiprocessor(&per_cu, (const void*)hymba_fwd, 512, LDS_BYTES) != hipSuccess || per_cu < 1) { fprintf(stderr, "kernel_launch: occupancy query failed (%d)\n", per_cu); grid = -1; return; }
        grid = cus * (per_cu > 1 ? 1 : per_cu);
        fprintf(stderr, "kernel_launch: %d CUs, %d blocks/CU by query, grid %d\n", cus, per_cu, grid);
    }
    if (grid < 0) return;
    hipMemsetAsync((char*)d_ws + WS_CTRL, 0, 16384, stream);
    Params p{};
    p.x = (const float*)d_in[0]; p.g1 = (const float*)d_in[1]; p.win = (const float*)d_in[2]; p.wgu = (const float*)d_in[3]; p.bg = (const float*)d_in[4]; p.glang = (const float*)d_in[5];
    p.qng = (const float*)d_in[6]; p.kng = (const float*)d_in[7]; p.wout = (const float*)d_in[8]; p.g2 = (const float*)d_in[9]; p.wpq = (const float*)d_in[10]; p.pkeys = (const float*)d_in[11];
    p.pu = (const float*)d_in[12]; p.pv = (const float*)d_in[13]; p.out = (float*)d_out; p.ws = (unsigned char*)d_ws;
#if MK_PER_PHASE
    for (int ph = 0; ph < NPHASE; ++ph) { p.ph_lo = ph; p.ph_hi = ph + 1; void* args[] = {&p};
        hipError_t e = hipLaunchCooperativeKernel((const void*)hymba_fwd, dim3(grid), dim3(512), args, LDS_BYTES, stream);
        if (e != hipSuccess) { fprintf(stderr, "cooperative launch failed: %s\n", hipGetErrorString(e)); break; } }
#else
    p.ph_lo = 0; p.ph_hi = NPHASE; void* args[] = {&p};
    hipError_t e = hipLaunchCooperativeKernel((const void*)hymba_fwd, dim3(grid), dim3(512), args, LDS_BYTES, stream);
    if (e != hipSuccess) fprintf(stderr, "cooperative launch failed: %s (grid %d)\n", hipGetErrorString(e), grid);
#endif
}
```

```cpp
#include <hip/hip_runtime.h>
#include <hip/hip_cooperative_groups.h>
#include <cstdio>
#include <cstdint>
namespace cg = cooperative_groups;
namespace pg8 {
#define PG8_LAS __attribute__((address_space(3)))
typedef unsigned short bf16_t;
typedef short bf16x8 __attribute__((ext_vector_type(8)));
typedef float f32x4 __attribute__((ext_vector_type(4)));
typedef unsigned u32x4 __attribute__((ext_vector_type(4)));
constexpr int BM = 256, BK = 64, HALF = 128, HTB = HALF * BK * 2  , STAGE_BYTES = 8 * HTB, NXCD = 8, WGM = 8;

__host__ __device__ __forceinline__ int lds_byte(int r, int c) { const int st = (r >> 4) * 2 + (c >> 5), rr = r & 15, cc = c & 31, ob = rr * 64 + cc * 2; return st * 1024 + (ob ^ (((ob >> 9) & 1) << 5)); }
__host__ __device__ __forceinline__ void stage_rc(int b, int& R, int& C) { const int st = b / 1024, sb = b % 1024, swz = sb ^ (((sb >> 9) & 1) << 5); R = (st >> 1) * 16 + swz / 64; C = (st & 1) * 32 + (swz % 64) / 2; }
__host__ __device__ __forceinline__ int perm32(int rho) { const int n = rho >> 4, i = rho & 15; return 8 * (i >> 2) + 4 * n + (i & 3); }

struct Unit { int pm, pn; };
struct Gemm { const bf16_t* A; const bf16_t* Bt; int M, N, K; };

struct StaticOrder {
    int nM, nN, nwg, G, c;
    __host__ __device__ void init(int M, int N, int G_, int c_) { nM = M / BM; nN = N / BM; nwg = nM * nN; G = G_; c = c_; }
    __host__ __device__ bool next(int i, Unit& u) const {
        const long L = (long)i * G + c; if (L >= nwg) return false;
        int wgid = (int)L; { const int q = nwg / NXCD, r = nwg % NXCD, xcd = wgid % NXCD, off = wgid / NXCD; wgid = (xcd < r ? xcd * (q + 1) : r * (q + 1) + (xcd - r) * q) + off; }
        const int nig = WGM * nN, gid = wgid / nig, fm = gid * WGM, gsz = (nM - fm) < WGM ? (nM - fm) : WGM;
        u.pm = fm + ((wgid % nig) % gsz); u.pn = (wgid % nig) / gsz; return true;
    }
    __device__ __forceinline__ void a_ready(const Unit&) const {}
    __device__ __forceinline__ void done(const Unit&) const {}
};
typedef __bf16 bf16x2_t __attribute__((ext_vector_type(2)));
typedef float f32x2c_t __attribute__((ext_vector_type(2)));
__device__ __forceinline__ unsigned cvt_pk_bf16(float lo, float hi) { f32x2c_t v = {lo, hi}; bf16x2_t b = __builtin_convertvector(v, bf16x2_t); return __builtin_bit_cast(unsigned, b); }
typedef float f32x2 __attribute__((ext_vector_type(2)));
__device__ __forceinline__ f32x2 gelu_pk(f32x2 v) {
    const f32x2 av = __builtin_elementwise_abs(v), d = av * 0.2316418882f + 1.0f;
    f32x2 t; t.x = __builtin_amdgcn_rcpf(d.x); t.y = __builtin_amdgcn_rcpf(d.y);
    f32x2 q = t * 0.5307027145f + (-0.7265760135f); q = q * t + 0.7107068705f; q = q * t + (-0.142248368f); q = q * t + 0.127414796f; q = q * t;
    const f32x2 s = (v * v) * (-0.72134752044f);
    f32x2 e; e.x = __builtin_amdgcn_exp2f(s.x); e.y = __builtin_amdgcn_exp2f(s.y);
    const f32x2 m = v * (q * e), r = v - m;
    f32x2 o; o.x = v.x < 0.f ? m.x : r.x; o.y = v.y < 0.f ? m.y : r.y; return o;
}

typedef int i32x4 __attribute__((ext_vector_type(4)));
typedef int i32x8 __attribute__((ext_vector_type(8)));
__device__ __forceinline__ i32x8 cat16(const bf16x8 a, const bf16x8 b) { const i32x4 lo = __builtin_bit_cast(i32x4, a), hi = __builtin_bit_cast(i32x4, b); return __builtin_shufflevector(lo, hi, 0, 1, 2, 3, 4, 5, 6, 7); }
template <bool F8> __device__ __forceinline__ void mma_block(f32x4 (&accb)[4][2], const bf16x8 (&At)[4][2], const bf16x8 (&Bt)[2][2], const i32x8 (&At8)[4], const i32x8 (&Bt8)[2]) {
    if constexpr (F8) {
#pragma unroll
        for (int m = 0; m < 4; ++m)
#pragma unroll
            for (int n = 0; n < 2; ++n) asm volatile("v_mfma_f32_16x16x128_f8f6f4 %0, %1, %2, %0" : "+v"(accb[m][n]) : "v"(Bt8[n]), "v"(At8[m]));
    } else {
#pragma unroll
        for (int m = 0; m < 4; ++m)
#pragma unroll
            for (int n = 0; n < 2; ++n)
#pragma unroll
                for (int k = 0; k < 2; ++k) accb[m][n] = __builtin_amdgcn_mfma_f32_16x16x32_bf16(Bt[n][k], At[m][k], accb[m][n], 0, 0, 0);
    }
}
template <class Epi, class Sched, bool STAMP = false, bool F8 = false>
__device__ __forceinline__ void gemm_phase(PG8_LAS unsigned char* lds, const Gemm g, const Sched& S, const Epi& E, unsigned long long* stamps) {
    const int tid = threadIdx.x, wid = __builtin_amdgcn_readfirstlane(tid >> 6), lane = tid & 63, wr = wid >> 2, wc = wid & 3, fr = lane & 15, fq = lane >> 4;
    const int K = g.K, nt = K / BK;
    int ts_lo = 0, ts_hi = 0, nts = 0; const unsigned long long rt_entry = STAMP ? (unsigned long long)wall_clock64() : 0ull;
#define PG8_STAMP() do { if (STAMP && wid == 0 && nts < 64) { const unsigned long long _c = (unsigned long long)clock64(); \
        ts_lo = (lane == nts) ? (int)(unsigned)_c : ts_lo; ts_hi = (lane == nts) ? (int)(unsigned)(_c >> 32) : ts_hi; ++nts; } } while (0)
    PG8_STAMP();
    unsigned voffA[2], voffB[2];
#pragma unroll
    for (int i = 0; i < 2; ++i) { int R, C; stage_rc(tid * 16 + i * 8192, R, C); const int Rb = Epi::PERM ? ((R & ~31) + perm32(R & 31)) : R;
        voffA[i] = (unsigned)(R * K + C) * 2u; voffB[i] = (unsigned)(Rb * K + C) * 2u; }
    const size_t kstep = (size_t)(BK * 2);
    const size_t hstep = (size_t)HALF * K * 2;
    const size_t tstep = 2 * hstep;
    const unsigned ldsw = (unsigned)wid * 1024u;
    const int aoff = lds_byte(wr * 64 + fr, fq * 8), boff = lds_byte(wc * 32 + fr, fq * 8);
#define PG8_SA(b, h) (((b) * 2 + (h)) * HTB)
#define PG8_SB(b, h) ((4 + (b) * 2 + (h)) * HTB)
#define PG8_STAGE(bufoff, gbase, voff) do { _Pragma("unroll") for (int _i = 0; _i < 2; ++_i) \
        __builtin_amdgcn_global_load_lds((const unsigned*)((const char*)(gbase) + (voff)[_i]), (PG8_LAS unsigned*)(lds + (bufoff) + ldsw + _i * 8192), 16, 0, 0); } while (0)
#define PG8_LDA(dst, b, h) do { _Pragma("unroll") for (int m = 0; m < 4; ++m) { if constexpr (F8) dst##8[m] = cat16(*(const PG8_LAS bf16x8*)(lds + PG8_SA(b, h) + aoff + m * 2048), *(const PG8_LAS bf16x8*)(lds + PG8_SA(b, h) + aoff + m * 2048 + 1024)); else { _Pragma("unroll") for (int k = 0; k < 2; ++k) dst[m][k] = *(const PG8_LAS bf16x8*)(lds + PG8_SA(b, h) + aoff + m * 2048 + k * 1024); } } } while (0)
#define PG8_LDB(dst, b, h) do { _Pragma("unroll") for (int n = 0; n < 2; ++n) { if constexpr (F8) dst##8[n] = cat16(*(const PG8_LAS bf16x8*)(lds + PG8_SB(b, h) + boff + n * 2048), *(const PG8_LAS bf16x8*)(lds + PG8_SB(b, h) + boff + n * 2048 + 1024)); else { _Pragma("unroll") for (int k = 0; k < 2; ++k) dst[n][k] = *(const PG8_LAS bf16x8*)(lds + PG8_SB(b, h) + boff + n * 2048 + k * 1024); } } } while (0)
#define PG8_MMA(ai, bj, At, Bt) do { __builtin_amdgcn_s_setprio(1); mma_block<F8>(acc[ai][bj], At, Bt, At##8, Bt##8); __builtin_amdgcn_s_setprio(0); } while (0)
#define PG8_WAIT_V(n) asm volatile("s_waitcnt vmcnt(" #n ")" ::: "memory")
#define PG8_WAIT_L(n) asm volatile("s_waitcnt lgkmcnt(" #n ")" ::: "memory")
#define PG8_BAR __builtin_amdgcn_s_barrier()
#define PG8_SCHED __builtin_amdgcn_sched_barrier(0)
    Unit cur, nxt; int ui = 0;
    if (!S.next(0, cur)) return;
    f32x4 acc[2][2][4][2];
#pragma unroll
    for (int a = 0; a < 2; ++a)
#pragma unroll
        for (int b = 0; b < 2; ++b)
#pragma unroll
            for (int m = 0; m < 4; ++m)
#pragma unroll
                for (int n = 0; n < 2; ++n) acc[a][b][m][n] = (f32x4){0.f, 0.f, 0.f, 0.f};
    bf16x8 At[4][2], B0[2][2], B1[2][2]; i32x8 At8[4], B08[2], B18[2];
    const char* cA = (const char*)g.A + (size_t)cur.pm * tstep; const char* cB = (const char*)g.Bt + (size_t)cur.pn * tstep;
    S.a_ready(cur);
    PG8_STAGE(PG8_SB(0, 0), cB, voffB); PG8_STAGE(PG8_SA(0, 0), cA, voffA); PG8_STAGE(PG8_SB(0, 1), cB + hstep, voffB); PG8_STAGE(PG8_SA(0, 1), cA + hstep, voffA);
    if (wr == 1) PG8_BAR;
    PG8_WAIT_V(4); PG8_BAR;
    PG8_STAGE(PG8_SB(1, 0), cB + kstep, voffB); PG8_STAGE(PG8_SA(1, 0), cA + kstep, voffA); PG8_STAGE(PG8_SB(1, 1), cB + hstep + kstep, voffB);
    PG8_WAIT_V(6); PG8_BAR;
    PG8_STAMP();
    for (;;) {
        const bool has_next = S.next(ui + 1, nxt);
        const char* nA = has_next ? (const char*)g.A + (size_t)nxt.pm * tstep : cA; const char* nB = has_next ? (const char*)g.Bt + (size_t)nxt.pn * tstep : cB;
        for (int t = 0; t < nt; t += 2) {
            const bool last = (t == nt - 2);
            const char* a1 = cA + (size_t)(t + 1) * kstep;
            const char* a2 = last ? nA : cA + (size_t)(t + 2) * kstep; const char* b2 = last ? nB : cB + (size_t)(t + 2) * kstep;
            const char* a3 = a2 + kstep; const char* b3 = b2 + kstep;
            if (last && has_next) S.a_ready(nxt);
            PG8_LDB(B0, 0, 0); PG8_SCHED; PG8_LDA(At, 0, 0); PG8_STAGE(PG8_SA(1, 1), a1 + hstep, voffA);
            PG8_WAIT_L(8); PG8_BAR; PG8_WAIT_L(0); PG8_MMA(0, 0, At, B0); PG8_BAR; PG8_SCHED;
            PG8_LDB(B1, 0, 1); PG8_STAGE(PG8_SB(0, 0), b2, voffB);
            PG8_BAR; PG8_WAIT_L(0); PG8_MMA(0, 1, At, B1); PG8_BAR;
            PG8_LDA(At, 0, 1); PG8_STAGE(PG8_SA(0, 0), a2, voffA);
            PG8_BAR; PG8_WAIT_L(0); PG8_MMA(1, 0, At, B0); PG8_BAR; PG8_SCHED;
            PG8_STAGE(PG8_SB(0, 1), b2 + hstep, voffB);
            PG8_WAIT_V(6); PG8_BAR; PG8_MMA(1, 1, At, B1); PG8_BAR;
            PG8_LDB(B0, 1, 0); PG8_SCHED; PG8_LDA(At, 1, 0); PG8_STAGE(PG8_SA(0, 1), a2 + hstep, voffA);
            PG8_WAIT_L(8); PG8_BAR; PG8_WAIT_L(0); PG8_MMA(0, 0, At, B0); PG8_BAR; PG8_SCHED;
            PG8_LDB(B1, 1, 1); PG8_STAGE(PG8_SB(1, 0), b3, voffB);
            PG8_BAR; PG8_WAIT_L(0); PG8_MMA(0, 1, At, B1); PG8_BAR;
            PG8_LDA(At, 1, 1); PG8_STAGE(PG8_SA(1, 0), a3, voffA);
            PG8_BAR; PG8_WAIT_L(0); PG8_MMA(1, 0, At, B0); PG8_BAR; PG8_SCHED;
            PG8_STAGE(PG8_SB(1, 1), b3 + hstep, voffB);
            PG8_WAIT_V(6); PG8_BAR; PG8_MMA(1, 1, At, B1); PG8_BAR;
        }
        PG8_STAMP();
        if constexpr (!Epi::AFTER_DRAIN) { E(acc, cur, wr, wc, fr, fq); S.done(cur); }
        PG8_STAMP();
        if (!has_next) break;
#pragma unroll
        for (int a = 0; a < 2; ++a)
#pragma unroll
            for (int b = 0; b < 2; ++b)
#pragma unroll
                for (int m = 0; m < 4; ++m)
#pragma unroll
                    for (int n = 0; n < 2; ++n) acc[a][b][m][n] = (f32x4){0.f, 0.f, 0.f, 0.f};
        cur = nxt; cA = nA; cB = nB; ++ui;
    }
    PG8_WAIT_V(0);
    if (wr == 0) PG8_BAR;
    PG8_BAR;
    if constexpr (Epi::AFTER_DRAIN) { E.fused(acc, cur, wr, wc, fr, fq, lds, wid, lane); S.done(cur); }
    PG8_STAMP();
    if (STAMP && wid == 0) { stamps[lane] = lane < nts ? (((unsigned long long)(unsigned)ts_hi << 32) | (unsigned)ts_lo) : 0ull;
        if (lane == 62) stamps[62] = rt_entry; if (lane == 63) stamps[63] = (unsigned long long)wall_clock64(); }
#undef PG8_STAMP
#undef PG8_SA
#undef PG8_SB
#undef PG8_STAGE
#undef PG8_LDA
#undef PG8_LDB
#undef PG8_MMA
#undef PG8_WAIT_V
#undef PG8_WAIT_L
#undef PG8_BAR
#undef PG8_SCHED
}
}

using pg8::bf16_t; using pg8::bf16x8; using pg8::f32x4; using pg8::f32x2; using pg8::cvt_pk_bf16; using pg8::Unit;
typedef unsigned long long u64;

constexpr int NTOK = 8192, DM = 4096, SEQL = 2048;
constexpr int NIN = 12304, NINP = 12544, PROJW = 12288;
constexpr int NEXP = 16384;
constexpr size_t MiB = 1024ull * 1024ull;
constexpr size_t WS_CTRL = 0, WS_KM = 1 * MiB, WS_GLR = 2 * MiB, WS_WINT = 4 * MiB, WS_WOUTT = 102 * MiB, WS_WPQT = 134 * MiB, WS_UB = 150 * MiB, WS_VTB = 278 * MiB,
                 WS_HB = 406 * MiB, WS_MIX = 470 * MiB, WS_OG = 534 * MiB, WS_PROJ = 598 * MiB, WS_QN = 790 * MiB, WS_KN = 822 * MiB, WS_VTM = 854 * MiB, WS_HB8 = 886 * MiB, WS_END = 918 * MiB;
constexpr size_t WS_W = WS_PROJ;
constexpr size_t WS_W8 = WS_MIX;
constexpr size_t WS_WINT8 = WS_UB + 64 * MiB;
constexpr size_t WS_KH = 2 * MiB + 512 * 1024, WS_KL = 3 * MiB;
constexpr size_t WS_Q = WS_OG;
constexpr int LDS_BYTES = 131072 + 16;
constexpr int NPHASE = 11;

struct Params {
    const float *x, *g1, *win, *wgu, *bg, *glang, *qng, *kng, *wout, *g2, *wpq, *pkeys, *pu, *pv;
    float* out; unsigned char* ws; int ph_lo, ph_hi;
};

__device__ __forceinline__ float bf2f(unsigned short b) { return __uint_as_float(((unsigned)b) << 16); }
__device__ __forceinline__ unsigned short f2bf(float f) { unsigned u = __float_as_uint(f); u += 0x7FFFu + ((u >> 16) & 1u); return (unsigned short)(u >> 16); }
constexpr float SC_X = 16.f, SC_U = 1024.f, SC_W = 64.f, SC_V = 128.f;
__device__ __forceinline__ float clamp_f8(float x) { return __builtin_fminf(__builtin_fmaxf(x, -448.f), 448.f); }
__device__ __forceinline__ unsigned pk4_fp8(float a, float b, float c, float d) {
    int r = __builtin_amdgcn_cvt_pk_fp8_f32(clamp_f8(a), clamp_f8(b), 0, false); r = __builtin_amdgcn_cvt_pk_fp8_f32(clamp_f8(c), clamp_f8(d), r, true); return (unsigned)r; }
__device__ __forceinline__ float row16_max(float v) {
    v = fmaxf(v, __builtin_bit_cast(float, __builtin_amdgcn_update_dpp(0, __builtin_bit_cast(int, v), 0xB1, 0xF, 0xF, true)));
    v = fmaxf(v, __builtin_bit_cast(float, __builtin_amdgcn_update_dpp(0, __builtin_bit_cast(int, v), 0x4E, 0xF, 0xF, true)));
    v = fmaxf(v, __builtin_bit_cast(float, __builtin_amdgcn_update_dpp(0, __builtin_bit_cast(int, v), 0x141, 0xF, 0xF, true)));
    v = fmaxf(v, __builtin_bit_cast(float, __builtin_amdgcn_update_dpp(0, __builtin_bit_cast(int, v), 0x140, 0xF, 0xF, true)));
    return v;
}
__device__ __forceinline__ float row16_sum(float v) {
    v += __builtin_bit_cast(float, __builtin_amdgcn_update_dpp(0, __builtin_bit_cast(int, v), 0xB1, 0xF, 0xF, true));
    v += __builtin_bit_cast(float, __builtin_amdgcn_update_dpp(0, __builtin_bit_cast(int, v), 0x4E, 0xF, 0xF, true));
    v += __builtin_bit_cast(float, __builtin_amdgcn_update_dpp(0, __builtin_bit_cast(int, v), 0x141, 0xF, 0xF, true));
    v += __builtin_bit_cast(float, __builtin_amdgcn_update_dpp(0, __builtin_bit_cast(int, v), 0x140, 0xF, 0xF, true));
    return v;
}
__device__ __forceinline__ float wave_sum(float v) { v = row16_sum(v); v += __shfl_xor(v, 16); v += __shfl_xor(v, 32); return v; }
#define LDS_WAIT() asm volatile("s_waitcnt lgkmcnt(0)" ::: "memory")
#define MFMA16(a, b, c) __builtin_amdgcn_mfma_f32_16x16x32_bf16((a), (b), (c), 0, 0, 0)

__device__ __forceinline__ int win_remap(int n) { return n < 6144 ? n : (n < 6160 ? 12288 + (n - 6144) : n - 16); }
__device__ __forceinline__ void transpose_item(const float* W, int K, int N, int ld, bf16_t* WT, unsigned* T, int item, int lane, bool remap) {
    const int nblk = (N + 63) >> 6, kb = item / nblk, nb = item - kb * nblk, k0 = 64 * kb, n0 = 64 * nb;
    const int r4 = lane >> 4, cc = lane & 15, nn = n0 + 4 * cc; const bool ok = nn < N;
    float4 v[16];
#pragma unroll
    for (int jj = 0; jj < 8; ++jj)
#pragma unroll
        for (int bb = 0; bb < 2; ++bb) { const int kk = 8 * jj + 2 * r4 + bb; v[2 * jj + bb] = ok ? *(const float4*)(W + (size_t)(k0 + kk) * ld + nn) : make_float4(0.f, 0.f, 0.f, 0.f); }
#pragma unroll
    for (int jj = 0; jj < 8; ++jj) { const float4 a = v[2 * jj], bq = v[2 * jj + 1]; const int kw = 4 * jj + r4;
        T[(4 * cc + 0) * 33 + kw] = cvt_pk_bf16(a.x, bq.x); T[(4 * cc + 1) * 33 + kw] = cvt_pk_bf16(a.y, bq.y);
        T[(4 * cc + 2) * 33 + kw] = cvt_pk_bf16(a.z, bq.z); T[(4 * cc + 3) * 33 + kw] = cvt_pk_bf16(a.w, bq.w); }
    LDS_WAIT();
    const int kc = lane & 7;
#pragma unroll
    for (int jr = 0; jr < 8; ++jr) { const int n = (lane >> 3) + 8 * jr, ns = n0 + n; const unsigned* tp = T + n * 33 + 4 * kc;
        uint4 o; o.x = tp[0]; o.y = tp[1]; o.z = tp[2]; o.w = tp[3];
        if (ns < N) { const int nd = remap ? win_remap(ns) : ns; *(uint4*)(WT + (size_t)nd * K + k0 + 8 * kc) = o; } }
    LDS_WAIT();
}
__device__ __forceinline__ void transpose_item8(const float* W, int K, int N, int ld, unsigned char* WT, unsigned* T, int item, int lane, float sc) {
    const int nblk = (N + 63) >> 6, kb = item / nblk, nb = item - kb * nblk, k0 = 64 * kb, n0 = 64 * nb;
    const int r4 = lane >> 4, cc = lane & 15, nn = n0 + 4 * cc;
    float4 v[16];
#pragma unroll
    for (int jj = 0; jj < 4; ++jj)
#pragma unroll
        for (int bb = 0; bb < 4; ++bb) { const int kk = 16 * jj + 4 * r4 + bb; v[4 * jj + bb] = *(const float4*)(W + (size_t)(k0 + kk) * ld + nn); }
#pragma unroll
    for (int jj = 0; jj < 4; ++jj) { const float4 a = v[4 * jj], b = v[4 * jj + 1], c = v[4 * jj + 2], d = v[4 * jj + 3]; const int kw = 4 * jj + r4;
        T[(4 * cc + 0) * 17 + kw] = pk4_fp8(a.x * sc, b.x * sc, c.x * sc, d.x * sc); T[(4 * cc + 1) * 17 + kw] = pk4_fp8(a.y * sc, b.y * sc, c.y * sc, d.y * sc);
        T[(4 * cc + 2) * 17 + kw] = pk4_fp8(a.z * sc, b.z * sc, c.z * sc, d.z * sc); T[(4 * cc + 3) * 17 + kw] = pk4_fp8(a.w * sc, b.w * sc, c.w * sc, d.w * sc); }
    LDS_WAIT();
    const int kc = lane & 3;
#pragma unroll
    for (int jr = 0; jr < 4; ++jr) { const int n = (lane >> 2) + 16 * jr; const unsigned* tp = T + n * 17 + 4 * kc;
        uint4 o; o.x = tp[0]; o.y = tp[1]; o.z = tp[2]; o.w = tp[3];
        *(uint4*)(WT + (size_t)(n0 + n) * K + k0 + 16 * kc) = o; }
    LDS_WAIT();
}
template <bool F8OUT> __device__ __forceinline__ void rms_row(const float* xrow, const float* g, bf16_t* orow, unsigned* orow8, int lane) {
    const float4* xr = (const float4*)xrow + lane; float4 v[16]; float s = 0.f;
#pragma unroll
    for (int j = 0; j < 16; ++j) { v[j] = xr[64 * j]; s += (v[j].x * v[j].x + v[j].y * v[j].y) + (v[j].z * v[j].z + v[j].w * v[j].w); }
    const float r = rsqrtf(wave_sum(s) * (1.f / DM) + 1e-6f);
    const float4* gr = (const float4*)g + lane; uint2* o8 = (uint2*)orow + lane;
#pragma unroll
    for (int j = 0; j < 16; ++j) { const float4 gg = gr[64 * j]; const float y0 = (v[j].x * r) * gg.x, y1 = (v[j].y * r) * gg.y, y2 = (v[j].z * r) * gg.z, y3 = (v[j].w * r) * gg.w;
        uint2 o; o.x = cvt_pk_bf16(y0, y1); o.y = cvt_pk_bf16(y2, y3); o8[64 * j] = o;
        if (F8OUT) orow8[64 * j + lane] = pk4_fp8(y0 * SC_X, y1 * SC_X, y2 * SC_X, y3 * SC_X); }
}
__device__ __forceinline__ void phase_prep(const Params& p, unsigned char* sm) {
    const int tid = threadIdx.x, lane = tid & 63, w = tid >> 6;
    unsigned* scr = (unsigned*)(sm + w * 8704);
    const int gw = blockIdx.x * 8 + w, NGW = gridDim.x * 8;
    constexpr int I_WIN = 64 * 97, I_WIN8 = 64 * 96, I_WOUT = 64 * 64, I_WPQ = 64 * 32, I_PV = 256 * 64, I_PU = NEXP, I_X = NTOK;
    constexpr int NITEMS = I_WIN + I_WIN8 + I_WOUT + I_WPQ + I_PV + I_PU + I_X;
    bf16_t* WinT = (bf16_t*)(p.ws + WS_WINT); bf16_t* WoutT = (bf16_t*)(p.ws + WS_WOUTT); bf16_t* WpqT = (bf16_t*)(p.ws + WS_WPQT);
    unsigned* UB8 = (unsigned*)(p.ws + WS_UB); unsigned char* VTB8 = p.ws + WS_VTB; bf16_t* HB = (bf16_t*)(p.ws + WS_HB);
    { unsigned* KH = (unsigned*)(p.ws + WS_KH); unsigned* KL = (unsigned*)(p.ws + WS_KL);
      for (int i = blockIdx.x * 512 + tid; i < 8 * 2 * 128 * 128 / 2; i += gridDim.x * 512) { const float2 v = ((const float2*)p.pkeys)[i];
          const unsigned h = cvt_pk_bf16(v.x, v.y); KH[i] = h; KL[i] = cvt_pk_bf16(v.x - bf2f(h & 0xffff), v.y - bf2f(h >> 16)); } }
    for (int it = gw; it < NITEMS; it += NGW) {
        int r = it;
        if (r < I_X) { rms_row<true>(p.x + (size_t)r * DM, p.g1, HB + (size_t)r * DM, (unsigned*)(p.ws + WS_HB8) + (size_t)r * (DM / 4), lane); continue; } r -= I_X;
        if (r < I_WIN) { transpose_item(p.win, DM, 6160, NIN, WinT, scr, r, lane, true); continue; } r -= I_WIN;
        if (r < I_WIN8) { transpose_item8(p.win + 6160, DM, 6144, NIN, p.ws + WS_WINT8, scr, r, lane, SC_U); continue; } r -= I_WIN8;
        if (r < I_WOUT) { transpose_item(p.wout, DM, DM, DM, WoutT, scr, r, lane, false); continue; } r -= I_WOUT;
        if (r < I_WPQ) { transpose_item(p.wpq, DM, 2048, 2048, WpqT, scr, r, lane, false); continue; } r -= I_WPQ;
        if (r < I_PV) { transpose_item8(p.pv, NEXP, DM, DM, VTB8, scr, r, lane, SC_V); continue; } r -= I_PV;
        { const float4* src = (const float4*)(p.pu + (size_t)r * DM) + lane; unsigned* dst = UB8 + (size_t)r * (DM / 4) + lane;
          float4 v[16];
#pragma unroll
          for (int j = 0; j < 16; ++j) v[j] = src[64 * j];
#pragma unroll
          for (int j = 0; j < 16; ++j) dst[64 * j] = pk4_fp8(v[j].x * SC_U, v[j].y * SC_U, v[j].z * SC_U, v[j].w * SC_U); }
    }
}

struct EpiProj {
    static constexpr bool PERM = true, AFTER_DRAIN = false;
    bf16_t* P; int coff; float sc;
    __device__ __forceinline__ void operator()(const f32x4 (&acc)[2][2][4][2], const Unit& u, int wr, int wc, int fr, int fq) const {
        const int row0 = u.pm * 256 + wr * 64 + fr, col0 = coff + u.pn * 256 + wc * 32 + 8 * fq;
#pragma unroll
        for (int ai = 0; ai < 2; ++ai)
#pragma unroll
            for (int m = 0; m < 4; ++m) { bf16_t* rowp = P + (size_t)(row0 + ai * 128 + m * 16) * PROJW + col0;
#pragma unroll
                for (int bj = 0; bj < 2; ++bj) { const f32x4 v0 = acc[ai][bj][m][0] * sc, v1 = acc[ai][bj][m][1] * sc;
                    uint4 o; o.x = cvt_pk_bf16(v0[0], v0[1]); o.y = cvt_pk_bf16(v0[2], v0[3]); o.z = cvt_pk_bf16(v1[0], v1[1]); o.w = cvt_pk_bf16(v1[2], v1[3]);
                    *(uint4*)(rowp + bj * 128) = o; } }
    }
};
struct EpiRes {
    static constexpr bool PERM = false, AFTER_DRAIN = false;
    float* C; const float* R; int ldc;
    __device__ __forceinline__ void operator()(const f32x4 (&acc)[2][2][4][2], const Unit& u, int wr, int wc, int fr, int fq) const {
        const int row0 = u.pm * 256 + wr * 64 + fr, col0 = u.pn * 256 + wc * 32 + 4 * fq;
#pragma unroll
        for (int ai = 0; ai < 2; ++ai)
#pragma unroll
            for (int m = 0; m < 4; ++m) { const size_t ro = (size_t)(row0 + ai * 128 + m * 16) * ldc + col0;
#pragma unroll
                for (int bj = 0; bj < 2; ++bj)
#pragma unroll
                    for (int n = 0; n < 2; ++n) { const f32x4 r = *(const f32x4*)(R + ro + bj * 128 + n * 16); *(f32x4*)(C + ro + bj * 128 + n * 16) = r + acc[ai][bj][m][n]; } }
    }
};
struct EpiF32 {
    static constexpr bool PERM = false, AFTER_DRAIN = false;
    float* C; int ldc;
    __device__ __forceinline__ void operator()(const f32x4 (&acc)[2][2][4][2], const Unit& u, int wr, int wc, int fr, int fq) const {
        const int row0 = u.pm * 256 + wr * 64 + fr, col0 = u.pn * 256 + wc * 32 + 4 * fq;
#pragma unroll
        for (int ai = 0; ai < 2; ++ai)
#pragma unroll
            for (int m = 0; m < 4; ++m) { float* rowp = C + (size_t)(row0 + ai * 128 + m * 16) * ldc + col0;
#pragma unroll
                for (int bj = 0; bj < 2; ++bj)
#pragma unroll
                    for (int n = 0; n < 2; ++n) *(f32x4*)(rowp + bj * 128 + n * 16) = acc[ai][bj][m][n]; }
    }
};
struct EpiResSc {
    static constexpr bool PERM = false, AFTER_DRAIN = false;
    float* C; const float* R; int ldc; float sc;
    __device__ __forceinline__ void operator()(const f32x4 (&acc)[2][2][4][2], const Unit& u, int wr, int wc, int fr, int fq) const {
        const int row0 = u.pm * 256 + wr * 64 + fr, col0 = u.pn * 256 + wc * 32 + 4 * fq;
#pragma unroll
        for (int ai = 0; ai < 2; ++ai)
#pragma unroll
            for (int m = 0; m < 4; ++m) { const size_t ro = (size_t)(row0 + ai * 128 + m * 16) * ldc + col0;
#pragma unroll
                for (int bj = 0; bj < 2; ++bj)
#pragma unroll
                    for (int n = 0; n < 2; ++n) { const f32x4 r = *(const f32x4*)(R + ro + bj * 128 + n * 16); *(f32x4*)(C + ro + bj * 128 + n * 16) = r + acc[ai][bj][m][n] * sc; } }
    }
};
constexpr float SC_G = 128.f;
struct EpiPeerW8 {
    static constexpr bool PERM = true, AFTER_DRAIN = false;
    const unsigned char* Gw; unsigned char* W8;
    __device__ __forceinline__ void operator()(const f32x4 (&acc)[2][2][4][2], const Unit& u, int wr, int wc, int fr, int fq) const {
        const int row0 = u.pm * 256 + wr * 64 + fr, col0 = u.pn * 256 + wc * 32 + 8 * fq; constexpr float isc = 1.f / (SC_X * SC_U), gsc = SC_W / SC_G;
#pragma unroll
        for (int ai = 0; ai < 2; ++ai)
#pragma unroll
            for (int m = 0; m < 4; ++m) { const size_t ro = (size_t)(row0 + ai * 128 + m * 16) * NEXP + col0;
#pragma unroll
                for (int bj = 0; bj < 2; ++bj) { const uint2 gv = *(const uint2*)(Gw + ro + bj * 128); uint2 o = make_uint2(0u, 0u);
                    if ((gv.x | gv.y) != 0u) {
                        const f32x4 v0 = acc[ai][bj][m][0] * isc, v1 = acc[ai][bj][m][1] * isc;
                        const f32x2 a = pg8::gelu_pk((f32x2){v0[0], v0[1]}), b = pg8::gelu_pk((f32x2){v0[2], v0[3]}), c = pg8::gelu_pk((f32x2){v1[0], v1[1]}), d = pg8::gelu_pk((f32x2){v1[2], v1[3]});
                        const int gx = (int)gv.x, gy = (int)gv.y;
                        o.x = pk4_fp8(a.x * __builtin_amdgcn_cvt_f32_fp8(gx, 0) * gsc, a.y * __builtin_amdgcn_cvt_f32_fp8(gx, 1) * gsc, b.x * __builtin_amdgcn_cvt_f32_fp8(gx, 2) * gsc, b.y * __builtin_amdgcn_cvt_f32_fp8(gx, 3) * gsc);
                        o.y = pk4_fp8(c.x * __builtin_amdgcn_cvt_f32_fp8(gy, 0) * gsc, c.y * __builtin_amdgcn_cvt_f32_fp8(gy, 1) * gsc, d.x * __builtin_amdgcn_cvt_f32_fp8(gy, 2) * gsc, d.y * __builtin_amdgcn_cvt_f32_fp8(gy, 3) * gsc); }
                    *(uint2*)(W8 + ro + bj * 128) = o; } }
    }
};

constexpr float QSCALE = 0.08838834764831845f * 1.4426950408889634f;
__device__ __forceinline__ void moba_prep_item(const Params& p, unsigned char* sm, int item) {
    const int tid = threadIdx.x, lane = tid & 63, w = tid >> 6;
    const int blk = item & 7, h = (item >> 3) & 15, b = item >> 7, bh = b * 16 + h;
    const bf16_t* proj = (const bf16_t*)(p.ws + WS_PROJ);
    bf16_t* QN = (bf16_t*)(p.ws + WS_QN); bf16_t* KN = (bf16_t*)(p.ws + WS_KN); bf16_t* VTM = (bf16_t*)(p.ws + WS_VTM); float* KM = (float*)(p.ws + WS_KM);
    bf16_t* VL = (bf16_t*)sm;
    float* KMS = (float*)(sm + 67584);
    const int d0 = 2 * lane;
    const float gq0 = p.qng[d0], gq1 = p.qng[d0 + 1], gk0 = p.kng[d0], gk1 = p.kng[d0 + 1];
    const int fi = d0 & 15;
    const float inv0 = exp2f(-(float)fi * (18.931568569324174f / 16.f)), inv1 = exp2f(-(float)(fi + 1) * (18.931568569324174f / 16.f));
    float km0 = 0.f, km1 = 0.f;
    __syncthreads();
    for (int t4 = 0; t4 < 32; t4 += 4) {
        unsigned qva[4], kva[4], vva[4];
#pragma unroll
        for (int u = 0; u < 4; ++u) { const int tt = w + 8 * (t4 + u); const bf16_t* pr = proj + ((size_t)b * SEQL + blk * 256 + tt) * PROJW;
            qva[u] = *(const unsigned*)(pr + 6144 + h * 128 + d0); kva[u] = *(const unsigned*)(pr + 8192 + h * 128 + d0); vva[u] = *(const unsigned*)(pr + 10240 + h * 128 + d0); }
#pragma unroll
        for (int u = 0; u < 4; ++u) { const int tt = w + 8 * (t4 + u); const int pos = blk * 256 + tt; const unsigned qv = qva[u], kv = kva[u], vv = vva[u];
        float q0 = bf2f(qv & 0xffff), q1 = bf2f(qv >> 16), k0 = bf2f(kv & 0xffff), k1 = bf2f(kv >> 16);
        const float rq = rsqrtf(wave_sum(q0 * q0 + q1 * q1) * (1.f / 128.f) + 1e-6f), rk = rsqrtf(wave_sum(k0 * k0 + k1 * k1) * (1.f / 128.f) + 1e-6f);
        q0 = (q0 * rq) * gq0; q1 = (q1 * rq) * gq1; k0 = (k0 * rk) * gk0; k1 = (k1 * rk) * gk1;
        const float pq0 = __shfl_xor(q0, 8), pq1 = __shfl_xor(q1, 8), pk0 = __shfl_xor(k0, 8), pk1 = __shfl_xor(k1, 8);
        if (lane < 16) {
            float a0 = (float)pos * inv0, a1 = (float)pos * inv1;
            float n0 = rintf(a0 * 0.15915494309189535f), n1 = rintf(a1 * 0.15915494309189535f);
            a0 = fmaf(-n0, 6.2831854820251465f, a0); a0 = fmaf(-n0, -1.7484555e-7f, a0);
            a1 = fmaf(-n1, 6.2831854820251465f, a1); a1 = fmaf(-n1, -1.7484555e-7f, a1);
            const float c0 = __cosf(a0), s0 = __sinf(a0), c1 = __cosf(a1), s1 = __sinf(a1);
            if (lane < 8) { q0 = q0 * c0 - pq0 * s0; q1 = q1 * c1 - pq1 * s1; k0 = k0 * c0 - pk0 * s0; k1 = k1 * c1 - pk1 * s1; }
            else          { q0 = q0 * c0 + pq0 * s0; q1 = q1 * c1 + pq1 * s1; k0 = k0 * c0 + pk0 * s0; k1 = k1 * c1 + pk1 * s1; }
        }
        km0 += k0; km1 += k1;
        const size_t o = ((size_t)bh * SEQL + pos) * 128 + d0;
        *(unsigned*)(QN + o) = cvt_pk_bf16(q0 * QSCALE, q1 * QSCALE);
        *(unsigned*)(KN + o) = cvt_pk_bf16(k0, k1);
        VL[d0 * 264 + tt] = (bf16_t)(vv & 0xffff); VL[(d0 + 1) * 264 + tt] = (bf16_t)(vv >> 16);
        } }
    KMS[w * 128 + d0] = km0; KMS[w * 128 + d0 + 1] = km1;
    __syncthreads();
    if (tid < 128) { float s = 0.f;
#pragma unroll
        for (int i = 0; i < 8; ++i) s += KMS[i * 128 + tid];
        KM[((size_t)bh * 8 + blk) * 128 + tid] = s * (1.f / 256.f); }
    for (int c = tid; c < 128 * 32; c += 512) { const int d = c >> 5, c8 = (c & 31) * 8;
        *(uint4*)(VTM + ((size_t)bh * 128 + d) * SEQL + blk * 256 + c8) = *(const uint4*)(VL + d * 264 + c8); }
}

__device__ __forceinline__ void glr_job(const Params& p, int job, int lane) {
    const int fr = lane & 15, fq = lane >> 4;
    const bf16_t* a = (const bf16_t*)(p.ws + WS_HB) + (size_t)(job * 16 + fr) * DM + fq * 8;
    const bf16_t* b = (const bf16_t*)(p.ws + WS_WINT) + (size_t)(12288 + fr) * DM + fq * 8;
    f32x4 acc0 = (f32x4){0.f, 0.f, 0.f, 0.f}, acc1 = acc0;
#pragma unroll 4
    for (int ks = 0; ks < 128; ks += 2) { const bf16x8 a0 = *(const bf16x8*)(a + ks * 32), b0 = *(const bf16x8*)(b + ks * 32), a1 = *(const bf16x8*)(a + ks * 32 + 32), b1 = *(const bf16x8*)(b + ks * 32 + 32);
        acc0 = MFMA16(a0, b0, acc0); acc1 = MFMA16(a1, b1, acc1); }
    float* glr = (float*)(p.ws + WS_GLR);
#pragma unroll
    for (int j = 0; j < 4; ++j) glr[(size_t)(job * 16 + fq * 4 + j) * 16 + fr] = acc0[j] + acc1[j];
}

constexpr size_t WS_GQD = WS_VTB + 64 * MiB, WS_GKI = WS_GQD + 16 * MiB, WS_GKST = WS_GKI + 16 * MiB, WS_GDEC = WS_GKST + 16 * MiB, WS_GVT = WS_HB8;
constexpr int GP_BC = 0, GP_GLR = 32768, GP_TOT = 36864, GP_KST = 38912, GP_VT = 57344;
__device__ __forceinline__ void gla_prep_item(const Params& p, unsigned char* sm, int item) {
    const int tid = threadIdx.x;
    const int h = item & 7, ch = item >> 3, t0 = ch * 64;
    float* BC = (float*)(sm + GP_BC); float* GLR = (float*)(sm + GP_GLR); float* TOT = (float*)(sm + GP_TOT); bf16_t* KST = (bf16_t*)(sm + GP_KST); bf16_t* VT = (bf16_t*)(sm + GP_VT);
    const bf16_t* proj = (const bf16_t*)(p.ws + WS_PROJ); const float* glr = (const float*)(p.ws + WS_GLR);
    bf16_t* QDg = (bf16_t*)(p.ws + WS_GQD) + (size_t)item * 8192; bf16_t* KIg = (bf16_t*)(p.ws + WS_GKI) + (size_t)item * 8192;
    bf16_t* KSTg = (bf16_t*)(p.ws + WS_GKST) + (size_t)item * 8192; bf16_t* VTg = (bf16_t*)(p.ws + WS_GVT) + (size_t)item * 16384; float* DECg = (float*)(p.ws + WS_GDEC) + (size_t)item * 128;
    __syncthreads();
    if (tid < 256) ((float4*)GLR)[tid] = ((const float4*)(glr + (size_t)t0 * 16))[tid];
    float wcol[16];
#pragma unroll
    for (int r = 0; r < 16; ++r) wcol[r] = p.wgu[r * 1024 + h * 128 + (tid & 127)];
    const float bias = p.bg[h * 128 + (tid & 127)];
    __syncthreads();
    {   const int d = tid & 127, part = tid >> 7; float la[16]; float run = 0.f;
#pragma unroll
        for (int i = 0; i < 16; ++i) { const float* gr = GLR + (part * 16 + i) * 16; float z = bias;
#pragma unroll
            for (int r = 0; r < 16; ++r) z = fmaf(gr[r], wcol[r], z);
            const float ls = fminf(z, 0.f) - __logf(1.f + __expf(-fabsf(z)));
            run += ls * (1.f / 16.f); la[i] = run; }
        TOT[part * 128 + d] = run;
        __syncthreads();
        float off = 0.f;
        for (int pp = 0; pp < part; ++pp) off += TOT[pp * 128 + d];
#pragma unroll
        for (int i = 0; i < 16; ++i) BC[(part * 16 + i) * 128 + d] = la[i] + off;
    }
    __syncthreads();
    if (tid < 128) DECg[tid] = __expf(BC[63 * 128 + tid]);
    for (int c = tid; c < 1024; c += 512) { const int s = c >> 4, dd = (c & 15) * 8;
        const bf16_t* pr = proj + (size_t)(t0 + s) * PROJW + h * 128 + dd;
        const uint4 qv = *(const uint4*)pr, kv = *(const uint4*)(pr + 1024);
        const unsigned qa[4] = {qv.x, qv.y, qv.z, qv.w}, ka[4] = {kv.x, kv.y, kv.z, kv.w};
        unsigned qo[4], ko[4];
#pragma unroll
        for (int i = 0; i < 4; ++i) {
            const float bc0 = BC[s * 128 + dd + 2 * i], bc1 = BC[s * 128 + dd + 2 * i + 1], bl0 = BC[63 * 128 + dd + 2 * i], bl1 = BC[63 * 128 + dd + 2 * i + 1];
            const float q0 = bf2f(qa[i] & 0xffff), q1 = bf2f(qa[i] >> 16), k0 = bf2f(ka[i] & 0xffff), k1 = bf2f(ka[i] >> 16);
            qo[i] = cvt_pk_bf16(q0 * 0.08838834764831845f * __expf(bc0), q1 * 0.08838834764831845f * __expf(bc1));
            ko[i] = cvt_pk_bf16(k0 * __expf(-bc0), k1 * __expf(-bc1));
            KST[(dd + 2 * i) * 72 + s] = f2bf(k0 * __expf(bl0 - bc0)); KST[(dd + 2 * i + 1) * 72 + s] = f2bf(k1 * __expf(bl1 - bc1)); }
        *(uint4*)(QDg + s * 128 + dd) = make_uint4(qo[0], qo[1], qo[2], qo[3]); *(uint4*)(KIg + s * 128 + dd) = make_uint4(ko[0], ko[1], ko[2], ko[3]); }
    for (int c = tid; c < 2048; c += 512) { const int s = c >> 5, e0 = (c & 31) * 8;
        const uint4 vv = *(const uint4*)(proj + (size_t)(t0 + s) * PROJW + 2048 + h * 256 + e0);
        const unsigned va[4] = {vv.x, vv.y, vv.z, vv.w};
#pragma unroll
        for (int i = 0; i < 4; ++i) { VT[(e0 + 2 * i) * 72 + s] = (bf16_t)(va[i] & 0xffff); VT[(e0 + 2 * i + 1) * 72 + s] = (bf16_t)(va[i] >> 16); } }
    __syncthreads();
    for (int c = tid; c < 1024; c += 512) { const int d = c >> 3, c8 = (c & 7) * 8; *(uint4*)(KSTg + d * 64 + c8) = *(const uint4*)(KST + d * 72 + c8); }
    for (int c = tid; c < 2048; c += 512) { const int e = c >> 3, c8 = (c & 7) * 8; *(uint4*)(VTg + e * 64 + c8) = *(const uint4*)(VT + e * 72 + c8); }
}
constexpr int GL_QD = 0, GL_KI = 17408, GL_KST = 34816, GL_VT = 53248, GL_ATT = 62464, GL_ST = 71680;
__device__ __forceinline__ void gla_item(const Params& p, unsigned char* sm, int item) {
    const int tid = threadIdx.x, lane = tid & 63, w = tid >> 6, fr = lane & 15, fq = lane >> 4;
    const int dvs = item & 3, h = (item >> 2) & 7, b = item >> 5;
    bf16_t* QD = (bf16_t*)(sm + GL_QD); bf16_t* KI = (bf16_t*)(sm + GL_KI); bf16_t* KST = (bf16_t*)(sm + GL_KST); bf16_t* VT = (bf16_t*)(sm + GL_VT);
    bf16_t* ATT = (bf16_t*)(sm + GL_ATT); bf16_t* ST = (bf16_t*)(sm + GL_ST);
    float* OG = (float*)(p.ws + WS_OG);
    const bf16_t* QDg = (const bf16_t*)(p.ws + WS_GQD); const bf16_t* KIg = (const bf16_t*)(p.ws + WS_GKI); const bf16_t* KSTg = (const bf16_t*)(p.ws + WS_GKST);
    const bf16_t* VTg = (const bf16_t*)(p.ws + WS_GVT); const float* DECg = (const float*)(p.ws + WS_GDEC);
    __syncthreads();
    for (int i = tid; i < 64 * 136 / 2; i += 512) ((unsigned*)ST)[i] = 0u;
    f32x4 Sacc[4];
#pragma unroll
    for (int i = 0; i < 4; ++i) Sacc[i] = (f32x4){0.f, 0.f, 0.f, 0.f};
    uint4 rq0, rq1, rk0, rk1, rs0, rs1, rv; float rd0, rd1, rd2, rd3;
#define GLA_FETCH(n_) do { const size_t it_ = (size_t)((b * 32 + (n_)) * 8 + h); \
        rq0 = *(const uint4*)(QDg + it_ * 8192 + tid * 8); rq1 = *(const uint4*)(QDg + it_ * 8192 + (tid + 512) * 8); \
        rk0 = *(const uint4*)(KIg + it_ * 8192 + tid * 8); rk1 = *(const uint4*)(KIg + it_ * 8192 + (tid + 512) * 8); \
        rs0 = *(const uint4*)(KSTg + it_ * 8192 + tid * 8); rs1 = *(const uint4*)(KSTg + it_ * 8192 + (tid + 512) * 8); \
        rv = *(const uint4*)(VTg + it_ * 16384 + (size_t)(dvs * 64) * 64 + tid * 8); \
        const float* dp_ = DECg + it_ * 128 + w * 16 + fq * 4; rd0 = dp_[0]; rd1 = dp_[1]; rd2 = dp_[2]; rd3 = dp_[3]; } while (0)
    GLA_FETCH(0);
    for (int n = 0; n < 32; ++n) {
        const int t0 = b * SEQL + n * 64;
        __syncthreads();
        { const int c0 = tid, c1 = tid + 512;
          *(uint4*)(QD + (c0 >> 4) * 136 + (c0 & 15) * 8) = rq0; *(uint4*)(QD + (c1 >> 4) * 136 + (c1 & 15) * 8) = rq1;
          *(uint4*)(KI + (c0 >> 4) * 136 + (c0 & 15) * 8) = rk0; *(uint4*)(KI + (c1 >> 4) * 136 + (c1 & 15) * 8) = rk1;
          *(uint4*)(KST + (c0 >> 3) * 72 + (c0 & 7) * 8) = rs0; *(uint4*)(KST + (c1 >> 3) * 72 + (c1 & 7) * 8) = rs1;
          *(uint4*)(VT + (tid >> 3) * 72 + (tid & 7) * 8) = rv; }
        const float dec[4] = {rd0, rd1, rd2, rd3};
        __syncthreads();
        if (n + 1 < 32) GLA_FETCH(n + 1);
        f32x4 oacc[2];
#pragma unroll
        for (int ti = 0; ti < 2; ++ti) { const int tile = 2 * w + ti, qt = tile >> 2, xt = tile & 3;
            f32x4 a = (f32x4){0.f, 0.f, 0.f, 0.f}, o = (f32x4){0.f, 0.f, 0.f, 0.f};
#pragma unroll
            for (int ks = 0; ks < 4; ++ks) { const bf16x8 af = *(const bf16x8*)(QD + (qt * 16 + fr) * 136 + ks * 32 + fq * 8);
                const bf16x8 bk = *(const bf16x8*)(KI + (xt * 16 + fr) * 136 + ks * 32 + fq * 8), bs = *(const bf16x8*)(ST + (xt * 16 + fr) * 136 + ks * 32 + fq * 8);
                a = MFMA16(af, bk, a); o = MFMA16(af, bs, o); }
#pragma unroll
            for (int j = 0; j < 4; ++j) { const int qq = qt * 16 + fq * 4 + j, ss = xt * 16 + fr; ATT[qq * 72 + ss] = f2bf(ss <= qq ? a[j] : 0.f); }
            oacc[ti] = o; }
        __syncthreads();
#pragma unroll
        for (int ti = 0; ti < 2; ++ti) { const int tile = 2 * w + ti, qt = tile >> 2, et = tile & 3; f32x4 o = oacc[ti];
#pragma unroll
            for (int ks = 0; ks < 2; ++ks) { const bf16x8 af = *(const bf16x8*)(ATT + (qt * 16 + fr) * 72 + ks * 32 + fq * 8), bv = *(const bf16x8*)(VT + (et * 16 + fr) * 72 + ks * 32 + fq * 8); o = MFMA16(af, bv, o); }
#pragma unroll
            for (int j = 0; j < 4; ++j) OG[(size_t)(t0 + qt * 16 + fq * 4 + j) * 2048 + h * 256 + dvs * 64 + et * 16 + fr] = o[j]; }
#pragma unroll
        for (int et = 0; et < 4; ++et) { f32x4 sv = Sacc[et];
#pragma unroll
            for (int j = 0; j < 4; ++j) sv[j] *= dec[j];
#pragma unroll
            for (int ks = 0; ks < 2; ++ks) { const bf16x8 af = *(const bf16x8*)(KST + (w * 16 + fr) * 72 + ks * 32 + fq * 8), bv = *(const bf16x8*)(VT + (et * 16 + fr) * 72 + ks * 32 + fq * 8); sv = MFMA16(af, bv, sv); }
            Sacc[et] = sv;
            uint2 pk; pk.x = cvt_pk_bf16(sv[0], sv[1]); pk.y = cvt_pk_bf16(sv[2], sv[3]);
            *(uint2*)(ST + (et * 16 + fr) * 136 + w * 16 + fq * 4) = pk; }
    }
}

constexpr int MB_KT = 0, MB_VT = 17408, MB_P = 35840, MB_MISC = 54272;
__device__ __forceinline__ void moba_item(const Params& p, unsigned char* sm, int item) {
    const int tid = threadIdx.x, lane = tid & 63, w = tid >> 6, fr = lane & 15, fq = lane >> 4;
    const int qt = 15 - (item >> 6), bh = item & 63, b = bh >> 4, h = bh & 15, q0 = qt * 128, blk = qt >> 1;
    const bf16_t* QNp = (const bf16_t*)(p.ws + WS_QN) + (size_t)bh * SEQL * 128; const bf16_t* KNp = (const bf16_t*)(p.ws + WS_KN) + (size_t)bh * SEQL * 128;
    const bf16_t* VTp = (const bf16_t*)(p.ws + WS_VTM) + (size_t)bh * 128 * SEQL; const float* KMp = (const float*)(p.ws + WS_KM) + (size_t)bh * 8 * 128;
    bf16_t* MIX = (bf16_t*)(p.ws + WS_MIX);
    bf16_t* KT = (bf16_t*)(sm + MB_KT); bf16_t* VT = (bf16_t*)(sm + MB_VT); bf16_t* Pw = (bf16_t*)(sm + MB_P) + w * 16 * 72; unsigned* bm = (unsigned*)(sm + MB_MISC);
    float* KMS = (float*)(sm + MB_MISC + 1024);
    __syncthreads();
    if (tid < blk * 32) ((float4*)KMS)[tid] = ((const float4*)KMp)[tid];
    if (tid == 0) *bm = 0u;
    __syncthreads();
    bf16x8 qf[4];
    { const bf16_t* qrow = QNp + (size_t)(q0 + w * 16 + fr) * 128;
#pragma unroll
      for (int ks = 0; ks < 4; ++ks) qf[ks] = *(const bf16x8*)(qrow + ks * 32 + fq * 8); }
    unsigned mask = 0u;
    { float g1 = -INFINITY, g2 = -INFINITY, g3 = -INFINITY; int i1 = -1, i2 = -1, i3 = -1;
      for (int n = 0; n < blk; ++n) { float part = 0.f;
#pragma unroll
          for (int ks = 0; ks < 4; ++ks) { const float* km = KMS + n * 128 + ks * 32 + fq * 8;
#pragma unroll
              for (int i = 0; i < 8; ++i) part = fmaf(bf2f((unsigned short)qf[ks][i]), km[i], part); }
          part += __shfl_xor(part, 16); part += __shfl_xor(part, 32);
          if (part > g1) { g3 = g2; i3 = i2; g2 = g1; i2 = i1; g1 = part; i1 = n; } else if (part > g2) { g3 = g2; i3 = i2; g2 = part; i2 = n; } else if (part > g3) { g3 = part; i3 = n; } }
      if (i1 >= 0) mask |= 1u << i1; if (i2 >= 0) mask |= 1u << i2; if (i3 >= 0) mask |= 1u << i3; }
    unsigned rm[4];
#pragma unroll
    for (int j = 0; j < 4; ++j) rm[j] = (unsigned)__shfl((int)mask, fq * 4 + j);
    { unsigned wm = mask;
#pragma unroll
      for (int o = 1; o < 16; o <<= 1) wm |= (unsigned)__shfl_xor((int)wm, o);
      if (lane == 0) atomicOr(bm, wm); }
    __syncthreads();
    const unsigned anym = *bm;
    f32x4 oacc[8];
#pragma unroll
    for (int i = 0; i < 8; ++i) oacc[i] = (f32x4){0.f, 0.f, 0.f, 0.f};
    float mrow[4] = {-1e30f, -1e30f, -1e30f, -1e30f}, lrow[4] = {0.f, 0.f, 0.f, 0.f};
    const int ntile = (q0 + 128) >> 6;
#define MB_NEXT(k_) do { while ((k_) < ntile && ((k_) >> 2) < blk && !((anym >> ((k_) >> 2)) & 1u)) ++(k_); } while (0)
    uint4 rka, rkb, rva, rvb;
#define MB_FETCH(k_) do { const int c0 = tid, c1 = tid + 512; \
        rka = *(const uint4*)(KNp + (size_t)((k_) * 64 + (c0 >> 4)) * 128 + (c0 & 15) * 8); rkb = *(const uint4*)(KNp + (size_t)((k_) * 64 + (c1 >> 4)) * 128 + (c1 & 15) * 8); \
        rva = *(const uint4*)(VTp + (size_t)(c0 >> 3) * SEQL + (k_) * 64 + (c0 & 7) * 8); rvb = *(const uint4*)(VTp + (size_t)(c1 >> 3) * SEQL + (k_) * 64 + (c1 & 7) * 8); } while (0)
    int kt = 0; MB_NEXT(kt);
    MB_FETCH(kt);
    while (kt < ntile) {
        const int kb = kt >> 2;
        __syncthreads();
        { const int c0 = tid, c1 = tid + 512, r0 = c0 >> 4, r1 = c1 >> 4;
          *(uint4*)(KT + ((r0 & 3) * 16 + (r0 >> 2)) * 136 + (c0 & 15) * 8) = rka; *(uint4*)(KT + ((r1 & 3) * 16 + (r1 >> 2)) * 136 + (c1 & 15) * 8) = rkb;
          *(uint4*)(VT + (c0 >> 3) * 72 + (c0 & 7) * 8) = rva; *(uint4*)(VT + (c1 >> 3) * 72 + (c1 & 7) * 8) = rvb; }
        __syncthreads();
        int nk = kt + 1; MB_NEXT(nk);
        if (nk < ntile) MB_FETCH(nk);
        f32x4 s[4];
#pragma unroll
        for (int g = 0; g < 4; ++g) s[g] = (f32x4){0.f, 0.f, 0.f, 0.f};
#pragma unroll
        for (int ks = 0; ks < 4; ++ks)
#pragma unroll
            for (int g = 0; g < 4; ++g) { const bf16x8 bk = *(const bf16x8*)(KT + (g * 16 + fr) * 136 + ks * 32 + fq * 8); s[g] = MFMA16(qf[ks], bk, s[g]); }
        float alpha[4]; bool resc = false;
#pragma unroll
        for (int j = 0; j < 4; ++j) { const int qpos = q0 + w * 16 + fq * 4 + j; const bool past = kb < blk; const bool rowok = past ? (((rm[j] >> kb) & 1u) != 0u) : true;
            float mx = -1e30f;
#pragma unroll
            for (int g = 0; g < 4; ++g) { const int kpos = kt * 64 + 4 * fr + g; const bool ok = rowok && (past || kpos <= qpos); const float sv = ok ? s[g][j] : -1e30f; s[g][j] = sv; mx = fmaxf(mx, sv); }
            mx = row16_max(mx);
            const float mnew = fmaxf(mrow[j], mx); alpha[j] = __builtin_amdgcn_exp2f(mrow[j] - mnew); resc = resc || (mnew != mrow[j]); mrow[j] = mnew;
            float rs = 0.f;
#pragma unroll
            for (int g = 0; g < 4; ++g) { const float pv = __builtin_amdgcn_exp2f(s[g][j] - mnew); s[g][j] = pv; rs += pv; }
            lrow[j] = lrow[j] * alpha[j] + rs;
            uint2 pk; pk.x = cvt_pk_bf16(s[0][j], s[1][j]); pk.y = cvt_pk_bf16(s[2][j], s[3][j]);
            *(uint2*)(Pw + (fq * 4 + j) * 72 + 4 * fr) = pk; }
        if (__ballot(resc)) {
#pragma unroll
            for (int j = 0; j < 4; ++j)
#pragma unroll
                for (int dt = 0; dt < 8; ++dt) oacc[dt][j] *= alpha[j]; }
        LDS_WAIT();
        bf16x8 pf[2];
#pragma unroll
        for (int ks = 0; ks < 2; ++ks) pf[ks] = *(const bf16x8*)(Pw + fr * 72 + ks * 32 + fq * 8);
#pragma unroll
        for (int dt = 0; dt < 8; ++dt)
#pragma unroll
            for (int ks = 0; ks < 2; ++ks) { const bf16x8 bv = *(const bf16x8*)(VT + (dt * 16 + fr) * 72 + ks * 32 + fq * 8); oacc[dt] = MFMA16(pf[ks], bv, oacc[dt]); }
        kt = nk;
    }
    float inv[4];
#pragma unroll
    for (int j = 0; j < 4; ++j) inv[j] = 1.f / row16_sum(lrow[j]);
#pragma unroll
    for (int dt = 0; dt < 8; ++dt)
#pragma unroll
        for (int j = 0; j < 4; ++j) MIX[(size_t)(b * SEQL + q0 + w * 16 + fq * 4 + j) * DM + 2048 + h * 128 + dt * 16 + fr] = f2bf(oacc[dt][j] * inv[j]);
}

__device__ __forceinline__ void gla_final(const Params& p) {
    const int tid = threadIdx.x, lane = tid & 63, w = tid >> 6;
    const float* OG = (const float*)(p.ws + WS_OG); const bf16_t* proj = (const bf16_t*)(p.ws + WS_PROJ); bf16_t* MIX = (bf16_t*)(p.ws + WS_MIX);
    const float4 gn = ((const float4*)p.glang)[lane];
    for (int it = blockIdx.x * 8 + w; it < NTOK * 8; it += gridDim.x * 8) { const int t = it >> 3, h = it & 7;
        const float4 o = ((const float4*)(OG + (size_t)t * 2048 + h * 256))[lane];
        const float r = rsqrtf(wave_sum((o.x * o.x + o.y * o.y) + (o.z * o.z + o.w * o.w)) * (1.f / 256.f) + 1e-6f);
        const uint2 gv = ((const uint2*)(proj + (size_t)t * PROJW + 4096 + h * 256))[lane];
        const float g0 = bf2f(gv.x & 0xffff), g1 = bf2f(gv.x >> 16), g2 = bf2f(gv.y & 0xffff), g3 = bf2f(gv.y >> 16);
        const float y0 = ((o.x * r) * gn.x) * (g0 / (1.f + __expf(-g0))), y1 = ((o.y * r) * gn.y) * (g1 / (1.f + __expf(-g1)));
        const float y2 = ((o.z * r) * gn.z) * (g2 / (1.f + __expf(-g2))), y3 = ((o.w * r) * gn.w) * (g3 / (1.f + __expf(-g3)));
        uint2 ov; ov.x = cvt_pk_bf16(y0, y1); ov.y = cvt_pk_bf16(y2, y3);
        ((uint2*)(MIX + (size_t)t * DM + h * 256))[lane] = ov; }
}

template <int N> __device__ __forceinline__ void bitonic_desc(unsigned (&x)[N]) {
#pragma unroll
    for (int k = 2; k <= N; k <<= 1)
#pragma unroll
        for (int j = k >> 1; j > 0; j >>= 1)
#pragma unroll
            for (int i = 0; i < N; ++i) { const int l = i ^ j;
                if (l > i) { const unsigned a = x[i], b = x[l], mx = a > b ? a : b, mn = a > b ? b : a;
                    if ((i & k) == 0) { x[i] = mx; x[l] = mn; } else { x[i] = mn; x[l] = mx; } } }
}
__device__ __forceinline__ void merge16(unsigned (&x)[16], int mask) {
    unsigned y[16];
#pragma unroll
    for (int i = 0; i < 16; ++i) y[i] = (unsigned)__shfl_xor((int)x[15 - i], mask);
#pragma unroll
    for (int i = 0; i < 16; ++i) x[i] = x[i] > y[i] ? x[i] : y[i];
    bitonic_desc<16>(x);
}
__device__ __forceinline__ unsigned mono(float f) { const unsigned u = __float_as_uint(f); return (u & 0x80000000u) ? ~u : (u | 0x80000000u); }
__device__ __forceinline__ float unmono(unsigned k) { return __uint_as_float((k & 0x80000000u) ? (k & 0x7fffffffu) : ~k); }
__device__ __forceinline__ void split_bf16(const float4 a, const float4 b, bf16x8& hi, bf16x8& lo) {
    const float x[8] = {a.x, a.y, a.z, a.w, b.x, b.y, b.z, b.w}; unsigned h[4], l[4];
#pragma unroll
    for (int i = 0; i < 4; ++i) { h[i] = cvt_pk_bf16(x[2 * i], x[2 * i + 1]); l[i] = cvt_pk_bf16(x[2 * i] - bf2f(h[i] & 0xffff), x[2 * i + 1] - bf2f(h[i] >> 16)); }
    hi = __builtin_bit_cast(bf16x8, make_uint4(h[0], h[1], h[2], h[3])); lo = __builtin_bit_cast(bf16x8, make_uint4(l[0], l[1], l[2], l[3]));
}
struct PairTab { int n; int i[64], j[64]; };
constexpr PairTab make_pairs() { PairTab t{}; t.n = 0; for (int a = 0; a < 16; ++a) for (int b = 0; b < 16; ++b) if ((a + 1) * (b + 1) <= 16) { t.i[t.n] = a; t.j[t.n] = b; ++t.n; } return t; }
__device__ __forceinline__ void peer_head(const Params& p, unsigned char* sm, int t0, int h, int lane, unsigned char* ibuf, int* LE, float* LG) {
    const int fr = lane & 15, fq = lane >> 4;
    const float* Q = (const float*)(p.ws + WS_Q); const bf16_t* KH = (const bf16_t*)(p.ws + WS_KH); const bf16_t* KL = (const bf16_t*)(p.ws + WS_KL);
    unsigned kk[2][16];
#pragma unroll
    for (int pp = 0; pp < 2; ++pp) {
        bf16x8 qh[4], ql[4];
        { const float* qr = Q + (size_t)(t0 + fr) * 2048 + h * 256 + pp * 128 + fq * 8;
#pragma unroll
          for (int ks = 0; ks < 4; ++ks) split_bf16(*(const float4*)(qr + ks * 32), *(const float4*)(qr + ks * 32 + 4), qh[ks], ql[ks]); }
        unsigned x[32];
#pragma unroll
        for (int n = 0; n < 8; ++n) { const size_t ko = ((size_t)(h * 2 + pp) * 128 + n * 16 + fr) * 128 + fq * 8; f32x4 acc = (f32x4){0.f, 0.f, 0.f, 0.f};
#pragma unroll
            for (int ks = 0; ks < 4; ++ks) { const bf16x8 kh = *(const bf16x8*)(KH + ko + ks * 32), kl = *(const bf16x8*)(KL + ko + ks * 32);
                acc = MFMA16(kh, qh[ks], acc); acc = MFMA16(kl, qh[ks], acc); acc = MFMA16(kh, ql[ks], acc); }
#pragma unroll
            for (int j = 0; j < 4; ++j) x[n * 4 + j] = (mono(acc[j]) & ~0x7Fu) | (unsigned)(n * 16 + fq * 4 + j); }
        bitonic_desc<32>(x);
#pragma unroll
        for (int i = 0; i < 16; ++i) kk[pp][i] = x[i];
        merge16(kk[pp], 16); merge16(kk[pp], 32);
    }
    constexpr PairTab PT = make_pairs();
    float v1[16], v2[16];
#pragma unroll
    for (int i = 0; i < 16; ++i) { v1[i] = unmono(kk[0][i] & ~0x7Fu); v2[i] = unmono(kk[1][i] & ~0x7Fu); }
    unsigned y[16];
#pragma unroll
    for (int c = 0; c < 16; ++c) { unsigned cand = 0u;
#pragma unroll
        for (int q = 0; q < 4; ++q) { const int idx = 4 * c + q;
            if (idx < PT.n) { const unsigned key = (mono(v1[PT.i[idx]] + v2[PT.j[idx]]) & ~0xFFu) | (unsigned)(PT.i[idx] * 16 + PT.j[idx]); cand = (fq == q) ? key : cand; } }
        y[c] = cand; }
    bitonic_desc<16>(y); merge16(y, 16); merge16(y, 32);
    if (fq == 0) {
#pragma unroll
        for (int c4 = 0; c4 < 4; ++c4) { unsigned w1 = 0u, w2 = 0u;
#pragma unroll
            for (int b = 0; b < 4; ++b) { w1 |= (kk[0][c4 * 4 + b] & 0x7Fu) << (8 * b); w2 |= (kk[1][c4 * 4 + b] & 0x7Fu) << (8 * b); }
            ((unsigned*)ibuf)[fr * 8 + c4] = w1; ((unsigned*)ibuf)[fr * 8 + 4 + c4] = w2; }
    }
    LDS_WAIT();
    if (fq == 0) { const float s0 = unmono(y[0] & ~0xFFu); float ex[16], sum = 0.f;
#pragma unroll
        for (int c = 0; c < 16; ++c) { ex[c] = __expf(unmono(y[c] & ~0xFFu) - s0); sum += ex[c]; }
        const float inv = 1.f / sum;
#pragma unroll
        for (int c = 0; c < 16; ++c) { const unsigned code = y[c] & 0xFFu; const int e = (int)ibuf[fr * 32 + (code >> 4)] * 128 + (int)ibuf[fr * 32 + 16 + (code & 15u)];
            LE[fr * 128 + h * 16 + c] = e; LG[fr * 128 + h * 16 + c] = ex[c] * inv; }
    }
}
constexpr int PE_IB = 0, PE_LE = 4096, PE_LG = 12288;
__device__ __forceinline__ void peer_item(const Params& p, unsigned char* sm, int item) {
    const int tid = threadIdx.x, lane = tid & 63, w = tid >> 6;
    const int t0 = item * 16;
    int* LE = (int*)(sm + PE_LE); float* LG = (float*)(sm + PE_LG); unsigned char* W = p.ws + WS_W;
    __syncthreads();
    { uint4* gz = (uint4*)(W + (size_t)t0 * NEXP) + tid; const uint4 z = make_uint4(0u, 0u, 0u, 0u);
#pragma unroll 8
      for (int i = 0; i < 32; ++i) gz[i * 512] = z; }
    peer_head(p, sm, t0, w, lane, sm + PE_IB + w * 512, LE, LG);
    asm volatile("s_waitcnt vmcnt(0)" ::: "memory");
    __syncthreads();
#pragma unroll
    for (int ti = 0; ti < 2; ++ti) { const int t = w * 2 + ti; const int* le = LE + t * 128; const float* lg = LG + t * 128;
        const int e0 = le[lane], e1 = le[lane + 64]; float g0 = 0.f, g1 = 0.f; bool f0 = true, f1 = true;
#pragma unroll 4
        for (int j4 = 0; j4 < 128; j4 += 4) { const int4 ev = *(const int4*)(le + j4); const float4 gv = *(const float4*)(lg + j4);
            const int ea[4] = {ev.x, ev.y, ev.z, ev.w}; const float ga[4] = {gv.x, gv.y, gv.z, gv.w};
#pragma unroll
            for (int q = 0; q < 4; ++q) { const int j = j4 + q;
                if (ea[q] == e0) { g0 += ga[q]; f0 = f0 && (j >= lane); }
                if (ea[q] == e1) { g1 += ga[q]; f1 = f1 && (j >= lane + 64); } } }
        unsigned char* wr = W + (size_t)(t0 + t) * NEXP;
        if (f0) wr[e0] = (unsigned char)(pk4_fp8(g0 * SC_G, 0.f, 0.f, 0.f) & 0xffu);
        if (f1) wr[e1] = (unsigned char)(pk4_fp8(g1 * SC_G, 0.f, 0.f, 0.f) & 0xffu); }
}

#define XB_TMO      128
#define XB_XCNT(j)  (256  + 64 * (j))
#define XB_XSUB(j)  (1280 + 64 * (j))
#define XB_XGEN(j)  (2304 + 64 * (j))
#define XB_TOP      3328
#define XB_TOPGEN   3392
#define XCD_BAR_WORDS 3456
#define XB_SPIN_CAP (1u << 18)
#define LAS __attribute__((address_space(3)))

__device__ __forceinline__ unsigned xb_ld(unsigned* p)              { return __hip_atomic_load(p, __ATOMIC_RELAXED, __HIP_MEMORY_SCOPE_AGENT); }
__device__ __forceinline__ unsigned xb_add(unsigned* p, unsigned v) { return __hip_atomic_fetch_add(p, v, __ATOMIC_RELAXED, __HIP_MEMORY_SCOPE_AGENT); }
__device__ __forceinline__ unsigned xb_xcc_id() { return (unsigned)__builtin_amdgcn_s_getreg((3 << 11) | 20) & 0xFu; }
#define XB_SPIN(cond, bar) do { unsigned _sp = 0; while (cond) { __builtin_amdgcn_s_sleep(1); \
    if ((++_sp & 255u) == 0u) { if (xb_ld(&(bar)[XB_TMO])) break; if (_sp > XB_SPIN_CAP) { atomicAdd(&(bar)[XB_TMO], 1u); break; } } } } while (0)

struct XcdBarrier {
    unsigned* bar; unsigned x;
    volatile LAS unsigned* st;
};

__device__ __forceinline__ XcdBarrier xcd_barrier_post(unsigned* bar, volatile LAS unsigned* st) {
    XcdBarrier b; b.bar = bar; b.x = xb_xcc_id(); b.st = st;
    if (threadIdx.x == 0) (void)xb_add(&bar[XB_XCNT(b.x)], 1u);
    return b;
}
__device__ __forceinline__ void xcd_barrier_complete(unsigned* bar, unsigned x, unsigned& nloc, unsigned& nx) {
    const unsigned G = gridDim.x * gridDim.y * gridDim.z;
    unsigned sum, cnt, mine, sp = 0u;
    for (;;) {
        sum = 0u; cnt = 0u; mine = 0u;
#pragma unroll
        for (unsigned j = 0; j < 16; ++j) { const unsigned c = xb_ld(&bar[XB_XCNT(j)]); sum += c; cnt += (c > 0u) ? 1u : 0u; mine = (j == x) ? c : mine; }
        if (sum == G) break;
        __builtin_amdgcn_s_sleep(1);
        if ((++sp & 255u) == 0u) { if (xb_ld(&bar[XB_TMO])) break; if (sp > XB_SPIN_CAP) { atomicAdd(&bar[XB_TMO], 1u); break; } }
    }
    nloc = mine > 0u ? mine : 1u; nx = cnt > 0u ? cnt : 1u;
}

__device__ __forceinline__ void xcd_barrier(const XcdBarrier& b) {
    asm volatile("s_waitcnt vmcnt(0)" ::: "memory");
    __syncthreads();
    if (threadIdx.x == 0) {
        unsigned* bar = b.bar;
        __builtin_amdgcn_s_waitcnt(0);
        unsigned nloc = b.st[0], nx = b.st[1];
        if (nloc == 0u) { xcd_barrier_complete(bar, b.x, nloc, nx); b.st[0] = nloc; b.st[1] = nx; }
        const unsigned old = xb_add(&bar[XB_XSUB(b.x)], 1u);
        const unsigned gen = old / nloc;
        if (old + 1u == (gen + 1u) * nloc) {
            __builtin_amdgcn_fence(__ATOMIC_RELEASE, "agent");
            asm volatile("s_waitcnt vmcnt(0)" ::: "memory");
            const unsigned og = xb_add(&bar[XB_TOP], 1u);
            const unsigned tg = og / nx;
            if (og + 1u == (tg + 1u) * nx) xb_add(&bar[XB_TOPGEN], 1u);
            else XB_SPIN(xb_ld(&bar[XB_TOPGEN]) == tg, bar);
            __builtin_amdgcn_fence(__ATOMIC_ACQUIRE, "agent");
            xb_add(&bar[XB_XGEN(b.x)], 1u);
            asm volatile("s_waitcnt vmcnt(0)" ::: "memory");
        } else {
            XB_SPIN(xb_ld(&bar[XB_XGEN(b.x)]) == gen, bar);
            __builtin_amdgcn_fence(__ATOMIC_ACQUIRE, "agent");
            asm volatile("s_waitcnt vmcnt(0)" ::: "memory");
        }
    }
    __syncthreads();
}

__global__ void __launch_bounds__(512, 2) hymba_fwd(Params p) {
    extern __shared__ __attribute__((aligned(16))) unsigned char smem[];
    cg::grid_group grid = cg::this_grid();
    volatile int& s_item = *(volatile int*)(smem + 131072);
    volatile LAS unsigned* bst = (volatile LAS unsigned*)(smem + 131072 + 8);
    if (threadIdx.x == 0) { bst[0] = 0u; bst[1] = 0u; }
    __syncthreads();
    const XcdBarrier xb = xcd_barrier_post((unsigned*)(p.ws + WS_CTRL), bst);
    const int tid = threadIdx.x, lane = tid & 63, w = tid >> 6;
    const int G = gridDim.x, c = blockIdx.x;
    unsigned* ctrl = (unsigned*)(p.ws + WS_CTRL) + 3584;
#define PH_ON(n) (p.ph_lo <= (n) && (n) < p.ph_hi)
#define PH_SYNC(n) if ((n) > p.ph_lo && (n) < p.ph_hi) { if ((n) == 1) grid.sync(); else xcd_barrier(xb); }
    if (PH_ON(0)) phase_prep(p, smem);
    PH_SYNC(1);
    if (PH_ON(1)) {
        { pg8::Gemm g{(const bf16_t*)(p.ws + WS_HB), (const bf16_t*)(p.ws + WS_WINT), NTOK, 6144, DM}; pg8::StaticOrder S; S.init(NTOK, 6144, G, c);
          EpiProj E{(bf16_t*)(p.ws + WS_PROJ), 0, 1.f}; pg8::gemm_phase<EpiProj, pg8::StaticOrder, false>((PG8_LAS unsigned char*)smem, g, S, E, nullptr); }
        { pg8::Gemm g{(const bf16_t*)(p.ws + WS_HB8), (const bf16_t*)(p.ws + WS_WINT8), NTOK, 6144, DM / 2}; pg8::StaticOrder S; S.init(NTOK, 6144, G, c);
          EpiProj E{(bf16_t*)(p.ws + WS_PROJ), 6144, 1.f / (SC_X * SC_U)}; pg8::gemm_phase<EpiProj, pg8::StaticOrder, false, true>((PG8_LAS unsigned char*)smem, g, S, E, nullptr); }
        for (int j = c * 8 + w; j < NTOK / 16; j += G * 8) glr_job(p, j, lane); }
    PH_SYNC(2);
    if (PH_ON(2)) { for (int it = c; it < 512; it += G) moba_prep_item(p, smem, it);
        for (int it = c; it < 1024; it += G) gla_prep_item(p, smem, it); }
    PH_SYNC(3);
    if (PH_ON(3)) for (;;) { __syncthreads(); if (tid == 0) s_item = (int)atomicAdd(ctrl, 1u); __syncthreads(); const int it = s_item; if (it >= 128 + 1024) break;
        if (it < 128) gla_item(p, smem, it); else moba_item(p, smem, it - 128); }
    PH_SYNC(4);
    if (PH_ON(4)) gla_final(p);
    PH_SYNC(5);
    if (PH_ON(5)) { pg8::Gemm g{(const bf16_t*)(p.ws + WS_MIX), (const bf16_t*)(p.ws + WS_WOUTT), NTOK, DM, DM}; pg8::StaticOrder S; S.init(NTOK, DM, G, c);
        EpiRes E{p.out, p.x, DM}; pg8::gemm_phase<EpiRes, pg8::StaticOrder, false>((PG8_LAS unsigned char*)smem, g, S, E, nullptr); }
    PH_SYNC(6);
    if (PH_ON(6)) { bf16_t* HB = (bf16_t*)(p.ws + WS_HB);
        for (int r = c * 8 + w; r < NTOK; r += G * 8) rms_row<true>(p.out + (size_t)r * DM, p.g2, HB + (size_t)r * DM, (unsigned*)(p.ws + WS_HB8) + (size_t)r * (DM / 4), lane);
        (void)0; }
    PH_SYNC(7);
    if (PH_ON(7)) { pg8::Gemm g{(const bf16_t*)(p.ws + WS_HB), (const bf16_t*)(p.ws + WS_WPQT), NTOK, 2048, DM}; pg8::StaticOrder S; S.init(NTOK, 2048, G, c);
        EpiF32 E{(float*)(p.ws + WS_Q), 2048}; pg8::gemm_phase<EpiF32, pg8::StaticOrder, false>((PG8_LAS unsigned char*)smem, g, S, E, nullptr); }
    PH_SYNC(8);
    if (PH_ON(8)) for (int it = c; it < NTOK / 16; it += G) peer_item(p, smem, it);
    PH_SYNC(9);
    if (PH_ON(9)) { pg8::Gemm g{(const bf16_t*)(p.ws + WS_HB8), (const bf16_t*)(p.ws + WS_UB), NTOK, NEXP, DM / 2}; pg8::StaticOrder S; S.init(NTOK, NEXP, G, c);
        EpiPeerW8 E{p.ws + WS_W, p.ws + WS_W8}; pg8::gemm_phase<EpiPeerW8, pg8::StaticOrder, false, true>((PG8_LAS unsigned char*)smem, g, S, E, nullptr); }
    PH_SYNC(10);
    if (PH_ON(10)) { pg8::Gemm g{(const bf16_t*)(p.ws + WS_W8), (const bf16_t*)(p.ws + WS_VTB), NTOK, DM, NEXP / 2}; pg8::StaticOrder S; S.init(NTOK, DM, G, c);
        EpiResSc E{p.out, p.out, DM, 1.f / (SC_W * SC_V)}; pg8::gemm_phase<EpiResSc, pg8::StaticOrder, false, true>((PG8_LAS unsigned char*)smem, g, S, E, nullptr); }
}

#ifndef MK_PER_PHASE
#define MK_PER_PHASE 0
#endif
extern "C" void kernel_launch(void* const* d_in, const int* in_sizes, int n_in, void* d_out, int out_size, void* d_ws, size_t ws_size, hipStream_t stream) {
    static int grid = 0;
    if (grid == 0) {
        if (n_in != 14 || out_size != NTOK * DM || ws_size < WS_END) { fprintf(stderr, "kernel_launch: unexpected shapes (n_in %d out %d ws %zu)\n", n_in, out_size, ws_size); grid = -1; return; }
        int dev = 0, cus = 0, per_cu = 0;
        hipGetDevice(&dev); hipDeviceGetAttribute(&cus, hipDeviceAttributeMultiprocessorCount, dev);
        if (hipFuncSetAttribute((const void*)hymba_fwd, hipFuncAttributeMaxDynamicSharedMemorySize, LDS_BYTES) != hipSuccess) { fprintf(stderr, "kernel_launch: hipFuncSetAttribute failed\n"); grid = -1; return; }
        if (hipOccupancyMaxActiveBlocksPerMultiprocessor(&per_cu, (const void*)hymba_fwd, 512, LDS_BYTES) != hipSuccess || per_cu < 1) { fprintf(stderr, "kernel_launch: occupancy query failed (%d)\n", per_cu); grid = -1; return; }
        grid = cus * (per_cu > 1 ? 1 : per_cu);
        fprintf(stderr, "kernel_launch: %d CUs, %d blocks/CU by query, grid %d\n", cus, per_cu, grid);
    }
    if (grid < 0) return;
    hipMemsetAsync((char*)d_ws + WS_CTRL, 0, 16384, stream);
    Params p{};
    p.x = (const float*)d_in[0]; p.g1 = (const float*)d_in[1]; p.win = (const float*)d_in[2]; p.wgu = (const float*)d_in[3]; p.bg = (const float*)d_in[4]; p.glang = (const float*)d_in[5];
    p.qng = (const float*)d_in[6]; p.kng = (const float*)d_in[7]; p.wout = (const float*)d_in[8]; p.g2 = (const float*)d_in[9]; p.wpq = (const float*)d_in[10]; p.pkeys = (const float*)d_in[11];
    p.pu = (const float*)d_in[12]; p.pv = (const float*)d_in[13]; p.out = (float*)d_out; p.ws = (unsigned char*)d_ws;
#if MK_PER_PHASE
    for (int ph = 0; ph < NPHASE; ++ph) { p.ph_lo = ph; p.ph_hi = ph + 1; void* args[] = {&p};
        hipError_t e = hipLaunchCooperativeKernel((const void*)hymba_fwd, dim3(grid), dim3(512), args, LDS_BYTES, stream);
        if (e != hipSuccess) { fprintf(stderr, "cooperative launch failed: %s\n", hipGetErrorString(e)); break; } }
#else
    p.ph_lo = 0; p.ph_hi = NPHASE; void* args[] = {&p};
    hipError_t e = hipLaunchCooperativeKernel((const void*)hymba_fwd, dim3(grid), dim3(512), args, LDS_BYTES, stream);
    if (e != hipSuccess) fprintf(stderr, "cooperative launch failed: %s (grid %d)\n", hipGetErrorString(e), grid);
#endif
}
```

```cpp
#include <hip/hip_runtime.h>
#include <hip/hip_cooperative_groups.h>
#include <cstdio>
#include <cstdint>
namespace cg = cooperative_groups;
namespace pg8 {
#define PG8_LAS __attribute__((address_space(3)))
typedef unsigned short bf16_t;
typedef short bf16x8 __attribute__((ext_vector_type(8)));
typedef float f32x4 __attribute__((ext_vector_type(4)));
typedef unsigned u32x4 __attribute__((ext_vector_type(4)));
constexpr int BM = 256, BK = 64, HALF = 128, HTB = HALF * BK * 2  , STAGE_BYTES = 8 * HTB, NXCD = 8, WGM = 8;

__host__ __device__ __forceinline__ int lds_byte(int r, int c) { const int st = (r >> 4) * 2 + (c >> 5), rr = r & 15, cc = c & 31, ob = rr * 64 + cc * 2; return st * 1024 + (ob ^ (((ob >> 9) & 1) << 5)); }
__host__ __device__ __forceinline__ void stage_rc(int b, int& R, int& C) { const int st = b / 1024, sb = b % 1024, swz = sb ^ (((sb >> 9) & 1) << 5); R = (st >> 1) * 16 + swz / 64; C = (st & 1) * 32 + (swz % 64) / 2; }
__host__ __device__ __forceinline__ int perm32(int rho) { const int n = rho >> 4, i = rho & 15; return 8 * (i >> 2) + 4 * n + (i & 3); }

struct Unit { int pm, pn; };
struct Gemm { const bf16_t* A; const bf16_t* Bt; int M, N, K; };

struct StaticOrder {
    int nM, nN, nwg, G, c;
    __host__ __device__ void init(int M, int N, int G_, int c_) { nM = M / BM; nN = N / BM; nwg = nM * nN; G = G_; c = c_; }
    __host__ __device__ bool next(int i, Unit& u) const {
        const long L = (long)i * G + c; if (L >= nwg) return false;
        int wgid = (int)L; { const int q = nwg / NXCD, r = nwg % NXCD, xcd = wgid % NXCD, off = wgid / NXCD; wgid = (xcd < r ? xcd * (q + 1) : r * (q + 1) + (xcd - r) * q) + off; }
        const int nig = WGM * nN, gid = wgid / nig, fm = gid * WGM, gsz = (nM - fm) < WGM ? (nM - fm) : WGM;
        u.pm = fm + ((wgid % nig) % gsz); u.pn = (wgid % nig) / gsz; return true;
    }
    __device__ __forceinline__ void a_ready(const Unit&) const {}
    __device__ __forceinline__ void done(const Unit&) const {}
};
typedef __bf16 bf16x2_t __attribute__((ext_vector_type(2)));
typedef float f32x2c_t __attribute__((ext_vector_type(2)));
__device__ __forceinline__ unsigned cvt_pk_bf16(float lo, float hi) { f32x2c_t v = {lo, hi}; bf16x2_t b = __builtin_convertvector(v, bf16x2_t); return __builtin_bit_cast(unsigned, b); }
typedef float f32x2 __attribute__((ext_vector_type(2)));
__device__ __forceinline__ f32x2 gelu_pk(f32x2 v) {
    const f32x2 av = __builtin_elementwise_abs(v), d = av * 0.2316418882f + 1.0f;
    f32x2 t; t.x = __builtin_amdgcn_rcpf(d.x); t.y = __builtin_amdgcn_rcpf(d.y);
    f32x2 q = t * 0.5307027145f + (-0.7265760135f); q = q * t + 0.7107068705f; q = q * t + (-0.142248368f); q = q * t + 0.127414796f; q = q * t;
    const f32x2 s = (v * v) * (-0.72134752044f);
    f32x2 e; e.x = __builtin_amdgcn_exp2f(s.x); e.y = __builtin_amdgcn_exp2f(s.y);
    const f32x2 m = v * (q * e), r = v - m;
    f32x2 o; o.x = v.x < 0.f ? m.x : r.x; o.y = v.y < 0.f ? m.y : r.y; return o;
}

typedef int i32x4 __attribute__((ext_vector_type(4)));
typedef int i32x8 __attribute__((ext_vector_type(8)));
__device__ __forceinline__ i32x8 cat16(const bf16x8 a, const bf16x8 b) { const i32x4 lo = __builtin_bit_cast(i32x4, a), hi = __builtin_bit_cast(i32x4, b); return __builtin_shufflevector(lo, hi, 0, 1, 2, 3, 4, 5, 6, 7); }
template <bool F8> __device__ __forceinline__ void mma_block(f32x4 (&accb)[4][2], const bf16x8 (&At)[4][2], const bf16x8 (&Bt)[2][2], const i32x8 (&At8)[4], const i32x8 (&Bt8)[2]) {
    if constexpr (F8) {
#pragma unroll
        for (int m = 0; m < 4; ++m)
#pragma unroll
            for (int n = 0; n < 2; ++n) asm volatile("v_mfma_f32_16x16x128_f8f6f4 %0, %1, %2, %0" : "+v"(accb[m][n]) : "v"(Bt8[n]), "v"(At8[m]));
    } else {
#pragma unroll
        for (int m = 0; m < 4; ++m)
#pragma unroll
            for (int n = 0; n < 2; ++n)
#pragma unroll
                for (int k = 0; k < 2; ++k) accb[m][n] = __builtin_amdgcn_mfma_f32_16x16x32_bf16(Bt[n][k], At[m][k], accb[m][n], 0, 0, 0);
    }
}
template <class Epi, class Sched, bool STAMP = false, bool F8 = false>
__device__ __forceinline__ void gemm_phase(PG8_LAS unsigned char* lds, const Gemm g, const Sched& S, const Epi& E, unsigned long long* stamps) {
    const int tid = threadIdx.x, wid = __builtin_amdgcn_readfirstlane(tid >> 6), lane = tid & 63, wr = wid >> 2, wc = wid & 3, fr = lane & 15, fq = lane >> 4;
    const int K = g.K, nt = K / BK;
    int ts_lo = 0, ts_hi = 0, nts = 0; const unsigned long long rt_entry = STAMP ? (unsigned long long)wall_clock64() : 0ull;
#define PG8_STAMP() do { if (STAMP && wid == 0 && nts < 64) { const unsigned long long _c = (unsigned long long)clock64(); \
        ts_lo = (lane == nts) ? (int)(unsigned)_c : ts_lo; ts_hi = (lane == nts) ? (int)(unsigned)(_c >> 32) : ts_hi; ++nts; } } while (0)
    PG8_STAMP();
    unsigned voffA[2], voffB[2];
#pragma unroll
    for (int i = 0; i < 2; ++i) { int R, C; stage_rc(tid * 16 + i * 8192, R, C); const int Rb = Epi::PERM ? ((R & ~31) + perm32(R & 31)) : R;
        voffA[i] = (unsigned)(R * K + C) * 2u; voffB[i] = (unsigned)(Rb * K + C) * 2u; }
    const size_t kstep = (size_t)(BK * 2);
    const size_t hstep = (size_t)HALF * K * 2;
    const size_t tstep = 2 * hstep;
    const unsigned ldsw = (unsigned)wid * 1024u;
    const int aoff = lds_byte(wr * 64 + fr, fq * 8), boff = lds_byte(wc * 32 + fr, fq * 8);
#define PG8_SA(b, h) (((b) * 2 + (h)) * HTB)
#define PG8_SB(b, h) ((4 + (b) * 2 + (h)) * HTB)
#define PG8_STAGE(bufoff, gbase, voff) do { _Pragma("unroll") for (int _i = 0; _i < 2; ++_i) \
        __builtin_amdgcn_global_load_lds((const unsigned*)((const char*)(gbase) + (voff)[_i]), (PG8_LAS unsigned*)(lds + (bufoff) + ldsw + _i * 8192), 16, 0, 0); } while (0)
#define PG8_LDA(dst, b, h) do { _Pragma("unroll") for (int m = 0; m < 4; ++m) { if constexpr (F8) dst##8[m] = cat16(*(const PG8_LAS bf16x8*)(lds + PG8_SA(b, h) + aoff + m * 2048), *(const PG8_LAS bf16x8*)(lds + PG8_SA(b, h) + aoff + m * 2048 + 1024)); else { _Pragma("unroll") for (int k = 0; k < 2; ++k) dst[m][k] = *(const PG8_LAS bf16x8*)(lds + PG8_SA(b, h) + aoff + m * 2048 + k * 1024); } } } while (0)
#define PG8_LDB(dst, b, h) do { _Pragma("unroll") for (int n = 0; n < 2; ++n) { if constexpr (F8) dst##8[n] = cat16(*(const PG8_LAS bf16x8*)(lds + PG8_SB(b, h) + boff + n * 2048), *(const PG8_LAS bf16x8*)(lds + PG8_SB(b, h) + boff + n * 2048 + 1024)); else { _Pragma("unroll") for (int k = 0; k < 2; ++k) dst[n][k] = *(const PG8_LAS bf16x8*)(lds + PG8_SB(b, h) + boff + n * 2048 + k * 1024); } } } while (0)
#define PG8_MMA(ai, bj, At, Bt) do { __builtin_amdgcn_s_setprio(1); mma_block<F8>(acc[ai][bj], At, Bt, At##8, Bt##8); __builtin_amdgcn_s_setprio(0); } while (0)
#define PG8_WAIT_V(n) asm volatile("s_waitcnt vmcnt(" #n ")" ::: "memory")
#define PG8_WAIT_L(n) asm volatile("s_waitcnt lgkmcnt(" #n ")" ::: "memory")
#define PG8_BAR __builtin_amdgcn_s_barrier()
#define PG8_SCHED __builtin_amdgcn_sched_barrier(0)
    Unit cur, nxt; int ui = 0;
    if (!S.next(0, cur)) return;
    f32x4 acc[2][2][4][2];
#pragma unroll
    for (int a = 0; a < 2; ++a)
#pragma unroll
        for (int b = 0; b < 2; ++b)
#pragma unroll
            for (int m = 0; m < 4; ++m)
#pragma unroll
                for (int n = 0; n < 2; ++n) acc[a][b][m][n] = (f32x4){0.f, 0.f, 0.f, 0.f};
    bf16x8 At[4][2], B0[2][2], B1[2][2]; i32x8 At8[4], B08[2], B18[2];
    const char* cA = (const char*)g.A + (size_t)cur.pm * tstep; const char* cB = (const char*)g.Bt + (size_t)cur.pn * tstep;
    S.a_ready(cur);
    PG8_STAGE(PG8_SB(0, 0), cB, voffB); PG8_STAGE(PG8_SA(0, 0), cA, voffA); PG8_STAGE(PG8_SB(0, 1), cB + hstep, voffB); PG8_STAGE(PG8_SA(0, 1), cA + hstep, voffA);
    if (wr == 1) PG8_BAR;
    PG8_WAIT_V(4); PG8_BAR;
    PG8_STAGE(PG8_SB(1, 0), cB + kstep, voffB); PG8_STAGE(PG8_SA(1, 0), cA + kstep, voffA); PG8_STAGE(PG8_SB(1, 1), cB + hstep + kstep, voffB);
    PG8_WAIT_V(6); PG8_BAR;
    PG8_STAMP();
    for (;;) {
        const bool has_next = S.next(ui + 1, nxt);
        const char* nA = has_next ? (const char*)g.A + (size_t)nxt.pm * tstep : cA; const char* nB = has_next ? (const char*)g.Bt + (size_t)nxt.pn * tstep : cB;
        for (int t = 0; t < nt; t += 2) {
            const bool last = (t == nt - 2);
            const char* a1 = cA + (size_t)(t + 1) * kstep;
            const char* a2 = last ? nA : cA + (size_t)(t + 2) * kstep; const char* b2 = last ? nB : cB + (size_t)(t + 2) * kstep;
            const char* a3 = a2 + kstep; const char* b3 = b2 + kstep;
            if (last && has_next) S.a_ready(nxt);
            PG8_LDB(B0, 0, 0); PG8_SCHED; PG8_LDA(At, 0, 0); PG8_STAGE(PG8_SA(1, 1), a1 + hstep, voffA);
            PG8_WAIT_L(8); PG8_BAR; PG8_WAIT_L(0); PG8_MMA(0, 0, At, B0); PG8_BAR; PG8_SCHED;
            PG8_LDB(B1, 0, 1); PG8_STAGE(PG8_SB(0, 0), b2, voffB);
            PG8_BAR; PG8_WAIT_L(0); PG8_MMA(0, 1, At, B1); PG8_BAR;
            PG8_LDA(At, 0, 1); PG8_STAGE(PG8_SA(0, 0), a2, voffA);
            PG8_BAR; PG8_WAIT_L(0); PG8_MMA(1, 0, At, B0); PG8_BAR; PG8_SCHED;
            PG8_STAGE(PG8_SB(0, 1), b2 + hstep, voffB);
            PG8_WAIT_V(6); PG8_BAR; PG8_MMA(1, 1, At, B1); PG8_BAR;
            PG8_LDB(B0, 1, 0); PG8_SCHED; PG8_LDA(At, 1, 0); PG8_STAGE(PG8_SA(0, 1), a2 + hstep, voffA);
            PG8_WAIT_L(8); PG8_BAR; PG8_WAIT_L(0); PG8_MMA(0, 0, At, B0); PG8_BAR; PG8_SCHED;
            PG8_LDB(B1, 1, 1); PG8_STAGE(PG8_SB(1, 0), b3, voffB);
            PG8_BAR; PG8_WAIT_L(0); PG8_MMA(0, 1, At, B1); PG8_BAR;
            PG8_LDA(At, 1, 1); PG8_STAGE(PG8_SA(1, 0), a3, voffA);
            PG8_BAR; PG8_WAIT_L(0); PG8_MMA(1, 0, At, B0); PG8_BAR; PG8_SCHED;
            PG8_STAGE(PG8_SB(1, 1), b3 + hstep, voffB);
            PG8_WAIT_V(6); PG8_BAR; PG8_MMA(1, 1, At, B1); PG8_BAR;
        }
        PG8_STAMP();
        if constexpr (!Epi::AFTER_DRAIN) { E(acc, cur, wr, wc, fr, fq); S.done(cur); }
        PG8_STAMP();
        if (!has_next) break;
#pragma unroll
        for (int a = 0; a < 2; ++a)
#pragma unroll
            for (int b = 0; b < 2; ++b)
#pragma unroll
                for (int m = 0; m < 4; ++m)
#pragma unroll
                    for (int n = 0; n < 2; ++n) acc[a][b][m][n] = (f32x4){0.f, 0.f, 0.f, 0.f};
        cur = nxt; cA = nA; cB = nB; ++ui;
    }
    PG8_WAIT_V(0);
    if (wr == 0) PG8_BAR;
    PG8_BAR;
    if constexpr (Epi::AFTER_DRAIN) { E.fused(acc, cur, wr, wc, fr, fq, lds, wid, lane); S.done(cur); }
    PG8_STAMP();
    if (STAMP && wid == 0) { stamps[lane] = lane < nts ? (((unsigned long long)(unsigned)ts_hi << 32) | (unsigned)ts_lo) : 0ull;
        if (lane == 62) stamps[62] = rt_entry; if (lane == 63) stamps[63] = (unsigned long long)wall_clock64(); }
#undef PG8_STAMP
#undef PG8_SA
#undef PG8_SB
#undef PG8_STAGE
#undef PG8_LDA
#undef PG8_LDB
#undef PG8_MMA
#undef PG8_WAIT_V
#undef PG8_WAIT_L
#undef PG8_BAR
#undef PG8_SCHED
}
}

using pg8::bf16_t; using pg8::bf16x8; using pg8::f32x4; using pg8::f32x2; using pg8::cvt_pk_bf16; using pg8::Unit;
typedef unsigned long long u64;

constexpr int NTOK = 8192, DM = 4096, SEQL = 2048;
constexpr int NIN = 12304, NINP = 12544, PROJW = 12288;
constexpr int NEXP = 16384;
constexpr size_t MiB = 1024ull * 1024ull;
constexpr size_t WS_CTRL = 0, WS_KM = 1 * MiB, WS_GLR = 2 * MiB, WS_WINT = 4 * MiB, WS_WOUTT = 102 * MiB, WS_WPQT = 134 * MiB, WS_UB = 150 * MiB, WS_VTB = 278 * MiB,
                 WS_HB = 406 * MiB, WS_MIX = 470 * MiB, WS_OG = 534 * MiB, WS_PROJ = 598 * MiB, WS_QN = 790 * MiB, WS_KN = 822 * MiB, WS_VTM = 854 * MiB, WS_HB8 = 886 * MiB, WS_END = 918 * MiB;
constexpr size_t WS_W = WS_PROJ;
constexpr size_t WS_W8 = WS_MIX;
constexpr size_t WS_WINT8 = WS_UB + 64 * MiB;
constexpr size_t WS_KH = 2 * MiB + 512 * 1024, WS_KL = 3 * MiB;
constexpr size_t WS_Q = WS_OG;
constexpr int LDS_BYTES = 131072 + 16;
constexpr int NPHASE = 11;

struct Params {
    const float *x, *g1, *win, *wgu, *bg, *glang, *qng, *kng, *wout, *g2, *wpq, *pkeys, *pu, *pv;
    float* out; unsigned char* ws; int ph_lo, ph_hi;
};

__device__ __forceinline__ float bf2f(unsigned short b) { return __uint_as_float(((unsigned)b) << 16); }
__device__ __forceinline__ unsigned short f2bf(float f) { unsigned u = __float_as_uint(f); u += 0x7FFFu + ((u >> 16) & 1u); return (unsigned short)(u >> 16); }
constexpr float SC_X = 16.f, SC_U = 1024.f, SC_W = 64.f, SC_V = 128.f;
__device__ __forceinline__ float clamp_f8(float x) { return __builtin_fminf(__builtin_fmaxf(x, -448.f), 448.f); }
__device__ __forceinline__ unsigned pk4_fp8(float a, float b, float c, float d) {
    int r = __builtin_amdgcn_cvt_pk_fp8_f32(clamp_f8(a), clamp_f8(b), 0, false); r = __builtin_amdgcn_cvt_pk_fp8_f32(clamp_f8(c), clamp_f8(d), r, true); return (unsigned)r; }
__device__ __forceinline__ float row16_max(float v) {
    v = fmaxf(v, __builtin_bit_cast(float, __builtin_amdgcn_update_dpp(0, __builtin_bit_cast(int, v), 0xB1, 0xF, 0xF, true)));
    v = fmaxf(v, __builtin_bit_cast(float, __builtin_amdgcn_update_dpp(0, __builtin_bit_cast(int, v), 0x4E, 0xF, 0xF, true)));
    v = fmaxf(v, __builtin_bit_cast(float, __builtin_amdgcn_update_dpp(0, __builtin_bit_cast(int, v), 0x141, 0xF, 0xF, true)));
    v = fmaxf(v, __builtin_bit_cast(float, __builtin_amdgcn_update_dpp(0, __builtin_bit_cast(int, v), 0x140, 0xF, 0xF, true)));
    return v;
}
__device__ __forceinline__ float row16_sum(float v) {
    v += __builtin_bit_cast(float, __builtin_amdgcn_update_dpp(0, __builtin_bit_cast(int, v), 0xB1, 0xF, 0xF, true));
    v += __builtin_bit_cast(float, __builtin_amdgcn_update_dpp(0, __builtin_bit_cast(int, v), 0x4E, 0xF, 0xF, true));
    v += __builtin_bit_cast(float, __builtin_amdgcn_update_dpp(0, __builtin_bit_cast(int, v), 0x141, 0xF, 0xF, true));
    v += __builtin_bit_cast(float, __builtin_amdgcn_update_dpp(0, __builtin_bit_cast(int, v), 0x140, 0xF, 0xF, true));
    return v;
}
__device__ __forceinline__ float wave_sum(float v) { v = row16_sum(v); v += __shfl_xor(v, 16); v += __shfl_xor(v, 32); return v; }
#define LDS_WAIT() asm volatile("s_waitcnt lgkmcnt(0)" ::: "memory")
#define MFMA16(a, b, c) __builtin_amdgcn_mfma_f32_16x16x32_bf16((a), (b), (c), 0, 0, 0)

__device__ __forceinline__ int win_remap(int n) { return n < 6144 ? n : (n < 6160 ? 12288 + (n - 6144) : n - 16); }
__device__ __forceinline__ void transpose_item(const float* W, int K, int N, int ld, bf16_t* WT, unsigned* T, int item, int lane, bool remap) {
    const int nblk = (N + 63) >> 6, kb = item / nblk, nb = item - kb * nblk, k0 = 64 * kb, n0 = 64 * nb;
    const int r4 = lane >> 4, cc = lane & 15, nn = n0 + 4 * cc; const bool ok = nn < N;
    float4 v[16];
#pragma unroll
    for (int jj = 0; jj < 8; ++jj)
#pragma unroll
        for (int bb = 0; bb < 2; ++bb) { const int kk = 8 * jj + 2 * r4 + bb; v[2 * jj + bb] = ok ? *(const float4*)(W + (size_t)(k0 + kk) * ld + nn) : make_float4(0.f, 0.f, 0.f, 0.f); }
#pragma unroll
    for (int jj = 0; jj < 8; ++jj) { const float4 a = v[2 * jj], bq = v[2 * jj + 1]; const int kw = 4 * jj + r4;
        T[(4 * cc + 0) * 33 + kw] = cvt_pk_bf16(a.x, bq.x); T[(4 * cc + 1) * 33 + kw] = cvt_pk_bf16(a.y, bq.y);
        T[(4 * cc + 2) * 33 + kw] = cvt_pk_bf16(a.z, bq.z); T[(4 * cc + 3) * 33 + kw] = cvt_pk_bf16(a.w, bq.w); }
    LDS_WAIT();
    const int kc = lane & 7;
#pragma unroll
    for (int jr = 0; jr < 8; ++jr) { const int n = (lane >> 3) + 8 * jr, ns = n0 + n; const unsigned* tp = T + n * 33 + 4 * kc;
        uint4 o; o.x = tp[0]; o.y = tp[1]; o.z = tp[2]; o.w = tp[3];
        if (ns < N) { const int nd = remap ? win_remap(ns) : ns; *(uint4*)(WT + (size_t)nd * K + k0 + 8 * kc) = o; } }
    LDS_WAIT();
}
__device__ __forceinline__ void transpose_item8(const float* W, int K, int N, int ld, unsigned char* WT, unsigned* T, int item, int lane, float sc) {
    const int nblk = (N + 63) >> 6, kb = item / nblk, nb = item - kb * nblk, k0 = 64 * kb, n0 = 64 * nb;
    const int r4 = lane >> 4, cc = lane & 15, nn = n0 + 4 * cc;
    float4 v[16];
#pragma unroll
    for (int jj = 0; jj < 4; ++jj)
#pragma unroll
        for (int bb = 0; bb < 4; ++bb) { const int kk = 16 * jj + 4 * r4 + bb; v[4 * jj + bb] = *(const float4*)(W + (size_t)(k0 + kk) * ld + nn); }
#pragma unroll
    for (int jj = 0; jj < 4; ++jj) { const float4 a = v[4 * jj], b = v[4 * jj + 1], c = v[4 * jj + 2], d = v[4 * jj + 3]; const int kw = 4 * jj + r4;
        T[(4 * cc + 0) * 17 + kw] = pk4_fp8(a.x * sc, b.x * sc, c.x * sc, d.x * sc); T[(4 * cc + 1) * 17 + kw] = pk4_fp8(a.y * sc, b.y * sc, c.y * sc, d.y * sc);
        T[(4 * cc + 2) * 17 + kw] = pk4_fp8(a.z * sc, b.z * sc, c.z * sc, d.z * sc); T[(4 * cc + 3) * 17 + kw] = pk4_fp8(a.w * sc, b.w * sc, c.w * sc, d.w * sc); }
    LDS_WAIT();
    const int kc = lane & 3;
#pragma unroll
    for (int jr = 0; jr < 4; ++jr) { const int n = (lane >> 2) + 16 * jr; const unsigned* tp = T + n * 17 + 4 * kc;
        uint4 o; o.x = tp[0]; o.y = tp[1]; o.z = tp[2]; o.w = tp[3];
        *(uint4*)(WT + (size_t)(n0 + n) * K + k0 + 16 * kc) = o; }
    LDS_WAIT();
}
template <bool F8OUT> __device__ __forceinline__ void rms_row(const float* xrow, const float* g, bf16_t* orow, unsigned* orow8, int lane) {
    const float4* xr = (const float4*)xrow + lane; float4 v[16]; float s = 0.f;
#pragma unroll
    for (int j = 0; j < 16; ++j) { v[j] = xr[64 * j]; s += (v[j].x * v[j].x + v[j].y * v[j].y) + (v[j].z * v[j].z + v[j].w * v[j].w); }
    const float r = rsqrtf(wave_sum(s) * (1.f / DM) + 1e-6f);
    const float4* gr = (const float4*)g + lane; uint2* o8 = (uint2*)orow + lane;
#pragma unroll
    for (int j = 0; j < 16; ++j) { const float4 gg = gr[64 * j]; const float y0 = (v[j].x * r) * gg.x, y1 = (v[j].y * r) * gg.y, y2 = (v[j].z * r) * gg.z, y3 = (v[j].w * r) * gg.w;
        uint2 o; o.x = cvt_pk_bf16(y0, y1); o.y = cvt_pk_bf16(y2, y3); o8[64 * j] = o;
        if (F8OUT) orow8[64 * j + lane] = pk4_fp8(y0 * SC_X, y1 * SC_X, y2 * SC_X, y3 * SC_X); }
}
__device__ __forceinline__ void phase_prep(const Params& p, unsigned char* sm) {
    const int tid = threadIdx.x, lane = tid & 63, w = tid >> 6;
    unsigned* scr = (unsigned*)(sm + w * 8704);
    const int gw = blockIdx.x * 8 + w, NGW = gridDim.x * 8;
    constexpr int I_WIN = 64 * 97, I_WIN8 = 64 * 96, I_WOUT = 64 * 64, I_WPQ = 64 * 32, I_PV = 256 * 64, I_PU = NEXP, I_X = NTOK;
    constexpr int NITEMS = I_WIN + I_WIN8 + I_WOUT + I_WPQ + I_PV + I_PU + I_X;
    bf16_t* WinT = (bf16_t*)(p.ws + WS_WINT); bf16_t* WoutT = (bf16_t*)(p.ws + WS_WOUTT); bf16_t* WpqT = (bf16_t*)(p.ws + WS_WPQT);
    unsigned* UB8 = (unsigned*)(p.ws + WS_UB); unsigned char* VTB8 = p.ws + WS_VTB; bf16_t* HB = (bf16_t*)(p.ws + WS_HB);
    { unsigned* KH = (unsigned*)(p.ws + WS_KH); unsigned* KL = (unsigned*)(p.ws + WS_KL);
      for (int i = blockIdx.x * 512 + tid; i < 8 * 2 * 128 * 128 / 2; i += gridDim.x * 512) { const float2 v = ((const float2*)p.pkeys)[i];
          const unsigned h = cvt_pk_bf16(v.x, v.y); KH[i] = h; KL[i] = cvt_pk_bf16(v.x - bf2f(h & 0xffff), v.y - bf2f(h >> 16)); } }
    for (int it = NITEMS - 1 - gw; it >= 0; it -= NGW) {
        int r = it;
        if (r < I_X) { rms_row<true>(p.x + (size_t)r * DM, p.g1, HB + (size_t)r * DM, (unsigned*)(p.ws + WS_HB8) + (size_t)r * (DM / 4), lane); continue; } r -= I_X;
        if (r < I_WIN) { transpose_item(p.win, DM, 6160, NIN, WinT, scr, r, lane, true); continue; } r -= I_WIN;
        if (r < I_WIN8) { transpose_item8(p.win + 6160, DM, 6144, NIN, p.ws + WS_WINT8, scr, r, lane, SC_U); continue; } r -= I_WIN8;
        if (r < I_WOUT) { transpose_item(p.wout, DM, DM, DM, WoutT, scr, r, lane, false); continue; } r -= I_WOUT;
        if (r < I_WPQ) { transpose_item(p.wpq, DM, 2048, 2048, WpqT, scr, r, lane, false); continue; } r -= I_WPQ;
        if (r < I_PV) { transpose_item8(p.pv, NEXP, DM, DM, VTB8, scr, r, lane, SC_V); continue; } r -= I_PV;
        { const float4* src = (const float4*)(p.pu + (size_t)r * DM) + lane; unsigned* dst = UB8 + (size_t)r * (DM / 4) + lane;
          float4 v[16];
#pragma unroll
          for (int j = 0; j < 16; ++j) v[j] = src[64 * j];
#pragma unroll
          for (int j = 0; j < 16; ++j) dst[64 * j] = pk4_fp8(v[j].x * SC_U, v[j].y * SC_U, v[j].z * SC_U, v[j].w * SC_U); }
    }
}

struct EpiProj {
    static constexpr bool PERM = true, AFTER_DRAIN = false;
    bf16_t* P; int coff; float sc;
    __device__ __forceinline__ void operator()(const f32x4 (&acc)[2][2][4][2], const Unit& u, int wr, int wc, int fr, int fq) const {
        const int row0 = u.pm * 256 + wr * 64 + fr, col0 = coff + u.pn * 256 + wc * 32 + 8 * fq;
#pragma unroll
        for (int ai = 0; ai < 2; ++ai)
#pragma unroll
            for (int m = 0; m < 4; ++m) { bf16_t* rowp = P + (size_t)(row0 + ai * 128 + m * 16) * PROJW + col0;
#pragma unroll
                for (int bj = 0; bj < 2; ++bj) { const f32x4 v0 = acc[ai][bj][m][0] * sc, v1 = acc[ai][bj][m][1] * sc;
                    uint4 o; o.x = cvt_pk_bf16(v0[0], v0[1]); o.y = cvt_pk_bf16(v0[2], v0[3]); o.z = cvt_pk_bf16(v1[0], v1[1]); o.w = cvt_pk_bf16(v1[2], v1[3]);
                    *(uint4*)(rowp + bj * 128) = o; } }
    }
};
struct EpiRes {
    static constexpr bool PERM = false, AFTER_DRAIN = false;
    float* C; const float* R; int ldc;
    __device__ __forceinline__ void operator()(const f32x4 (&acc)[2][2][4][2], const Unit& u, int wr, int wc, int fr, int fq) const {
        const int row0 = u.pm * 256 + wr * 64 + fr, col0 = u.pn * 256 + wc * 32 + 4 * fq;
#pragma unroll
        for (int ai = 0; ai < 2; ++ai)
#pragma unroll
            for (int m = 0; m < 4; ++m) { const size_t ro = (size_t)(row0 + ai * 128 + m * 16) * ldc + col0;
#pragma unroll
                for (int bj = 0; bj < 2; ++bj)
#pragma unroll
                    for (int n = 0; n < 2; ++n) { const f32x4 r = *(const f32x4*)(R + ro + bj * 128 + n * 16); *(f32x4*)(C + ro + bj * 128 + n * 16) = r + acc[ai][bj][m][n]; } }
    }
};
struct EpiF32 {
    static constexpr bool PERM = false, AFTER_DRAIN = false;
    float* C; int ldc;
    __device__ __forceinline__ void operator()(const f32x4 (&acc)[2][2][4][2], const Unit& u, int wr, int wc, int fr, int fq) const {
        const int row0 = u.pm * 256 + wr * 64 + fr, col0 = u.pn * 256 + wc * 32 + 4 * fq;
#pragma unroll
        for (int ai = 0; ai < 2; ++ai)
#pragma unroll
            for (int m = 0; m < 4; ++m) { float* rowp = C + (size_t)(row0 + ai * 128 + m * 16) * ldc + col0;
#pragma unroll
                for (int bj = 0; bj < 2; ++bj)
#pragma unroll
                    for (int n = 0; n < 2; ++n) *(f32x4*)(rowp + bj * 128 + n * 16) = acc[ai][bj][m][n]; }
    }
};
struct EpiResSc {
    static constexpr bool PERM = false, AFTER_DRAIN = false;
    float* C; const float* R; int ldc; float sc;
    __device__ __forceinline__ void operator()(const f32x4 (&acc)[2][2][4][2], const Unit& u, int wr, int wc, int fr, int fq) const {
        const int row0 = u.pm * 256 + wr * 64 + fr, col0 = u.pn * 256 + wc * 32 + 4 * fq;
#pragma unroll
        for (int ai = 0; ai < 2; ++ai)
#pragma unroll
            for (int m = 0; m < 4; ++m) { const size_t ro = (size_t)(row0 + ai * 128 + m * 16) * ldc + col0;
#pragma unroll
                for (int bj = 0; bj < 2; ++bj)
#pragma unroll
                    for (int n = 0; n < 2; ++n) { const f32x4 r = *(const f32x4*)(R + ro + bj * 128 + n * 16); *(f32x4*)(C + ro + bj * 128 + n * 16) = r + acc[ai][bj][m][n] * sc; } }
    }
};
constexpr float SC_G = 128.f;
struct EpiPeerW8 {
    static constexpr bool PERM = true, AFTER_DRAIN = false;
    const unsigned char* Gw; unsigned char* W8;
    __device__ __forceinline__ void operator()(const f32x4 (&acc)[2][2][4][2], const Unit& u, int wr, int wc, int fr, int fq) const {
        const int row0 = u.pm * 256 + wr * 64 + fr, col0 = u.pn * 256 + wc * 32 + 8 * fq; constexpr float isc = 1.f / (SC_X * SC_U), gsc = SC_W / SC_G;
#pragma unroll
        for (int ai = 0; ai < 2; ++ai)
#pragma unroll
            for (int m = 0; m < 4; ++m) { const size_t ro = (size_t)(row0 + ai * 128 + m * 16) * NEXP + col0;
#pragma unroll
                for (int bj = 0; bj < 2; ++bj) { const uint2 gv = *(const uint2*)(Gw + ro + bj * 128); uint2 o = make_uint2(0u, 0u);
                    if ((gv.x | gv.y) != 0u) {
                        const f32x4 v0 = acc[ai][bj][m][0] * isc, v1 = acc[ai][bj][m][1] * isc;
                        const f32x2 a = pg8::gelu_pk((f32x2){v0[0], v0[1]}), b = pg8::gelu_pk((f32x2){v0[2], v0[3]}), c = pg8::gelu_pk((f32x2){v1[0], v1[1]}), d = pg8::gelu_pk((f32x2){v1[2], v1[3]});
                        const int gx = (int)gv.x, gy = (int)gv.y;
                        o.x = pk4_fp8(a.x * __builtin_amdgcn_cvt_f32_fp8(gx, 0) * gsc, a.y * __builtin_amdgcn_cvt_f32_fp8(gx, 1) * gsc, b.x * __builtin_amdgcn_cvt_f32_fp8(gx, 2) * gsc, b.y * __builtin_amdgcn_cvt_f32_fp8(gx, 3) * gsc);
                        o.y = pk4_fp8(c.x * __builtin_amdgcn_cvt_f32_fp8(gy, 0) * gsc, c.y * __builtin_amdgcn_cvt_f32_fp8(gy, 1) * gsc, d.x * __builtin_amdgcn_cvt_f32_fp8(gy, 2) * gsc, d.y * __builtin_amdgcn_cvt_f32_fp8(gy, 3) * gsc); }
                    *(uint2*)(W8 + ro + bj * 128) = o; } }
    }
};

constexpr float QSCALE = 0.08838834764831845f * 1.4426950408889634f;
__device__ __forceinline__ void moba_prep_item(const Params& p, unsigned char* sm, int item) {
    const int tid = threadIdx.x, lane = tid & 63, w = tid >> 6;
    const int blk = item & 7, h = (item >> 3) & 15, b = item >> 7, bh = b * 16 + h;
    const bf16_t* proj = (const bf16_t*)(p.ws + WS_PROJ);
    bf16_t* QN = (bf16_t*)(p.ws + WS_QN); bf16_t* KN = (bf16_t*)(p.ws + WS_KN); bf16_t* VTM = (bf16_t*)(p.ws + WS_VTM); float* KM = (float*)(p.ws + WS_KM);
    bf16_t* VL = (bf16_t*)sm;
    float* KMS = (float*)(sm + 67584);
    const int d0 = 2 * lane;
    const float gq0 = p.qng[d0], gq1 = p.qng[d0 + 1], gk0 = p.kng[d0], gk1 = p.kng[d0 + 1];
    const int fi = d0 & 15;
    const float inv0 = exp2f(-(float)fi * (18.931568569324174f / 16.f)), inv1 = exp2f(-(float)(fi + 1) * (18.931568569324174f / 16.f));
    float km0 = 0.f, km1 = 0.f;
    __syncthreads();
    for (int t4 = 0; t4 < 32; t4 += 4) {
        unsigned qva[4], kva[4], vva[4];
#pragma unroll
        for (int u = 0; u < 4; ++u) { const int tt = w + 8 * (t4 + u); const bf16_t* pr = proj + ((size_t)b * SEQL + blk * 256 + tt) * PROJW;
            qva[u] = *(const unsigned*)(pr + 6144 + h * 128 + d0); kva[u] = *(const unsigned*)(pr + 8192 + h * 128 + d0); vva[u] = *(const unsigned*)(pr + 10240 + h * 128 + d0); }
#pragma unroll
        for (int u = 0; u < 4; ++u) { const int tt = w + 8 * (t4 + u); const int pos = blk * 256 + tt; const unsigned qv = qva[u], kv = kva[u], vv = vva[u];
        float q0 = bf2f(qv & 0xffff), q1 = bf2f(qv >> 16), k0 = bf2f(kv & 0xffff), k1 = bf2f(kv >> 16);
        const float rq = rsqrtf(wave_sum(q0 * q0 + q1 * q1) * (1.f / 128.f) + 1e-6f), rk = rsqrtf(wave_sum(k0 * k0 + k1 * k1) * (1.f / 128.f) + 1e-6f);
        q0 = (q0 * rq) * gq0; q1 = (q1 * rq) * gq1; k0 = (k0 * rk) * gk0; k1 = (k1 * rk) * gk1;
        const float pq0 = __shfl_xor(q0, 8), pq1 = __shfl_xor(q1, 8), pk0 = __shfl_xor(k0, 8), pk1 = __shfl_xor(k1, 8);
        if (lane < 16) {
            float a0 = (float)pos * inv0, a1 = (float)pos * inv1;
            float n0 = rintf(a0 * 0.15915494309189535f), n1 = rintf(a1 * 0.15915494309189535f);
            a0 = fmaf(-n0, 6.2831854820251465f, a0); a0 = fmaf(-n0, -1.7484555e-7f, a0);
            a1 = fmaf(-n1, 6.2831854820251465f, a1); a1 = fmaf(-n1, -1.7484555e-7f, a1);
            const float c0 = __cosf(a0), s0 = __sinf(a0), c1 = __cosf(a1), s1 = __sinf(a1);
            if (lane < 8) { q0 = q0 * c0 - pq0 * s0; q1 = q1 * c1 - pq1 * s1; k0 = k0 * c0 - pk0 * s0; k1 = k1 * c1 - pk1 * s1; }
            else          { q0 = q0 * c0 + pq0 * s0; q1 = q1 * c1 + pq1 * s1; k0 = k0 * c0 + pk0 * s0; k1 = k1 * c1 + pk1 * s1; }
        }
        km0 += k0; km1 += k1;
        const size_t o = ((size_t)bh * SEQL + pos) * 128 + d0;
        *(unsigned*)(QN + o) = cvt_pk_bf16(q0 * QSCALE, q1 * QSCALE);
        *(unsigned*)(KN + o) = cvt_pk_bf16(k0, k1);
        VL[d0 * 264 + tt] = (bf16_t)(vv & 0xffff); VL[(d0 + 1) * 264 + tt] = (bf16_t)(vv >> 16);
        } }
    KMS[w * 128 + d0] = km0; KMS[w * 128 + d0 + 1] = km1;
    __syncthreads();
    if (tid < 128) { float s = 0.f;
#pragma unroll
        for (int i = 0; i < 8; ++i) s += KMS[i * 128 + tid];
        KM[((size_t)bh * 8 + blk) * 128 + tid] = s * (1.f / 256.f); }
    for (int c = tid; c < 128 * 32; c += 512) { const int d = c >> 5, c8 = (c & 31) * 8;
        *(uint4*)(VTM + ((size_t)bh * 128 + d) * SEQL + blk * 256 + c8) = *(const uint4*)(VL + d * 264 + c8); }
}

__device__ __forceinline__ void glr_job(const Params& p, int job, int lane) {
    const int fr = lane & 15, fq = lane >> 4;
    const bf16_t* a = (const bf16_t*)(p.ws + WS_HB) + (size_t)(job * 16 + fr) * DM + fq * 8;
    const bf16_t* b = (const bf16_t*)(p.ws + WS_WINT) + (size_t)(12288 + fr) * DM + fq * 8;
    f32x4 acc0 = (f32x4){0.f, 0.f, 0.f, 0.f}, acc1 = acc0;
#pragma unroll 4
    for (int ks = 0; ks < 128; ks += 2) { const bf16x8 a0 = *(const bf16x8*)(a + ks * 32), b0 = *(const bf16x8*)(b + ks * 32), a1 = *(const bf16x8*)(a + ks * 32 + 32), b1 = *(const bf16x8*)(b + ks * 32 + 32);
        acc0 = MFMA16(a0, b0, acc0); acc1 = MFMA16(a1, b1, acc1); }
    float* glr = (float*)(p.ws + WS_GLR);
#pragma unroll
    for (int j = 0; j < 4; ++j) glr[(size_t)(job * 16 + fq * 4 + j) * 16 + fr] = acc0[j] + acc1[j];
}

constexpr size_t WS_GQD = WS_VTB + 64 * MiB, WS_GKI = WS_GQD + 16 * MiB, WS_GKST = WS_GKI + 16 * MiB, WS_GDEC = WS_GKST + 16 * MiB, WS_GVT = WS_HB8;
constexpr int GP_BC = 0, GP_GLR = 32768, GP_TOT = 36864, GP_KST = 38912, GP_VT = 57344;
__device__ __forceinline__ void gla_prep_item(const Params& p, unsigned char* sm, int item) {
    const int tid = threadIdx.x;
    const int h = item & 7, ch = item >> 3, t0 = ch * 64;
    float* BC = (float*)(sm + GP_BC); float* GLR = (float*)(sm + GP_GLR); float* TOT = (float*)(sm + GP_TOT); bf16_t* KST = (bf16_t*)(sm + GP_KST); bf16_t* VT = (bf16_t*)(sm + GP_VT);
    const bf16_t* proj = (const bf16_t*)(p.ws + WS_PROJ); const float* glr = (const float*)(p.ws + WS_GLR);
    bf16_t* QDg = (bf16_t*)(p.ws + WS_GQD) + (size_t)item * 8192; bf16_t* KIg = (bf16_t*)(p.ws + WS_GKI) + (size_t)item * 8192;
    bf16_t* KSTg = (bf16_t*)(p.ws + WS_GKST) + (size_t)item * 8192; bf16_t* VTg = (bf16_t*)(p.ws + WS_GVT) + (size_t)item * 16384; float* DECg = (float*)(p.ws + WS_GDEC) + (size_t)item * 128;
    __syncthreads();
    if (tid < 256) ((float4*)GLR)[tid] = ((const float4*)(glr + (size_t)t0 * 16))[tid];
    float wcol[16];
#pragma unroll
    for (int r = 0; r < 16; ++r) wcol[r] = p.wgu[r * 1024 + h * 128 + (tid & 127)];
    const float bias = p.bg[h * 128 + (tid & 127)];
    __syncthreads();
    {   const int d = tid & 127, part = tid >> 7; float la[16]; float run = 0.f;
#pragma unroll
        for (int i = 0; i < 16; ++i) { const float* gr = GLR + (part * 16 + i) * 16; float z = bias;
#pragma unroll
            for (int r = 0; r < 16; ++r) z = fmaf(gr[r], wcol[r], z);
            const float ls = fminf(z, 0.f) - __logf(1.f + __expf(-fabsf(z)));
            run += ls * (1.f / 16.f); la[i] = run; }
        TOT[part * 128 + d] = run;
        __syncthreads();
        float off = 0.f;
        for (int pp = 0; pp < part; ++pp) off += TOT[pp * 128 + d];
#pragma unroll
        for (int i = 0; i < 16; ++i) BC[(part * 16 + i) * 128 + d] = la[i] + off;
    }
    __syncthreads();
    if (tid < 128) DECg[tid] = __expf(BC[63 * 128 + tid]);
    for (int c = tid; c < 1024; c += 512) { const int s = c >> 4, dd = (c & 15) * 8;
        const bf16_t* pr = proj + (size_t)(t0 + s) * PROJW + h * 128 + dd;
        const uint4 qv = *(const uint4*)pr, kv = *(const uint4*)(pr + 1024);
        const unsigned qa[4] = {qv.x, qv.y, qv.z, qv.w}, ka[4] = {kv.x, kv.y, kv.z, kv.w};
        unsigned qo[4], ko[4];
#pragma unroll
        for (int i = 0; i < 4; ++i) {
            const float bc0 = BC[s * 128 + dd + 2 * i], bc1 = BC[s * 128 + dd + 2 * i + 1], bl0 = BC[63 * 128 + dd + 2 * i], bl1 = BC[63 * 128 + dd + 2 * i + 1];
            const float q0 = bf2f(qa[i] & 0xffff), q1 = bf2f(qa[i] >> 16), k0 = bf2f(ka[i] & 0xffff), k1 = bf2f(ka[i] >> 16);
            qo[i] = cvt_pk_bf16(q0 * 0.08838834764831845f * __expf(bc0), q1 * 0.08838834764831845f * __expf(bc1));
            ko[i] = cvt_pk_bf16(k0 * __expf(-bc0), k1 * __expf(-bc1));
            KST[(dd + 2 * i) * 72 + s] = f2bf(k0 * __expf(bl0 - bc0)); KST[(dd + 2 * i + 1) * 72 + s] = f2bf(k1 * __expf(bl1 - bc1)); }
        *(uint4*)(QDg + s * 128 + dd) = make_uint4(qo[0], qo[1], qo[2], qo[3]); *(uint4*)(KIg + s * 128 + dd) = make_uint4(ko[0], ko[1], ko[2], ko[3]); }
    for (int c = tid; c < 2048; c += 512) { const int s = c >> 5, e0 = (c & 31) * 8;
        const uint4 vv = *(const uint4*)(proj + (size_t)(t0 + s) * PROJW + 2048 + h * 256 + e0);
        const unsigned va[4] = {vv.x, vv.y, vv.z, vv.w};
#pragma unroll
        for (int i = 0; i < 4; ++i) { VT[(e0 + 2 * i) * 72 + s] = (bf16_t)(va[i] & 0xffff); VT[(e0 + 2 * i + 1) * 72 + s] = (bf16_t)(va[i] >> 16); } }
    __syncthreads();
    for (int c = tid; c < 1024; c += 512) { const int d = c >> 3, c8 = (c & 7) * 8; *(uint4*)(KSTg + d * 64 + c8) = *(const uint4*)(KST + d * 72 + c8); }
    for (int c = tid; c < 2048; c += 512) { const int e = c >> 3, c8 = (c & 7) * 8; *(uint4*)(VTg + e * 64 + c8) = *(const uint4*)(VT + e * 72 + c8); }
}
constexpr int GL_QD = 0, GL_KI = 17408, GL_KST = 34816, GL_VT = 53248, GL_ATT = 62464, GL_ST = 71680;
__device__ __forceinline__ void gla_item(const Params& p, unsigned char* sm, int item) {
    const int tid = threadIdx.x, lane = tid & 63, w = tid >> 6, fr = lane & 15, fq = lane >> 4;
    const int dvs = item & 3, h = (item >> 2) & 7, b = item >> 5;
    bf16_t* QD = (bf16_t*)(sm + GL_QD); bf16_t* KI = (bf16_t*)(sm + GL_KI); bf16_t* KST = (bf16_t*)(sm + GL_KST); bf16_t* VT = (bf16_t*)(sm + GL_VT);
    bf16_t* ATT = (bf16_t*)(sm + GL_ATT); bf16_t* ST = (bf16_t*)(sm + GL_ST);
    float* OG = (float*)(p.ws + WS_OG);
    const bf16_t* QDg = (const bf16_t*)(p.ws + WS_GQD); const bf16_t* KIg = (const bf16_t*)(p.ws + WS_GKI); const bf16_t* KSTg = (const bf16_t*)(p.ws + WS_GKST);
    const bf16_t* VTg = (const bf16_t*)(p.ws + WS_GVT); const float* DECg = (const float*)(p.ws + WS_GDEC);
    __syncthreads();
    for (int i = tid; i < 64 * 136 / 2; i += 512) ((unsigned*)ST)[i] = 0u;
    f32x4 Sacc[4];
#pragma unroll
    for (int i = 0; i < 4; ++i) Sacc[i] = (f32x4){0.f, 0.f, 0.f, 0.f};
    uint4 rq0, rq1, rk0, rk1, rs0, rs1, rv; float rd0, rd1, rd2, rd3;
#define GLA_FETCH(n_) do { const size_t it_ = (size_t)((b * 32 + (n_)) * 8 + h); \
        rq0 = *(const uint4*)(QDg + it_ * 8192 + tid * 8); rq1 = *(const uint4*)(QDg + it_ * 8192 + (tid + 512) * 8); \
        rk0 = *(const uint4*)(KIg + it_ * 8192 + tid * 8); rk1 = *(const uint4*)(KIg + it_ * 8192 + (tid + 512) * 8); \
        rs0 = *(const uint4*)(KSTg + it_ * 8192 + tid * 8); rs1 = *(const uint4*)(KSTg + it_ * 8192 + (tid + 512) * 8); \
        rv = *(const uint4*)(VTg + it_ * 16384 + (size_t)(dvs * 64) * 64 + tid * 8); \
        const float* dp_ = DECg + it_ * 128 + w * 16 + fq * 4; rd0 = dp_[0]; rd1 = dp_[1]; rd2 = dp_[2]; rd3 = dp_[3]; } while (0)
    GLA_FETCH(0);
    for (int n = 0; n < 32; ++n) {
        const int t0 = b * SEQL + n * 64;
        __syncthreads();
        { const int c0 = tid, c1 = tid + 512;
          *(uint4*)(QD + (c0 >> 4) * 136 + (c0 & 15) * 8) = rq0; *(uint4*)(QD + (c1 >> 4) * 136 + (c1 & 15) * 8) = rq1;
          *(uint4*)(KI + (c0 >> 4) * 136 + (c0 & 15) * 8) = rk0; *(uint4*)(KI + (c1 >> 4) * 136 + (c1 & 15) * 8) = rk1;
          *(uint4*)(KST + (c0 >> 3) * 72 + (c0 & 7) * 8) = rs0; *(uint4*)(KST + (c1 >> 3) * 72 + (c1 & 7) * 8) = rs1;
          *(uint4*)(VT + (tid >> 3) * 72 + (tid & 7) * 8) = rv; }
        const float dec[4] = {rd0, rd1, rd2, rd3};
        __syncthreads();
        if (n + 1 < 32) GLA_FETCH(n + 1);
        f32x4 oacc[2];
#pragma unroll
        for (int ti = 0; ti < 2; ++ti) { const int tile = 2 * w + ti, qt = tile >> 2, xt = tile & 3;
            f32x4 a = (f32x4){0.f, 0.f, 0.f, 0.f}, o = (f32x4){0.f, 0.f, 0.f, 0.f};
#pragma unroll
            for (int ks = 0; ks < 4; ++ks) { const bf16x8 af = *(const bf16x8*)(QD + (qt * 16 + fr) * 136 + ks * 32 + fq * 8);
                const bf16x8 bk = *(const bf16x8*)(KI + (xt * 16 + fr) * 136 + ks * 32 + fq * 8), bs = *(const bf16x8*)(ST + (xt * 16 + fr) * 136 + ks * 32 + fq * 8);
                a = MFMA16(af, bk, a); o = MFMA16(af, bs, o); }
#pragma unroll
            for (int j = 0; j < 4; ++j) { const int qq = qt * 16 + fq * 4 + j, ss = xt * 16 + fr; ATT[qq * 72 + ss] = f2bf(ss <= qq ? a[j] : 0.f); }
            oacc[ti] = o; }
        __syncthreads();
#pragma unroll
        for (int ti = 0; ti < 2; ++ti) { const int tile = 2 * w + ti, qt = tile >> 2, et = tile & 3; f32x4 o = oacc[ti];
#pragma unroll
            for (int ks = 0; ks < 2; ++ks) { const bf16x8 af = *(const bf16x8*)(ATT + (qt * 16 + fr) * 72 + ks * 32 + fq * 8), bv = *(const bf16x8*)(VT + (et * 16 + fr) * 72 + ks * 32 + fq * 8); o = MFMA16(af, bv, o); }
#pragma unroll
            for (int j = 0; j < 4; ++j) OG[(size_t)(t0 + qt * 16 + fq * 4 + j) * 2048 + h * 256 + dvs * 64 + et * 16 + fr] = o[j]; }
#pragma unroll
        for (int et = 0; et < 4; ++et) { f32x4 sv = Sacc[et];
#pragma unroll
            for (int j = 0; j < 4; ++j) sv[j] *= dec[j];
#pragma unroll
            for (int ks = 0; ks < 2; ++ks) { const bf16x8 af = *(const bf16x8*)(KST + (w * 16 + fr) * 72 + ks * 32 + fq * 8), bv = *(const bf16x8*)(VT + (et * 16 + fr) * 72 + ks * 32 + fq * 8); sv = MFMA16(af, bv, sv); }
            Sacc[et] = sv;
            uint2 pk; pk.x = cvt_pk_bf16(sv[0], sv[1]); pk.y = cvt_pk_bf16(sv[2], sv[3]);
            *(uint2*)(ST + (et * 16 + fr) * 136 + w * 16 + fq * 4) = pk; }
    }
}

constexpr int MB_KT = 0, MB_VT = 17408, MB_P = 35840, MB_MISC = 54272;
__device__ __forceinline__ void moba_item(const Params& p, unsigned char* sm, int item) {
    const int tid = threadIdx.x, lane = tid & 63, w = tid >> 6, fr = lane & 15, fq = lane >> 4;
    const int qt = 15 - (item >> 6), bh = item & 63, b = bh >> 4, h = bh & 15, q0 = qt * 128, blk = qt >> 1;
    const bf16_t* QNp = (const bf16_t*)(p.ws + WS_QN) + (size_t)bh * SEQL * 128; const bf16_t* KNp = (const bf16_t*)(p.ws + WS_KN) + (size_t)bh * SEQL * 128;
    const bf16_t* VTp = (const bf16_t*)(p.ws + WS_VTM) + (size_t)bh * 128 * SEQL; const float* KMp = (const float*)(p.ws + WS_KM) + (size_t)bh * 8 * 128;
    bf16_t* MIX = (bf16_t*)(p.ws + WS_MIX);
    bf16_t* KT = (bf16_t*)(sm + MB_KT); bf16_t* VT = (bf16_t*)(sm + MB_VT); bf16_t* Pw = (bf16_t*)(sm + MB_P) + w * 16 * 72; unsigned* bm = (unsigned*)(sm + MB_MISC);
    float* KMS = (float*)(sm + MB_MISC + 1024);
    __syncthreads();
    if (tid < blk * 32) ((float4*)KMS)[tid] = ((const float4*)KMp)[tid];
    if (tid == 0) *bm = 0u;
    __syncthreads();
    bf16x8 qf[4];
    { const bf16_t* qrow = QNp + (size_t)(q0 + w * 16 + fr) * 128;
#pragma unroll
      for (int ks = 0; ks < 4; ++ks) qf[ks] = *(const bf16x8*)(qrow + ks * 32 + fq * 8); }
    unsigned mask = 0u;
    { float g1 = -INFINITY, g2 = -INFINITY, g3 = -INFINITY; int i1 = -1, i2 = -1, i3 = -1;
      for (int n = 0; n < blk; ++n) { float part = 0.f;
#pragma unroll
          for (int ks = 0; ks < 4; ++ks) { const float* km = KMS + n * 128 + ks * 32 + fq * 8;
#pragma unroll
              for (int i = 0; i < 8; ++i) part = fmaf(bf2f((unsigned short)qf[ks][i]), km[i], part); }
          part += __shfl_xor(part, 16); part += __shfl_xor(part, 32);
          if (part > g1) { g3 = g2; i3 = i2; g2 = g1; i2 = i1; g1 = part; i1 = n; } else if (part > g2) { g3 = g2; i3 = i2; g2 = part; i2 = n; } else if (part > g3) { g3 = part; i3 = n; } }
      if (i1 >= 0) mask |= 1u << i1; if (i2 >= 0) mask |= 1u << i2; if (i3 >= 0) mask |= 1u << i3; }
    unsigned rm[4];
#pragma unroll
    for (int j = 0; j < 4; ++j) rm[j] = (unsigned)__shfl((int)mask, fq * 4 + j);
    { unsigned wm = mask;
#pragma unroll
      for (int o = 1; o < 16; o <<= 1) wm |= (unsigned)__shfl_xor((int)wm, o);
      if (lane == 0) atomicOr(bm, wm); }
    __syncthreads();
    const unsigned anym = *bm;
    f32x4 oacc[8];
#pragma unroll
    for (int i = 0; i < 8; ++i) oacc[i] = (f32x4){0.f, 0.f, 0.f, 0.f};
    float mrow[4] = {-1e30f, -1e30f, -1e30f, -1e30f}, lrow[4] = {0.f, 0.f, 0.f, 0.f};
    const int ntile = (q0 + 128) >> 6;
#define MB_NEXT(k_) do { while ((k_) < ntile && ((k_) >> 2) < blk && !((anym >> ((k_) >> 2)) & 1u)) ++(k_); } while (0)
    uint4 rka, rkb, rva, rvb;
#define MB_FETCH(k_) do { const int c0 = tid, c1 = tid + 512; \
        rka = *(const uint4*)(KNp + (size_t)((k_) * 64 + (c0 >> 4)) * 128 + (c0 & 15) * 8); rkb = *(const uint4*)(KNp + (size_t)((k_) * 64 + (c1 >> 4)) * 128 + (c1 & 15) * 8); \
        rva = *(const uint4*)(VTp + (size_t)(c0 >> 3) * SEQL + (k_) * 64 + (c0 & 7) * 8); rvb = *(const uint4*)(VTp + (size_t)(c1 >> 3) * SEQL + (k_) * 64 + (c1 & 7) * 8); } while (0)
    int kt = 0; MB_NEXT(kt);
    MB_FETCH(kt);
    while (kt < ntile) {
        const int kb = kt >> 2;
        __syncthreads();
        { const int c0 = tid, c1 = tid + 512, r0 = c0 >> 4, r1 = c1 >> 4;
          *(uint4*)(KT + ((r0 & 3) * 16 + (r0 >> 2)) * 136 + (c0 & 15) * 8) = rka; *(uint4*)(KT + ((r1 & 3) * 16 + (r1 >> 2)) * 136 + (c1 & 15) * 8) = rkb;
          *(uint4*)(VT + (c0 >> 3) * 72 + (c0 & 7) * 8) = rva; *(uint4*)(VT + (c1 >> 3) * 72 + (c1 & 7) * 8) = rvb; }
        __syncthreads();
        int nk = kt + 1; MB_NEXT(nk);
        if (nk < ntile) MB_FETCH(nk);
        f32x4 s[4];
#pragma unroll
        for (int g = 0; g < 4; ++g) s[g] = (f32x4){0.f, 0.f, 0.f, 0.f};
#pragma unroll
        for (int ks = 0; ks < 4; ++ks)
#pragma unroll
            for (int g = 0; g < 4; ++g) { const bf16x8 bk = *(const bf16x8*)(KT + (g * 16 + fr) * 136 + ks * 32 + fq * 8); s[g] = MFMA16(qf[ks], bk, s[g]); }
        float alpha[4]; bool resc = false;
#pragma unroll
        for (int j = 0; j < 4; ++j) { const int qpos = q0 + w * 16 + fq * 4 + j; const bool past = kb < blk; const bool rowok = past ? (((rm[j] >> kb) & 1u) != 0u) : true;
            float mx = -1e30f;
#pragma unroll
            for (int g = 0; g < 4; ++g) { const int kpos = kt * 64 + 4 * fr + g; const bool ok = rowok && (past || kpos <= qpos); const float sv = ok ? s[g][j] : -1e30f; s[g][j] = sv; mx = fmaxf(mx, sv); }
            mx = row16_max(mx);
            const float mnew = fmaxf(mrow[j], mx); alpha[j] = __builtin_amdgcn_exp2f(mrow[j] - mnew); resc = resc || (mnew != mrow[j]); mrow[j] = mnew;
            float rs = 0.f;
#pragma unroll
            for (int g = 0; g < 4; ++g) { const float pv = __builtin_amdgcn_exp2f(s[g][j] - mnew); s[g][j] = pv; rs += pv; }
            lrow[j] = lrow[j] * alpha[j] + rs;
            uint2 pk; pk.x = cvt_pk_bf16(s[0][j], s[1][j]); pk.y = cvt_pk_bf16(s[2][j], s[3][j]);
            *(uint2*)(Pw + (fq * 4 + j) * 72 + 4 * fr) = pk; }
        if (__ballot(resc)) {
#pragma unroll
            for (int j = 0; j < 4; ++j)
#pragma unroll
                for (int dt = 0; dt < 8; ++dt) oacc[dt][j] *= alpha[j]; }
        LDS_WAIT();
        bf16x8 pf[2];
#pragma unroll
        for (int ks = 0; ks < 2; ++ks) pf[ks] = *(const bf16x8*)(Pw + fr * 72 + ks * 32 + fq * 8);
#pragma unroll
        for (int dt = 0; dt < 8; ++dt)
#pragma unroll
            for (int ks = 0; ks < 2; ++ks) { const bf16x8 bv = *(const bf16x8*)(VT + (dt * 16 + fr) * 72 + ks * 32 + fq * 8); oacc[dt] = MFMA16(pf[ks], bv, oacc[dt]); }
        kt = nk;
    }
    float inv[4];
#pragma unroll
    for (int j = 0; j < 4; ++j) inv[j] = 1.f / row16_sum(lrow[j]);
#pragma unroll
    for (int dt = 0; dt < 8; ++dt)
#pragma unroll
        for (int j = 0; j < 4; ++j) MIX[(size_t)(b * SEQL + q0 + w * 16 + fq * 4 + j) * DM + 2048 + h * 128 + dt * 16 + fr] = f2bf(oacc[dt][j] * inv[j]);
}

__device__ __forceinline__ void gla_final(const Params& p) {
    const int tid = threadIdx.x, lane = tid & 63, w = tid >> 6;
    const float* OG = (const float*)(p.ws + WS_OG); const bf16_t* proj = (const bf16_t*)(p.ws + WS_PROJ); bf16_t* MIX = (bf16_t*)(p.ws + WS_MIX);
    const float4 gn = ((const float4*)p.glang)[lane];
    for (int it = blockIdx.x * 8 + w; it < NTOK * 8; it += gridDim.x * 8) { const int t = it >> 3, h = it & 7;
        const float4 o = ((const float4*)(OG + (size_t)t * 2048 + h * 256))[lane];
        const float r = rsqrtf(wave_sum((o.x * o.x + o.y * o.y) + (o.z * o.z + o.w * o.w)) * (1.f / 256.f) + 1e-6f);
        const uint2 gv = ((const uint2*)(proj + (size_t)t * PROJW + 4096 + h * 256))[lane];
        const float g0 = bf2f(gv.x & 0xffff), g1 = bf2f(gv.x >> 16), g2 = bf2f(gv.y & 0xffff), g3 = bf2f(gv.y >> 16);
        const float y0 = ((o.x * r) * gn.x) * (g0 / (1.f + __expf(-g0))), y1 = ((o.y * r) * gn.y) * (g1 / (1.f + __expf(-g1)));
        const float y2 = ((o.z * r) * gn.z) * (g2 / (1.f + __expf(-g2))), y3 = ((o.w * r) * gn.w) * (g3 / (1.f + __expf(-g3)));
        uint2 ov; ov.x = cvt_pk_bf16(y0, y1); ov.y = cvt_pk_bf16(y2, y3);
        ((uint2*)(MIX + (size_t)t * DM + h * 256))[lane] = ov; }
}

template <int N> __device__ __forceinline__ void bitonic_desc(unsigned (&x)[N]) {
#pragma unroll
    for (int k = 2; k <= N; k <<= 1)
#pragma unroll
        for (int j = k >> 1; j > 0; j >>= 1)
#pragma unroll
            for (int i = 0; i < N; ++i) { const int l = i ^ j;
                if (l > i) { const unsigned a = x[i], b = x[l], mx = a > b ? a : b, mn = a > b ? b : a;
                    if ((i & k) == 0) { x[i] = mx; x[l] = mn; } else { x[i] = mn; x[l] = mx; } } }
}
__device__ __forceinline__ void merge16(unsigned (&x)[16], int mask) {
    unsigned y[16];
#pragma unroll
    for (int i = 0; i < 16; ++i) y[i] = (unsigned)__shfl_xor((int)x[15 - i], mask);
#pragma unroll
    for (int i = 0; i < 16; ++i) x[i] = x[i] > y[i] ? x[i] : y[i];
    bitonic_desc<16>(x);
}
__device__ __forceinline__ unsigned mono(float f) { const unsigned u = __float_as_uint(f); return (u & 0x80000000u) ? ~u : (u | 0x80000000u); }
__device__ __forceinline__ float unmono(unsigned k) { return __uint_as_float((k & 0x80000000u) ? (k & 0x7fffffffu) : ~k); }
__device__ __forceinline__ void split_bf16(const float4 a, const float4 b, bf16x8& hi, bf16x8& lo) {
    const float x[8] = {a.x, a.y, a.z, a.w, b.x, b.y, b.z, b.w}; unsigned h[4], l[4];
#pragma unroll
    for (int i = 0; i < 4; ++i) { h[i] = cvt_pk_bf16(x[2 * i], x[2 * i + 1]); l[i] = cvt_pk_bf16(x[2 * i] - bf2f(h[i] & 0xffff), x[2 * i + 1] - bf2f(h[i] >> 16)); }
    hi = __builtin_bit_cast(bf16x8, make_uint4(h[0], h[1], h[2], h[3])); lo = __builtin_bit_cast(bf16x8, make_uint4(l[0], l[1], l[2], l[3]));
}
struct PairTab { int n; int i[64], j[64]; };
constexpr PairTab make_pairs() { PairTab t{}; t.n = 0; for (int a = 0; a < 16; ++a) for (int b = 0; b < 16; ++b) if ((a + 1) * (b + 1) <= 16) { t.i[t.n] = a; t.j[t.n] = b; ++t.n; } return t; }
__device__ __forceinline__ void peer_head(const Params& p, unsigned char* sm, int t0, int h, int lane, unsigned char* ibuf, int* LE, float* LG) {
    const int fr = lane & 15, fq = lane >> 4;
    const float* Q = (const float*)(p.ws + WS_Q); const bf16_t* KH = (const bf16_t*)(p.ws + WS_KH); const bf16_t* KL = (const bf16_t*)(p.ws + WS_KL);
    unsigned kk[2][16];
#pragma unroll
    for (int pp = 0; pp < 2; ++pp) {
        bf16x8 qh[4], ql[4];
        { const float* qr = Q + (size_t)(t0 + fr) * 2048 + h * 256 + pp * 128 + fq * 8;
#pragma unroll
          for (int ks = 0; ks < 4; ++ks) split_bf16(*(const float4*)(qr + ks * 32), *(const float4*)(qr + ks * 32 + 4), qh[ks], ql[ks]); }
        unsigned x[32];
#pragma unroll
        for (int n = 0; n < 8; ++n) { const size_t ko = ((size_t)(h * 2 + pp) * 128 + n * 16 + fr) * 128 + fq * 8; f32x4 acc = (f32x4){0.f, 0.f, 0.f, 0.f};
#pragma unroll
            for (int ks = 0; ks < 4; ++ks) { const bf16x8 kh = *(const bf16x8*)(KH + ko + ks * 32), kl = *(const bf16x8*)(KL + ko + ks * 32);
                acc = MFMA16(kh, qh[ks], acc); acc = MFMA16(kl, qh[ks], acc); acc = MFMA16(kh, ql[ks], acc); }
#pragma unroll
            for (int j = 0; j < 4; ++j) x[n * 4 + j] = (mono(acc[j]) & ~0x7Fu) | (unsigned)(n * 16 + fq * 4 + j); }
        bitonic_desc<32>(x);
#pragma unroll
        for (int i = 0; i < 16; ++i) kk[pp][i] = x[i];
        merge16(kk[pp], 16); merge16(kk[pp], 32);
    }
    constexpr PairTab PT = make_pairs();
    float v1[16], v2[16];
#pragma unroll
    for (int i = 0; i < 16; ++i) { v1[i] = unmono(kk[0][i] & ~0x7Fu); v2[i] = unmono(kk[1][i] & ~0x7Fu); }
    unsigned y[16];
#pragma unroll
    for (int c = 0; c < 16; ++c) { unsigned cand = 0u;
#pragma unroll
        for (int q = 0; q < 4; ++q) { const int idx = 4 * c + q;
            if (idx < PT.n) { const unsigned key = (mono(v1[PT.i[idx]] + v2[PT.j[idx]]) & ~0xFFu) | (unsigned)(PT.i[idx] * 16 + PT.j[idx]); cand = (fq == q) ? key : cand; } }
        y[c] = cand; }
    bitonic_desc<16>(y); merge16(y, 16); merge16(y, 32);
    if (fq == 0) {
#pragma unroll
        for (int c4 = 0; c4 < 4; ++c4) { unsigned w1 = 0u, w2 = 0u;
#pragma unroll
            for (int b = 0; b < 4; ++b) { w1 |= (kk[0][c4 * 4 + b] & 0x7Fu) << (8 * b); w2 |= (kk[1][c4 * 4 + b] & 0x7Fu) << (8 * b); }
            ((unsigned*)ibuf)[fr * 8 + c4] = w1; ((unsigned*)ibuf)[fr * 8 + 4 + c4] = w2; }
    }
    LDS_WAIT();
    if (fq == 0) { const float s0 = unmono(y[0] & ~0xFFu); float ex[16], sum = 0.f;
#pragma unroll
        for (int c = 0; c < 16; ++c) { ex[c] = __expf(unmono(y[c] & ~0xFFu) - s0); sum += ex[c]; }
        const float inv = 1.f / sum;
#pragma unroll
        for (int c = 0; c < 16; ++c) { const unsigned code = y[c] & 0xFFu; const int e = (int)ibuf[fr * 32 + (code >> 4)] * 128 + (int)ibuf[fr * 32 + 16 + (code & 15u)];
            LE[fr * 128 + h * 16 + c] = e; LG[fr * 128 + h * 16 + c] = ex[c] * inv; }
    }
}
constexpr int PE_IB = 0, PE_LE = 4096, PE_LG = 12288;
__device__ __forceinline__ void peer_item(const Params& p, unsigned char* sm, int item) {
    const int tid = threadIdx.x, lane = tid & 63, w = tid >> 6;
    const int t0 = item * 16;
    int* LE = (int*)(sm + PE_LE); float* LG = (float*)(sm + PE_LG); unsigned char* W = p.ws + WS_W;
    __syncthreads();
    { uint4* gz = (uint4*)(W + (size_t)t0 * NEXP) + tid; const uint4 z = make_uint4(0u, 0u, 0u, 0u);
#pragma unroll 8
      for (int i = 0; i < 32; ++i) gz[i * 512] = z; }
    peer_head(p, sm, t0, w, lane, sm + PE_IB + w * 512, LE, LG);
    asm volatile("s_waitcnt vmcnt(0)" ::: "memory");
    __syncthreads();
#pragma unroll
    for (int ti = 0; ti < 2; ++ti) { const int t = w * 2 + ti; const int* le = LE + t * 128; const float* lg = LG + t * 128;
        const int e0 = le[lane], e1 = le[lane + 64]; float g0 = 0.f, g1 = 0.f; bool f0 = true, f1 = true;
#pragma unroll 4
        for (int j4 = 0; j4 < 128; j4 += 4) { const int4 ev = *(const int4*)(le + j4); const float4 gv = *(const float4*)(lg + j4);
            const int ea[4] = {ev.x, ev.y, ev.z, ev.w}; const float ga[4] = {gv.x, gv.y, gv.z, gv.w};
#pragma unroll
            for (int q = 0; q < 4; ++q) { const int j = j4 + q;
                if (ea[q] == e0) { g0 += ga[q]; f0 = f0 && (j >= lane); }
                if (ea[q] == e1) { g1 += ga[q]; f1 = f1 && (j >= lane + 64); } } }
        unsigned char* wr = W + (size_t)(t0 + t) * NEXP;
        if (f0) wr[e0] = (unsigned char)(pk4_fp8(g0 * SC_G, 0.f, 0.f, 0.f) & 0xffu);
        if (f1) wr[e1] = (unsigned char)(pk4_fp8(g1 * SC_G, 0.f, 0.f, 0.f) & 0xffu); }
}

#define XB_TMO      128
#define XB_XCNT(j)  (256  + 64 * (j))
#define XB_XSUB(j)  (1280 + 64 * (j))
#define XB_XGEN(j)  (2304 + 64 * (j))
#define XB_TOP      3328
#define XB_TOPGEN   3392
#define XCD_BAR_WORDS 3456
#define XB_SPIN_CAP (1u << 18)
#define LAS __attribute__((address_space(3)))

__device__ __forceinline__ unsigned xb_ld(unsigned* p)              { return __hip_atomic_load(p, __ATOMIC_RELAXED, __HIP_MEMORY_SCOPE_AGENT); }
__device__ __forceinline__ unsigned xb_add(unsigned* p, unsigned v) { return __hip_atomic_fetch_add(p, v, __ATOMIC_RELAXED, __HIP_MEMORY_SCOPE_AGENT); }
__device__ __forceinline__ unsigned xb_xcc_id() { return (unsigned)__builtin_amdgcn_s_getreg((3 << 11) | 20) & 0xFu; }
#define XB_SPIN(cond, bar) do { unsigned _sp = 0; while (cond) { __builtin_amdgcn_s_sleep(1); \
    if ((++_sp & 255u) == 0u) { if (xb_ld(&(bar)[XB_TMO])) break; if (_sp > XB_SPIN_CAP) { atomicAdd(&(bar)[XB_TMO], 1u); break; } } } } while (0)

struct XcdBarrier {
    unsigned* bar; unsigned x;
    volatile LAS unsigned* st;
};

__device__ __forceinline__ XcdBarrier xcd_barrier_post(unsigned* bar, volatile LAS unsigned* st) {
    XcdBarrier b; b.bar = bar; b.x = xb_xcc_id(); b.st = st;
    if (threadIdx.x == 0) (void)xb_add(&bar[XB_XCNT(b.x)], 1u);
    return b;
}
__device__ __forceinline__ void xcd_barrier_complete(unsigned* bar, unsigned x, unsigned& nloc, unsigned& nx) {
    const unsigned G = gridDim.x * gridDim.y * gridDim.z;
    unsigned sum, cnt, mine, sp = 0u;
    for (;;) {
        sum = 0u; cnt = 0u; mine = 0u;
#pragma unroll
        for (unsigned j = 0; j < 16; ++j) { const unsigned c = xb_ld(&bar[XB_XCNT(j)]); sum += c; cnt += (c > 0u) ? 1u : 0u; mine = (j == x) ? c : mine; }
        if (sum == G) break;
        __builtin_amdgcn_s_sleep(1);
        if ((++sp & 255u) == 0u) { if (xb_ld(&bar[XB_TMO])) break; if (sp > XB_SPIN_CAP) { atomicAdd(&bar[XB_TMO], 1u); break; } }
    }
    nloc = mine > 0u ? mine : 1u; nx = cnt > 0u ? cnt : 1u;
}

__device__ __forceinline__ void xcd_barrier(const XcdBarrier& b) {
    asm volatile("s_waitcnt vmcnt(0)" ::: "memory");
    __syncthreads();
    if (threadIdx.x == 0) {
        unsigned* bar = b.bar;
        __builtin_amdgcn_s_waitcnt(0);
        unsigned nloc = b.st[0], nx = b.st[1];
        if (nloc == 0u) { xcd_barrier_complete(bar, b.x, nloc, nx); b.st[0] = nloc; b.st[1] = nx; }
        const unsigned old = xb_add(&bar[XB_XSUB(b.x)], 1u);
        const unsigned gen = old / nloc;
        if (old + 1u == (gen + 1u) * nloc) {
            __builtin_amdgcn_fence(__ATOMIC_RELEASE, "agent");
            asm volatile("s_waitcnt vmcnt(0)" ::: "memory");
            const unsigned og = xb_add(&bar[XB_TOP], 1u);
            const unsigned tg = og / nx;
            if (og + 1u == (tg + 1u) * nx) xb_add(&bar[XB_TOPGEN], 1u);
            else XB_SPIN(xb_ld(&bar[XB_TOPGEN]) == tg, bar);
            __builtin_amdgcn_fence(__ATOMIC_ACQUIRE, "agent");
            xb_add(&bar[XB_XGEN(b.x)], 1u);
            asm volatile("s_waitcnt vmcnt(0)" ::: "memory");
        } else {
            XB_SPIN(xb_ld(&bar[XB_XGEN(b.x)]) == gen, bar);
            __builtin_amdgcn_fence(__ATOMIC_ACQUIRE, "agent");
            asm volatile("s_waitcnt vmcnt(0)" ::: "memory");
        }
    }
    __syncthreads();
}

__global__ void __launch_bounds__(512, 2) hymba_fwd(Params p) {
    extern __shared__ __attribute__((aligned(16))) unsigned char smem[];
    cg::grid_group grid = cg::this_grid();
    volatile int& s_item = *(volatile int*)(smem + 131072);
    volatile LAS unsigned* bst = (volatile LAS unsigned*)(smem + 131072 + 8);
    if (threadIdx.x == 0) { bst[0] = 0u; bst[1] = 0u; }
    __syncthreads();
    const XcdBarrier xb = xcd_barrier_post((unsigned*)(p.ws + WS_CTRL), bst);
    const int tid = threadIdx.x, lane = tid & 63, w = tid >> 6;
    const int G = gridDim.x, c = blockIdx.x;
    unsigned* ctrl = (unsigned*)(p.ws + WS_CTRL) + 3584;
#define PH_ON(n) (p.ph_lo <= (n) && (n) < p.ph_hi)
#define PH_SYNC(n) if ((n) > p.ph_lo && (n) < p.ph_hi) { if ((n) == 1) grid.sync(); else xcd_barrier(xb); }
    if (PH_ON(0)) phase_prep(p, smem);
    PH_SYNC(1);
    if (PH_ON(1)) {
        { pg8::Gemm g{(const bf16_t*)(p.ws + WS_HB), (const bf16_t*)(p.ws + WS_WINT), NTOK, 6144, DM}; pg8::StaticOrder S; S.init(NTOK, 6144, G, c);
          EpiProj E{(bf16_t*)(p.ws + WS_PROJ), 0, 1.f}; pg8::gemm_phase<EpiProj, pg8::StaticOrder, false>((PG8_LAS unsigned char*)smem, g, S, E, nullptr); }
        { pg8::Gemm g{(const bf16_t*)(p.ws + WS_HB8), (const bf16_t*)(p.ws + WS_WINT8), NTOK, 6144, DM / 2}; pg8::StaticOrder S; S.init(NTOK, 6144, G, c);
          EpiProj E{(bf16_t*)(p.ws + WS_PROJ), 6144, 1.f / (SC_X * SC_U)}; pg8::gemm_phase<EpiProj, pg8::StaticOrder, false, true>((PG8_LAS unsigned char*)smem, g, S, E, nullptr); }
        for (int j = c * 8 + w; j < NTOK / 16; j += G * 8) glr_job(p, j, lane); }
    PH_SYNC(2);
    if (PH_ON(2)) { for (int it = c; it < 512; it += G) moba_prep_item(p, smem, it);
        for (int it = c; it < 1024; it += G) gla_prep_item(p, smem, it); }
    PH_SYNC(3);
    if (PH_ON(3)) for (;;) { __syncthreads(); if (tid == 0) s_item = (int)atomicAdd(ctrl, 1u); __syncthreads(); const int it = s_item; if (it >= 128 + 1024) break;
        if (it < 128) gla_item(p, smem, it); else moba_item(p, smem, it - 128); }
    PH_SYNC(4);
    if (PH_ON(4)) gla_final(p);
    PH_SYNC(5);
    if (PH_ON(5)) { pg8::Gemm g{(const bf16_t*)(p.ws + WS_MIX), (const bf16_t*)(p.ws + WS_WOUTT), NTOK, DM, DM}; pg8::StaticOrder S; S.init(NTOK, DM, G, c);
        EpiRes E{p.out, p.x, DM}; pg8::gemm_phase<EpiRes, pg8::StaticOrder, false>((PG8_LAS unsigned char*)smem, g, S, E, nullptr); }
    PH_SYNC(6);
    if (PH_ON(6)) { bf16_t* HB = (bf16_t*)(p.ws + WS_HB);
        for (int r = c * 8 + w; r < NTOK; r += G * 8) rms_row<true>(p.out + (size_t)r * DM, p.g2, HB + (size_t)r * DM, (unsigned*)(p.ws + WS_HB8) + (size_t)r * (DM / 4), lane);
        (void)0; }
    PH_SYNC(7);
    if (PH_ON(7)) { pg8::Gemm g{(const bf16_t*)(p.ws + WS_HB), (const bf16_t*)(p.ws + WS_WPQT), NTOK, 2048, DM}; pg8::StaticOrder S; S.init(NTOK, 2048, G, c);
        EpiF32 E{(float*)(p.ws + WS_Q), 2048}; pg8::gemm_phase<EpiF32, pg8::StaticOrder, false>((PG8_LAS unsigned char*)smem, g, S, E, nullptr); }
    PH_SYNC(8);
    if (PH_ON(8)) for (int it = c; it < NTOK / 16; it += G) peer_item(p, smem, it);
    PH_SYNC(9);
    if (PH_ON(9)) { pg8::Gemm g{(const bf16_t*)(p.ws + WS_HB8), (const bf16_t*)(p.ws + WS_UB), NTOK, NEXP, DM / 2}; pg8::StaticOrder S; S.init(NTOK, NEXP, G, c);
        EpiPeerW8 E{p.ws + WS_W, p.ws + WS_W8}; pg8::gemm_phase<EpiPeerW8, pg8::StaticOrder, false, true>((PG8_LAS unsigned char*)smem, g, S, E, nullptr); }
    PH_SYNC(10);
    if (PH_ON(10)) { pg8::Gemm g{(const bf16_t*)(p.ws + WS_W8), (const bf16_t*)(p.ws + WS_VTB), NTOK, DM, NEXP / 2}; pg8::StaticOrder S; S.init(NTOK, DM, G, c);
        EpiResSc E{p.out, p.out, DM, 1.f / (SC_W * SC_V)}; pg8::gemm_phase<EpiResSc, pg8::StaticOrder, false, true>((PG8_LAS unsigned char*)smem, g, S, E, nullptr); }
}

#ifndef MK_PER_PHASE
#define MK_PER_PHASE 0
#endif
extern "C" void kernel_launch(void* const* d_in, const int* in_sizes, int n_in, void* d_out, int out_size, void* d_ws, size_t ws_size, hipStream_t stream) {
    static int grid = 0;
    if (grid == 0) {
        if (n_in != 14 || out_size != NTOK * DM || ws_size < WS_END) { fprintf(stderr, "kernel_launch: unexpected shapes (n_in %d out %d ws %zu)\n", n_in, out_size, ws_size); grid = -1; return; }
        int dev = 0, cus = 0, per_cu = 0;
        hipGetDevice(&dev); hipDeviceGetAttribute(&cus, hipDeviceAttributeMultiprocessorCount, dev);
        if (hipFuncSetAttribute((const void*)hymba_fwd, hipFuncAttributeMaxDynamicSharedMemorySize, LDS_BYTES) != hipSuccess) { fprintf(stderr, "kernel_launch: hipFuncSetAttribute failed\n"); grid = -1; return; }
        if (hipOccupancyMaxActiveBlocksPerMultiprocessor(&per_cu, (const void*)hymba_fwd, 512, LDS_BYTES) != hipSuccess || per_cu < 1) { fprintf(stderr, "kernel_launch: occupancy query failed (%d)\n", per_cu); grid = -1; return; }
        grid = cus * (per_cu > 1 ? 1 : per_cu);
        fprintf(stderr, "kernel_launch: %d CUs, %d blocks/CU by query, grid %d\n", cus, per_cu, grid);
    }
    if (grid < 0) return;
    hipMemsetAsync((char*)d_ws + WS_CTRL, 0, 16384, stream);
    Params p{};
    p.x = (const float*)d_in[0]; p.g1 = (const float*)d_in[1]; p.win = (const float*)d_in[2]; p.wgu = (const float*)d_in[3]; p.bg = (const float*)d_in[4]; p.glang = (const float*)d_in[5];
    p.qng = (const float*)d_in[6]; p.kng = (const float*)d_in[7]; p.wout = (const float*)d_in[8]; p.g2 = (const float*)d_in[9]; p.wpq = (const float*)d_in[10]; p.pkeys = (const float*)d_in[11];
    p.pu = (const float*)d_in[12]; p.pv = (const float*)d_in[13]; p.out = (float*)d_out; p.ws = (unsigned char*)d_ws;
#if MK_PER_PHASE
    for (int ph = 0; ph < NPHASE; ++ph) { p.ph_lo = ph; p.ph_hi = ph + 1; void* args[] = {&p};
        hipError_t e = hipLaunchCooperativeKernel((const void*)hymba_fwd, dim3(grid), dim3(512), args, LDS_BYTES, stream);
        if (e != hipSuccess) { fprintf(stderr, "cooperative launch failed: %s\n", hipGetErrorString(e)); break; } }
#else
    p.ph_lo = 0; p.ph_hi = NPHASE; void* args[] = {&p};
    hipError_t e = hipLaunchCooperativeKernel((const void*)hymba_fwd, dim3(grid), dim3(512), args, LDS_BYTES, stream);
    if (e != hipSuccess) fprintf(stderr, "cooperative launch failed: %s (grid %d)\n", hipGetErrorString(e), grid);
#endif
}
```

```cpp
#include <hip/hip_runtime.h>
#include <hip/hip_cooperative_groups.h>
#include <cstdio>
#include <cstdint>
namespace cg = cooperative_groups;
namespace pg8 {
#define PG8_LAS __attribute__((address_space(3)))
typedef unsigned short bf16_t;
typedef short bf16x8 __attribute__((ext_vector_type(8)));
typedef float f32x4 __attribute__((ext_vector_type(4)));
typedef unsigned u32x4 __attribute__((ext_vector_type(4)));
constexpr int BM = 256, BK = 64, HALF = 128, HTB = HALF * BK * 2  , STAGE_BYTES = 8 * HTB, NXCD = 8, WGM = 8;

__host__ __device__ __forceinline__ int lds_byte(int r, int c) { const int st = (r >> 4) * 2 + (c >> 5), rr = r & 15, cc = c & 31, ob = rr * 64 + cc * 2; return st * 1024 + (ob ^ (((ob >> 9) & 1) << 5)); }
__host__ __device__ __forceinline__ void stage_rc(int b, int& R, int& C) { const int st = b / 1024, sb = b % 1024, swz = sb ^ (((sb >> 9) & 1) << 5); R = (st >> 1) * 16 + swz / 64; C = (st & 1) * 32 + (swz % 64) / 2; }
__host__ __device__ __forceinline__ int perm32(int rho) { const int n = rho >> 4, i = rho & 15; return 8 * (i >> 2) + 4 * n + (i & 3); }

struct Unit { int pm, pn; };
struct Gemm { const bf16_t* A; const bf16_t* Bt; int M, N, K; };

struct StaticOrder {
    int nM, nN, nwg, G, c;
    __host__ __device__ void init(int M, int N, int G_, int c_) { nM = M / BM; nN = N / BM; nwg = nM * nN; G = G_; c = c_; }
    __host__ __device__ bool next(int i, Unit& u) const {
        const long L = (long)i * G + c; if (L >= nwg) return false;
        int wgid = (int)L; { const int q = nwg / NXCD, r = nwg % NXCD, xcd = wgid % NXCD, off = wgid / NXCD; wgid = (xcd < r ? xcd * (q + 1) : r * (q + 1) + (xcd - r) * q) + off; }
        const int nig = WGM * nN, gid = wgid / nig, fm = gid * WGM, gsz = (nM - fm) < WGM ? (nM - fm) : WGM;
        u.pm = fm + ((wgid % nig) % gsz); u.pn = (wgid % nig) / gsz; return true;
    }
    __device__ __forceinline__ void a_ready(const Unit&) const {}
    __device__ __forceinline__ void done(const Unit&) const {}
};
typedef __bf16 bf16x2_t __attribute__((ext_vector_type(2)));
typedef float f32x2c_t __attribute__((ext_vector_type(2)));
__device__ __forceinline__ unsigned cvt_pk_bf16(float lo, float hi) { f32x2c_t v = {lo, hi}; bf16x2_t b = __builtin_convertvector(v, bf16x2_t); return __builtin_bit_cast(unsigned, b); }
typedef float f32x2 __attribute__((ext_vector_type(2)));
__device__ __forceinline__ f32x2 gelu_pk(f32x2 v) {
    const f32x2 av = __builtin_elementwise_abs(v), d = av * 0.2316418882f + 1.0f;
    f32x2 t; t.x = __builtin_amdgcn_rcpf(d.x); t.y = __builtin_amdgcn_rcpf(d.y);
    f32x2 q = t * 0.5307027145f + (-0.7265760135f); q = q * t + 0.7107068705f; q = q * t + (-0.142248368f); q = q * t + 0.127414796f; q = q * t;
    const f32x2 s = (v * v) * (-0.72134752044f);
    f32x2 e; e.x = __builtin_amdgcn_exp2f(s.x); e.y = __builtin_amdgcn_exp2f(s.y);
    const f32x2 m = v * (q * e), r = v - m;
    f32x2 o; o.x = v.x < 0.f ? m.x : r.x; o.y = v.y < 0.f ? m.y : r.y; return o;
}

typedef int i32x4 __attribute__((ext_vector_type(4)));
typedef int i32x8 __attribute__((ext_vector_type(8)));
__device__ __forceinline__ i32x8 cat16(const bf16x8 a, const bf16x8 b) { const i32x4 lo = __builtin_bit_cast(i32x4, a), hi = __builtin_bit_cast(i32x4, b); return __builtin_shufflevector(lo, hi, 0, 1, 2, 3, 4, 5, 6, 7); }
template <bool F8> __device__ __forceinline__ void mma_block(f32x4 (&accb)[4][2], const bf16x8 (&At)[4][2], const bf16x8 (&Bt)[2][2], const i32x8 (&At8)[4], const i32x8 (&Bt8)[2]) {
    if constexpr (F8) {
#pragma unroll
        for (int m = 0; m < 4; ++m)
#pragma unroll
            for (int n = 0; n < 2; ++n) asm volatile("v_mfma_f32_16x16x128_f8f6f4 %0, %1, %2, %0" : "+v"(accb[m][n]) : "v"(Bt8[n]), "v"(At8[m]));
    } else {
#pragma unroll
        for (int m = 0; m < 4; ++m)
#pragma unroll
            for (int n = 0; n < 2; ++n)
#pragma unroll
                for (int k = 0; k < 2; ++k) accb[m][n] = __builtin_amdgcn_mfma_f32_16x16x32_bf16(Bt[n][k], At[m][k], accb[m][n], 0, 0, 0);
    }
}
template <class Epi, class Sched, bool STAMP = false, bool F8 = false>
__device__ __forceinline__ void gemm_phase(PG8_LAS unsigned char* lds, const Gemm g, const Sched& S, const Epi& E, unsigned long long* stamps) {
    const int tid = threadIdx.x, wid = __builtin_amdgcn_readfirstlane(tid >> 6), lane = tid & 63, wr = wid >> 2, wc = wid & 3, fr = lane & 15, fq = lane >> 4;
    const int K = g.K, nt = K / BK;
    int ts_lo = 0, ts_hi = 0, nts = 0; const unsigned long long rt_entry = STAMP ? (unsigned long long)wall_clock64() : 0ull;
#define PG8_STAMP() do { if (STAMP && wid == 0 && nts < 64) { const unsigned long long _c = (unsigned long long)clock64(); \
        ts_lo = (lane == nts) ? (int)(unsigned)_c : ts_lo; ts_hi = (lane == nts) ? (int)(unsigned)(_c >> 32) : ts_hi; ++nts; } } while (0)
    PG8_STAMP();
    unsigned voffA[2], voffB[2];
#pragma unroll
    for (int i = 0; i < 2; ++i) { int R, C; stage_rc(tid * 16 + i * 8192, R, C); const int Rb = Epi::PERM ? ((R & ~31) + perm32(R & 31)) : R;
        voffA[i] = (unsigned)(R * K + C) * 2u; voffB[i] = (unsigned)(Rb * K + C) * 2u; }
    const size_t kstep = (size_t)(BK * 2);
    const size_t hstep = (size_t)HALF * K * 2;
    const size_t tstep = 2 * hstep;
    const unsigned ldsw = (unsigned)wid * 1024u;
    const int aoff = lds_byte(wr * 64 + fr, fq * 8), boff = lds_byte(wc * 32 + fr, fq * 8);
#define PG8_SA(b, h) (((b) * 2 + (h)) * HTB)
#define PG8_SB(b, h) ((4 + (b) * 2 + (h)) * HTB)
#define PG8_STAGE(bufoff, gbase, voff) do { _Pragma("unroll") for (int _i = 0; _i < 2; ++_i) \
        __builtin_amdgcn_global_load_lds((const unsigned*)((const char*)(gbase) + (voff)[_i]), (PG8_LAS unsigned*)(lds + (bufoff) + ldsw + _i * 8192), 16, 0, 0); } while (0)
#define PG8_LDA(dst, b, h) do { _Pragma("unroll") for (int m = 0; m < 4; ++m) { if constexpr (F8) dst##8[m] = cat16(*(const PG8_LAS bf16x8*)(lds + PG8_SA(b, h) + aoff + m * 2048), *(const PG8_LAS bf16x8*)(lds + PG8_SA(b, h) + aoff + m * 2048 + 1024)); else { _Pragma("unroll") for (int k = 0; k < 2; ++k) dst[m][k] = *(const PG8_LAS bf16x8*)(lds + PG8_SA(b, h) + aoff + m * 2048 + k * 1024); } } } while (0)
#define PG8_LDB(dst, b, h) do { _Pragma("unroll") for (int n = 0; n < 2; ++n) { if constexpr (F8) dst##8[n] = cat16(*(const PG8_LAS bf16x8*)(lds + PG8_SB(b, h) + boff + n * 2048), *(const PG8_LAS bf16x8*)(lds + PG8_SB(b, h) + boff + n * 2048 + 1024)); else { _Pragma("unroll") for (int k = 0; k < 2; ++k) dst[n][k] = *(const PG8_LAS bf16x8*)(lds + PG8_SB(b, h) + boff + n * 2048 + k * 1024); } } } while (0)
#define PG8_MMA(ai, bj, At, Bt) do { __builtin_amdgcn_s_setprio(1); mma_block<F8>(acc[ai][bj], At, Bt, At##8, Bt##8); __builtin_amdgcn_s_setprio(0); } while (0)
#define PG8_WAIT_V(n) asm volatile("s_waitcnt vmcnt(" #n ")" ::: "memory")
#define PG8_WAIT_L(n) asm volatile("s_waitcnt lgkmcnt(" #n ")" ::: "memory")
#define PG8_BAR __builtin_amdgcn_s_barrier()
#define PG8_SCHED __builtin_amdgcn_sched_barrier(0)
    Unit cur, nxt; int ui = 0;
    if (!S.next(0, cur)) return;
    f32x4 acc[2][2][4][2];
#pragma unroll
    for (int a = 0; a < 2; ++a)
#pragma unroll
        for (int b = 0; b < 2; ++b)
#pragma unroll
            for (int m = 0; m < 4; ++m)
#pragma unroll
                for (int n = 0; n < 2; ++n) acc[a][b][m][n] = (f32x4){0.f, 0.f, 0.f, 0.f};
    bf16x8 At[4][2], B0[2][2], B1[2][2]; i32x8 At8[4], B08[2], B18[2];
    const char* cA = (const char*)g.A + (size_t)cur.pm * tstep; const char* cB = (const char*)g.Bt + (size_t)cur.pn * tstep;
    S.a_ready(cur);
    PG8_STAGE(PG8_SB(0, 0), cB, voffB); PG8_STAGE(PG8_SA(0, 0), cA, voffA); PG8_STAGE(PG8_SB(0, 1), cB + hstep, voffB); PG8_STAGE(PG8_SA(0, 1), cA + hstep, voffA);
    if (wr == 1) PG8_BAR;
    PG8_WAIT_V(4); PG8_BAR;
    PG8_STAGE(PG8_SB(1, 0), cB + kstep, voffB); PG8_STAGE(PG8_SA(1, 0), cA + kstep, voffA); PG8_STAGE(PG8_SB(1, 1), cB + hstep + kstep, voffB);
    PG8_WAIT_V(6); PG8_BAR;
    PG8_STAMP();
    for (;;) {
        const bool has_next = S.next(ui + 1, nxt);
        const char* nA = has_next ? (const char*)g.A + (size_t)nxt.pm * tstep : cA; const char* nB = has_next ? (const char*)g.Bt + (size_t)nxt.pn * tstep : cB;
        for (int t = 0; t < nt; t += 2) {
            const bool last = (t == nt - 2);
            const char* a1 = cA + (size_t)(t + 1) * kstep;
            const char* a2 = last ? nA : cA + (size_t)(t + 2) * kstep; const char* b2 = last ? nB : cB + (size_t)(t + 2) * kstep;
            const char* a3 = a2 + kstep; const char* b3 = b2 + kstep;
            if (last && has_next) S.a_ready(nxt);
            PG8_LDB(B0, 0, 0); PG8_SCHED; PG8_LDA(At, 0, 0); PG8_STAGE(PG8_SA(1, 1), a1 + hstep, voffA);
            PG8_WAIT_L(8); PG8_BAR; PG8_WAIT_L(0); PG8_MMA(0, 0, At, B0); PG8_BAR; PG8_SCHED;
            PG8_LDB(B1, 0, 1); PG8_STAGE(PG8_SB(0, 0), b2, voffB);
            PG8_BAR; PG8_WAIT_L(0); PG8_MMA(0, 1, At, B1); PG8_BAR;
            PG8_LDA(At, 0, 1); PG8_STAGE(PG8_SA(0, 0), a2, voffA);
            PG8_BAR; PG8_WAIT_L(0); PG8_MMA(1, 0, At, B0); PG8_BAR; PG8_SCHED;
            PG8_STAGE(PG8_SB(0, 1), b2 + hstep, voffB);
            PG8_WAIT_V(6); PG8_BAR; PG8_MMA(1, 1, At, B1); PG8_BAR;
            PG8_LDB(B0, 1, 0); PG8_SCHED; PG8_LDA(At, 1, 0); PG8_STAGE(PG8_SA(0, 1), a2 + hstep, voffA);
            PG8_WAIT_L(8); PG8_BAR; PG8_WAIT_L(0); PG8_MMA(0, 0, At, B0); PG8_BAR; PG8_SCHED;
            PG8_LDB(B1, 1, 1); PG8_STAGE(PG8_SB(1, 0), b3, voffB);
            PG8_BAR; PG8_WAIT_L(0); PG8_MMA(0, 1, At, B1); PG8_BAR;
            PG8_LDA(At, 1, 1); PG8_STAGE(PG8_SA(1, 0), a3, voffA);
            PG8_BAR; PG8_WAIT_L(0); PG8_MMA(1, 0, At, B0); PG8_BAR; PG8_SCHED;
            PG8_STAGE(PG8_SB(1, 1), b3 + hstep, voffB);
            PG8_WAIT_V(6); PG8_BAR; PG8_MMA(1, 1, At, B1); PG8_BAR;
        }
        PG8_STAMP();
        if constexpr (!Epi::AFTER_DRAIN) { E(acc, cur, wr, wc, fr, fq); S.done(cur); }
        PG8_STAMP();
        if (!has_next) break;
#pragma unroll
        for (int a = 0; a < 2; ++a)
#pragma unroll
            for (int b = 0; b < 2; ++b)
#pragma unroll
                for (int m = 0; m < 4; ++m)
#pragma unroll
                    for (int n = 0; n < 2; ++n) acc[a][b][m][n] = (f32x4){0.f, 0.f, 0.f, 0.f};
        cur = nxt; cA = nA; cB = nB; ++ui;
    }
    PG8_WAIT_V(0);
    if (wr == 0) PG8_BAR;
    PG8_BAR;
    if constexpr (Epi::AFTER_DRAIN) { E.fused(acc, cur, wr, wc, fr, fq, lds, wid, lane); S.done(cur); }
    PG8_STAMP();
    if (STAMP && wid == 0) { stamps[lane] = lane < nts ? (((unsigned long long)(unsigned)ts_hi << 32) | (unsigned)ts_lo) : 0ull;
        if (lane == 62) stamps[62] = rt_entry; if (lane == 63) stamps[63] = (unsigned long long)wall_clock64(); }
#undef PG8_STAMP
#undef PG8_SA
#undef PG8_SB
#undef PG8_STAGE
#undef PG8_LDA
#undef PG8_LDB
#undef PG8_MMA
#undef PG8_WAIT_V
#undef PG8_WAIT_L
#undef PG8_BAR
#undef PG8_SCHED
}
}

using pg8::bf16_t; using pg8::bf16x8; using pg8::f32x4; using pg8::f32x2; using pg8::cvt_pk_bf16; using pg8::Unit;
typedef unsigned long long u64;

constexpr int NTOK = 8192, DM = 4096, SEQL = 2048;
constexpr int NIN = 12304, NINP = 12544, PROJW = 12288;
constexpr int NEXP = 16384;
constexpr size_t MiB = 1024ull * 1024ull;
constexpr size_t WS_CTRL = 0, WS_KM = 1 * MiB, WS_GLR = 2 * MiB, WS_WINT = 4 * MiB, WS_WOUTT = 102 * MiB, WS_WPQT = 134 * MiB, WS_UB = 150 * MiB, WS_VTB = 278 * MiB,
                 WS_HB = 406 * MiB, WS_MIX = 470 * MiB, WS_OG = 534 * MiB, WS_PROJ = 598 * MiB, WS_QN = 790 * MiB, WS_KN = 822 * MiB, WS_VTM = 854 * MiB, WS_HB8 = 886 * MiB, WS_END = 918 * MiB;
constexpr size_t WS_W = WS_PROJ;
constexpr size_t WS_W8 = WS_MIX;
constexpr size_t WS_WINT8 = WS_UB + 64 * MiB;
constexpr size_t WS_KH = 2 * MiB + 512 * 1024, WS_KL = 3 * MiB;
constexpr size_t WS_Q = WS_OG;
constexpr int LDS_BYTES = 131072 + 16;
constexpr int NPHASE = 11;

struct Params {
    const float *x, *g1, *win, *wgu, *bg, *glang, *qng, *kng, *wout, *g2, *wpq, *pkeys, *pu, *pv;
    float* out; unsigned char* ws; int ph_lo, ph_hi;
};

__device__ __forceinline__ float bf2f(unsigned short b) { return __uint_as_float(((unsigned)b) << 16); }
__device__ __forceinline__ unsigned short f2bf(float f) { unsigned u = __float_as_uint(f); u += 0x7FFFu + ((u >> 16) & 1u); return (unsigned short)(u >> 16); }
constexpr float SC_X = 16.f, SC_U = 1024.f, SC_W = 64.f, SC_V = 128.f;
__device__ __forceinline__ float clamp_f8(float x) { return __builtin_fminf(__builtin_fmaxf(x, -448.f), 448.f); }
__device__ __forceinline__ unsigned pk4_fp8(float a, float b, float c, float d) {
    int r = __builtin_amdgcn_cvt_pk_fp8_f32(clamp_f8(a), clamp_f8(b), 0, false); r = __builtin_amdgcn_cvt_pk_fp8_f32(clamp_f8(c), clamp_f8(d), r, true); return (unsigned)r; }
__device__ __forceinline__ float row16_max(float v) {
    v = fmaxf(v, __builtin_bit_cast(float, __builtin_amdgcn_update_dpp(0, __builtin_bit_cast(int, v), 0xB1, 0xF, 0xF, true)));
    v = fmaxf(v, __builtin_bit_cast(float, __builtin_amdgcn_update_dpp(0, __builtin_bit_cast(int, v), 0x4E, 0xF, 0xF, true)));
    v = fmaxf(v, __builtin_bit_cast(float, __builtin_amdgcn_update_dpp(0, __builtin_bit_cast(int, v), 0x141, 0xF, 0xF, true)));
    v = fmaxf(v, __builtin_bit_cast(float, __builtin_amdgcn_update_dpp(0, __builtin_bit_cast(int, v), 0x140, 0xF, 0xF, true)));
    return v;
}
__device__ __forceinline__ float row16_sum(float v) {
    v += __builtin_bit_cast(float, __builtin_amdgcn_update_dpp(0, __builtin_bit_cast(int, v), 0xB1, 0xF, 0xF, true));
    v += __builtin_bit_cast(float, __builtin_amdgcn_update_dpp(0, __builtin_bit_cast(int, v), 0x4E, 0xF, 0xF, true));
    v += __builtin_bit_cast(float, __builtin_amdgcn_update_dpp(0, __builtin_bit_cast(int, v), 0x141, 0xF, 0xF, true));
    v += __builtin_bit_cast(float, __builtin_amdgcn_update_dpp(0, __builtin_bit_cast(int, v), 0x140, 0xF, 0xF, true));
    return v;
}
__device__ __forceinline__ float wave_sum(float v) { v = row16_sum(v); v += __shfl_xor(v, 16); v += __shfl_xor(v, 32); return v; }
#define LDS_WAIT() asm volatile("s_waitcnt lgkmcnt(0)" ::: "memory")
#define MFMA16(a, b, c) __builtin_amdgcn_mfma_f32_16x16x32_bf16((a), (b), (c), 0, 0, 0)

__device__ __forceinline__ int win_remap(int n) { return n < 6144 ? n : (n < 6160 ? 12288 + (n - 6144) : n - 16); }
__device__ __forceinline__ void transpose_item(const float* W, int K, int N, int ld, bf16_t* WT, unsigned* T, int item, int lane, bool remap) {
    const int nblk = (N + 63) >> 6, kb = item / nblk, nb = item - kb * nblk, k0 = 64 * kb, n0 = 64 * nb;
    const int r4 = lane >> 4, cc = lane & 15, nn = n0 + 4 * cc; const bool ok = nn < N;
    float4 v[16];
#pragma unroll
    for (int jj = 0; jj < 8; ++jj)
#pragma unroll
        for (int bb = 0; bb < 2; ++bb) { const int kk = 8 * jj + 2 * r4 + bb; v[2 * jj + bb] = ok ? *(const float4*)(W + (size_t)(k0 + kk) * ld + nn) : make_float4(0.f, 0.f, 0.f, 0.f); }
#pragma unroll
    for (int jj = 0; jj < 8; ++jj) { const float4 a = v[2 * jj], bq = v[2 * jj + 1]; const int kw = 4 * jj + r4;
        T[(4 * cc + 0) * 33 + kw] = cvt_pk_bf16(a.x, bq.x); T[(4 * cc + 1) * 33 + kw] = cvt_pk_bf16(a.y, bq.y);
        T[(4 * cc + 2) * 33 + kw] = cvt_pk_bf16(a.z, bq.z); T[(4 * cc + 3) * 33 + kw] = cvt_pk_bf16(a.w, bq.w); }
    LDS_WAIT();
    const int kc = lane & 7;
#pragma unroll
    for (int jr = 0; jr < 8; ++jr) { const int n = (lane >> 3) + 8 * jr, ns = n0 + n; const unsigned* tp = T + n * 33 + 4 * kc;
        uint4 o; o.x = tp[0]; o.y = tp[1]; o.z = tp[2]; o.w = tp[3];
        if (ns < N) { const int nd = remap ? win_remap(ns) : ns; *(uint4*)(WT + (size_t)nd * K + k0 + 8 * kc) = o; } }
    LDS_WAIT();
}
__device__ __forceinline__ void transpose_item8(const float* W, int K, int N, int ld, unsigned char* WT, unsigned* T, int item, int lane, float sc) {
    const int nblk = (N + 63) >> 6, kb = item / nblk, nb = item - kb * nblk, k0 = 64 * kb, n0 = 64 * nb;
    const int r4 = lane >> 4, cc = lane & 15, nn = n0 + 4 * cc;
    float4 v[16];
#pragma unroll
    for (int jj = 0; jj < 4; ++jj)
#pragma unroll
        for (int bb = 0; bb < 4; ++bb) { const int kk = 16 * jj + 4 * r4 + bb; v[4 * jj + bb] = *(const float4*)(W + (size_t)(k0 + kk) * ld + nn); }
#pragma unroll
    for (int jj = 0; jj < 4; ++jj) { const float4 a = v[4 * jj], b = v[4 * jj + 1], c = v[4 * jj + 2], d = v[4 * jj + 3]; const int kw = 4 * jj + r4;
        T[(4 * cc + 0) * 17 + kw] = pk4_fp8(a.x * sc, b.x * sc, c.x * sc, d.x * sc); T[(4 * cc + 1) * 17 + kw] = pk4_fp8(a.y * sc, b.y * sc, c.y * sc, d.y * sc);
        T[(4 * cc + 2) * 17 + kw] = pk4_fp8(a.z * sc, b.z * sc, c.z * sc, d.z * sc); T[(4 * cc + 3) * 17 + kw] = pk4_fp8(a.w * sc, b.w * sc, c.w * sc, d.w * sc); }
    LDS_WAIT();
    const int kc = lane & 3;
#pragma unroll
    for (int jr = 0; jr < 4; ++jr) { const int n = (lane >> 2) + 16 * jr; const unsigned* tp = T + n * 17 + 4 * kc;
        uint4 o; o.x = tp[0]; o.y = tp[1]; o.z = tp[2]; o.w = tp[3];
        *(uint4*)(WT + (size_t)(n0 + n) * K + k0 + 16 * kc) = o; }
    LDS_WAIT();
}
template <bool F8OUT> __device__ __forceinline__ void rms_row(const float* xrow, const float* g, bf16_t* orow, unsigned* orow8, int lane) {
    const float4* xr = (const float4*)xrow + lane; float4 v[16]; float s = 0.f;
#pragma unroll
    for (int j = 0; j < 16; ++j) { v[j] = xr[64 * j]; s += (v[j].x * v[j].x + v[j].y * v[j].y) + (v[j].z * v[j].z + v[j].w * v[j].w); }
    const float r = rsqrtf(wave_sum(s) * (1.f / DM) + 1e-6f);
    const float4* gr = (const float4*)g + lane; uint2* o8 = (uint2*)orow + lane;
#pragma unroll
    for (int j = 0; j < 16; ++j) { const float4 gg = gr[64 * j]; const float y0 = (v[j].x * r) * gg.x, y1 = (v[j].y * r) * gg.y, y2 = (v[j].z * r) * gg.z, y3 = (v[j].w * r) * gg.w;
        uint2 o; o.x = cvt_pk_bf16(y0, y1); o.y = cvt_pk_bf16(y2, y3); o8[64 * j] = o;
        if (F8OUT) orow8[64 * j + lane] = pk4_fp8(y0 * SC_X, y1 * SC_X, y2 * SC_X, y3 * SC_X); }
}
__device__ __forceinline__ void phase_prep(const Params& p, unsigned char* sm) {
    const int tid = threadIdx.x, lane = tid & 63, w = tid >> 6;
    unsigned* scr = (unsigned*)(sm + w * 8704);
    const int gw = blockIdx.x * 8 + w, NGW = gridDim.x * 8;
    constexpr int I_WIN = 64 * 97, I_WIN8 = 64 * 96, I_WOUT = 64 * 64, I_WPQ = 64 * 32, I_PV = 256 * 64, I_PU = NEXP, I_X = NTOK;
    constexpr int NITEMS = I_WIN + I_WIN8 + I_WOUT + I_WPQ + I_PV + I_PU + I_X;
    bf16_t* WinT = (bf16_t*)(p.ws + WS_WINT); bf16_t* WoutT = (bf16_t*)(p.ws + WS_WOUTT); bf16_t* WpqT = (bf16_t*)(p.ws + WS_WPQT);
    unsigned* UB8 = (unsigned*)(p.ws + WS_UB); unsigned char* VTB8 = p.ws + WS_VTB; bf16_t* HB = (bf16_t*)(p.ws + WS_HB);
    { unsigned* KH = (unsigned*)(p.ws + WS_KH); unsigned* KL = (unsigned*)(p.ws + WS_KL);
      for (int i = blockIdx.x * 512 + tid; i < 8 * 2 * 128 * 128 / 2; i += gridDim.x * 512) { const float2 v = ((const float2*)p.pkeys)[i];
          const unsigned h = cvt_pk_bf16(v.x, v.y); KH[i] = h; KL[i] = cvt_pk_bf16(v.x - bf2f(h & 0xffff), v.y - bf2f(h >> 16)); } }
    for (int it = NITEMS - 1 - gw; it >= 0; it -= NGW) {
        int r = it;
        if (r < I_X) { rms_row<true>(p.x + (size_t)r * DM, p.g1, HB + (size_t)r * DM, (unsigned*)(p.ws + WS_HB8) + (size_t)r * (DM / 4), lane); continue; } r -= I_X;
        if (r < I_WIN) { transpose_item(p.win, DM, 6160, NIN, WinT, scr, r, lane, true); continue; } r -= I_WIN;
        if (r < I_WIN8) { transpose_item8(p.win + 6160, DM, 6144, NIN, p.ws + WS_WINT8, scr, r, lane, SC_U); continue; } r -= I_WIN8;
        if (r < I_WOUT) { transpose_item(p.wout, DM, DM, DM, WoutT, scr, r, lane, false); continue; } r -= I_WOUT;
        if (r < I_WPQ) { transpose_item(p.wpq, DM, 2048, 2048, WpqT, scr, r, lane, false); continue; } r -= I_WPQ;
        if (r < I_PV) { transpose_item8(p.pv, NEXP, DM, DM, VTB8, scr, r, lane, SC_V); continue; } r -= I_PV;
        { const float4* src = (const float4*)(p.pu + (size_t)r * DM) + lane; unsigned* dst = UB8 + (size_t)r * (DM / 4) + lane;
          float4 v[16];
#pragma unroll
          for (int j = 0; j < 16; ++j) v[j] = src[64 * j];
#pragma unroll
          for (int j = 0; j < 16; ++j) dst[64 * j] = pk4_fp8(v[j].x * SC_U, v[j].y * SC_U, v[j].z * SC_U, v[j].w * SC_U); }
    }
}

struct EpiProj {
    static constexpr bool PERM = true, AFTER_DRAIN = false;
    bf16_t* P; int coff; float sc;
    __device__ __forceinline__ void operator()(const f32x4 (&acc)[2][2][4][2], const Unit& u, int wr, int wc, int fr, int fq) const {
        const int row0 = u.pm * 256 + wr * 64 + fr, col0 = coff + u.pn * 256 + wc * 32 + 8 * fq;
#pragma unroll
        for (int ai = 0; ai < 2; ++ai)
#pragma unroll
            for (int m = 0; m < 4; ++m) { bf16_t* rowp = P + (size_t)(row0 + ai * 128 + m * 16) * PROJW + col0;
#pragma unroll
                for (int bj = 0; bj < 2; ++bj) { const f32x4 v0 = acc[ai][bj][m][0] * sc, v1 = acc[ai][bj][m][1] * sc;
                    uint4 o; o.x = cvt_pk_bf16(v0[0], v0[1]); o.y = cvt_pk_bf16(v0[2], v0[3]); o.z = cvt_pk_bf16(v1[0], v1[1]); o.w = cvt_pk_bf16(v1[2], v1[3]);
                    *(uint4*)(rowp + bj * 128) = o; } }
    }
};
struct EpiRes {
    static constexpr bool PERM = false, AFTER_DRAIN = false;
    float* C; const float* R; int ldc;
    __device__ __forceinline__ void operator()(const f32x4 (&acc)[2][2][4][2], const Unit& u, int wr, int wc, int fr, int fq) const {
        const int row0 = u.pm * 256 + wr * 64 + fr, col0 = u.pn * 256 + wc * 32 + 4 * fq;
#pragma unroll
        for (int ai = 0; ai < 2; ++ai)
#pragma unroll
            for (int m = 0; m < 4; ++m) { const size_t ro = (size_t)(row0 + ai * 128 + m * 16) * ldc + col0;
#pragma unroll
                for (int bj = 0; bj < 2; ++bj)
#pragma unroll
                    for (int n = 0; n < 2; ++n) { const f32x4 r = *(const f32x4*)(R + ro + bj * 128 + n * 16); *(f32x4*)(C + ro + bj * 128 + n * 16) = r + acc[ai][bj][m][n]; } }
    }
};
struct EpiF32 {
    static constexpr bool PERM = false, AFTER_DRAIN = false;
    float* C; int ldc;
    __device__ __forceinline__ void operator()(const f32x4 (&acc)[2][2][4][2], const Unit& u, int wr, int wc, int fr, int fq) const {
        const int row0 = u.pm * 256 + wr * 64 + fr, col0 = u.pn * 256 + wc * 32 + 4 * fq;
#pragma unroll
        for (int ai = 0; ai < 2; ++ai)
#pragma unroll
            for (int m = 0; m < 4; ++m) { float* rowp = C + (size_t)(row0 + ai * 128 + m * 16) * ldc + col0;
#pragma unroll
                for (int bj = 0; bj < 2; ++bj)
#pragma unroll
                    for (int n = 0; n < 2; ++n) *(f32x4*)(rowp + bj * 128 + n * 16) = acc[ai][bj][m][n]; }
    }
};
struct EpiResSc {
    static constexpr bool PERM = false, AFTER_DRAIN = false;
    float* C; const float* R; int ldc; float sc;
    __device__ __forceinline__ void operator()(const f32x4 (&acc)[2][2][4][2], const Unit& u, int wr, int wc, int fr, int fq) const {
        const int row0 = u.pm * 256 + wr * 64 + fr, col0 = u.pn * 256 + wc * 32 + 4 * fq;
#pragma unroll
        for (int ai = 0; ai < 2; ++ai)
#pragma unroll
            for (int m = 0; m < 4; ++m) { const size_t ro = (size_t)(row0 + ai * 128 + m * 16) * ldc + col0;
#pragma unroll
                for (int bj = 0; bj < 2; ++bj)
#pragma unroll
                    for (int n = 0; n < 2; ++n) { const f32x4 r = *(const f32x4*)(R + ro + bj * 128 + n * 16); *(f32x4*)(C + ro + bj * 128 + n * 16) = r + acc[ai][bj][m][n] * sc; } }
    }
};
constexpr float SC_G = 128.f;
struct EpiPeerW8 {
    static constexpr bool PERM = true, AFTER_DRAIN = false;
    const unsigned char* Gw; unsigned char* W8;
    __device__ __forceinline__ void operator()(const f32x4 (&acc)[2][2][4][2], const Unit& u, int wr, int wc, int fr, int fq) const {
        const int row0 = u.pm * 256 + wr * 64 + fr, col0 = u.pn * 256 + wc * 32 + 8 * fq; constexpr float isc = 1.f / (SC_X * SC_U), gsc = SC_W / SC_G;
#pragma unroll
        for (int ai = 0; ai < 2; ++ai)
#pragma unroll
            for (int m = 0; m < 4; ++m) { const size_t ro = (size_t)(row0 + ai * 128 + m * 16) * NEXP + col0;
#pragma unroll
                for (int bj = 0; bj < 2; ++bj) { const uint2 gv = *(const uint2*)(Gw + ro + bj * 128); uint2 o = make_uint2(0u, 0u);
                    if ((gv.x | gv.y) != 0u) {
                        const f32x4 v0 = acc[ai][bj][m][0] * isc, v1 = acc[ai][bj][m][1] * isc;
                        const f32x2 a = pg8::gelu_pk((f32x2){v0[0], v0[1]}), b = pg8::gelu_pk((f32x2){v0[2], v0[3]}), c = pg8::gelu_pk((f32x2){v1[0], v1[1]}), d = pg8::gelu_pk((f32x2){v1[2], v1[3]});
                        const int gx = (int)gv.x, gy = (int)gv.y;
                        o.x = pk4_fp8(a.x * __builtin_amdgcn_cvt_f32_fp8(gx, 0) * gsc, a.y * __builtin_amdgcn_cvt_f32_fp8(gx, 1) * gsc, b.x * __builtin_amdgcn_cvt_f32_fp8(gx, 2) * gsc, b.y * __builtin_amdgcn_cvt_f32_fp8(gx, 3) * gsc);
                        o.y = pk4_fp8(c.x * __builtin_amdgcn_cvt_f32_fp8(gy, 0) * gsc, c.y * __builtin_amdgcn_cvt_f32_fp8(gy, 1) * gsc, d.x * __builtin_amdgcn_cvt_f32_fp8(gy, 2) * gsc, d.y * __builtin_amdgcn_cvt_f32_fp8(gy, 3) * gsc); }
                    *(uint2*)(W8 + ro + bj * 128) = o; } }
    }
};

constexpr float QSCALE = 0.08838834764831845f * 1.4426950408889634f;
__device__ __forceinline__ void moba_prep_item(const Params& p, unsigned char* sm, int item) {
    const int tid = threadIdx.x, lane = tid & 63, w = tid >> 6;
    const int blk = item & 7, h = (item >> 3) & 15, b = item >> 7, bh = b * 16 + h;
    const bf16_t* proj = (const bf16_t*)(p.ws + WS_PROJ);
    bf16_t* QN = (bf16_t*)(p.ws + WS_QN); bf16_t* KN = (bf16_t*)(p.ws + WS_KN); bf16_t* VTM = (bf16_t*)(p.ws + WS_VTM); float* KM = (float*)(p.ws + WS_KM);
    bf16_t* VL = (bf16_t*)sm;
    float* KMS = (float*)(sm + 67584);
    const int d0 = 2 * lane;
    const float gq0 = p.qng[d0], gq1 = p.qng[d0 + 1], gk0 = p.kng[d0], gk1 = p.kng[d0 + 1];
    const int fi = d0 & 15;
    const float inv0 = exp2f(-(float)fi * (18.931568569324174f / 16.f)), inv1 = exp2f(-(float)(fi + 1) * (18.931568569324174f / 16.f));
    float km0 = 0.f, km1 = 0.f;
    __syncthreads();
    for (int t4 = 0; t4 < 32; t4 += 4) {
        unsigned qva[4], kva[4], vva[4];
#pragma unroll
        for (int u = 0; u < 4; ++u) { const int tt = w + 8 * (t4 + u); const bf16_t* pr = proj + ((size_t)b * SEQL + blk * 256 + tt) * PROJW;
            qva[u] = *(const unsigned*)(pr + 6144 + h * 128 + d0); kva[u] = *(const unsigned*)(pr + 8192 + h * 128 + d0); vva[u] = *(const unsigned*)(pr + 10240 + h * 128 + d0); }
#pragma unroll
        for (int u = 0; u < 4; ++u) { const int tt = w + 8 * (t4 + u); const int pos = blk * 256 + tt; const unsigned qv = qva[u], kv = kva[u], vv = vva[u];
        float q0 = bf2f(qv & 0xffff), q1 = bf2f(qv >> 16), k0 = bf2f(kv & 0xffff), k1 = bf2f(kv >> 16);
        const float rq = rsqrtf(wave_sum(q0 * q0 + q1 * q1) * (1.f / 128.f) + 1e-6f), rk = rsqrtf(wave_sum(k0 * k0 + k1 * k1) * (1.f / 128.f) + 1e-6f);
        q0 = (q0 * rq) * gq0; q1 = (q1 * rq) * gq1; k0 = (k0 * rk) * gk0; k1 = (k1 * rk) * gk1;
        const float pq0 = __shfl_xor(q0, 8), pq1 = __shfl_xor(q1, 8), pk0 = __shfl_xor(k0, 8), pk1 = __shfl_xor(k1, 8);
        if (lane < 16) {
            float a0 = (float)pos * inv0, a1 = (float)pos * inv1;
            float n0 = rintf(a0 * 0.15915494309189535f), n1 = rintf(a1 * 0.15915494309189535f);
            a0 = fmaf(-n0, 6.2831854820251465f, a0); a0 = fmaf(-n0, -1.7484555e-7f, a0);
            a1 = fmaf(-n1, 6.2831854820251465f, a1); a1 = fmaf(-n1, -1.7484555e-7f, a1);
            const float c0 = __cosf(a0), s0 = __sinf(a0), c1 = __cosf(a1), s1 = __sinf(a1);
            if (lane < 8) { q0 = q0 * c0 - pq0 * s0; q1 = q1 * c1 - pq1 * s1; k0 = k0 * c0 - pk0 * s0; k1 = k1 * c1 - pk1 * s1; }
            else          { q0 = q0 * c0 + pq0 * s0; q1 = q1 * c1 + pq1 * s1; k0 = k0 * c0 + pk0 * s0; k1 = k1 * c1 + pk1 * s1; }
        }
        km0 += k0; km1 += k1;
        const size_t o = ((size_t)bh * SEQL + pos) * 128 + d0;
        *(unsigned*)(QN + o) = cvt_pk_bf16(q0 * QSCALE, q1 * QSCALE);
        *(unsigned*)(KN + o) = cvt_pk_bf16(k0, k1);
        VL[d0 * 264 + tt] = (bf16_t)(vv & 0xffff); VL[(d0 + 1) * 264 + tt] = (bf16_t)(vv >> 16);
        } }
    KMS[w * 128 + d0] = km0; KMS[w * 128 + d0 + 1] = km1;
    __syncthreads();
    if (tid < 128) { float s = 0.f;
#pragma unroll
        for (int i = 0; i < 8; ++i) s += KMS[i * 128 + tid];
        KM[((size_t)bh * 8 + blk) * 128 + tid] = s * (1.f / 256.f); }
    for (int c = tid; c < 128 * 32; c += 512) { const int d = c >> 5, c8 = (c & 31) * 8;
        *(uint4*)(VTM + ((size_t)bh * 128 + d) * SEQL + blk * 256 + c8) = *(const uint4*)(VL + d * 264 + c8); }
}

__device__ __forceinline__ void glr_job(const Params& p, int job, int lane) {
    const int fr = lane & 15, fq = lane >> 4;
    const bf16_t* a = (const bf16_t*)(p.ws + WS_HB) + (size_t)(job * 16 + fr) * DM + fq * 8;
    const bf16_t* b = (const bf16_t*)(p.ws + WS_WINT) + (size_t)(12288 + fr) * DM + fq * 8;
    f32x4 acc0 = (f32x4){0.f, 0.f, 0.f, 0.f}, acc1 = acc0;
#pragma unroll 4
    for (int ks = 0; ks < 128; ks += 2) { const bf16x8 a0 = *(const bf16x8*)(a + ks * 32), b0 = *(const bf16x8*)(b + ks * 32), a1 = *(const bf16x8*)(a + ks * 32 + 32), b1 = *(const bf16x8*)(b + ks * 32 + 32);
        acc0 = MFMA16(a0, b0, acc0); acc1 = MFMA16(a1, b1, acc1); }
    float* glr = (float*)(p.ws + WS_GLR);
#pragma unroll
    for (int j = 0; j < 4; ++j) glr[(size_t)(job * 16 + fq * 4 + j) * 16 + fr] = acc0[j] + acc1[j];
}

constexpr size_t WS_GQD = WS_VTB + 64 * MiB, WS_GKI = WS_GQD + 16 * MiB, WS_GKST = WS_GKI + 16 * MiB, WS_GDEC = WS_GKST + 16 * MiB, WS_GVT = WS_HB8;
constexpr int GP_BC = 0, GP_GLR = 32768, GP_TOT = 36864, GP_KST = 38912, GP_VT = 57344;
__device__ __forceinline__ void gla_prep_item(const Params& p, unsigned char* sm, int item) {
    const int tid = threadIdx.x;
    const int h = item & 7, ch = item >> 3, t0 = ch * 64;
    float* BC = (float*)(sm + GP_BC); float* GLR = (float*)(sm + GP_GLR); float* TOT = (float*)(sm + GP_TOT); bf16_t* KST = (bf16_t*)(sm + GP_KST); bf16_t* VT = (bf16_t*)(sm + GP_VT);
    const bf16_t* proj = (const bf16_t*)(p.ws + WS_PROJ); const float* glr = (const float*)(p.ws + WS_GLR);
    bf16_t* QDg = (bf16_t*)(p.ws + WS_GQD) + (size_t)item * 8192; bf16_t* KIg = (bf16_t*)(p.ws + WS_GKI) + (size_t)item * 8192;
    bf16_t* KSTg = (bf16_t*)(p.ws + WS_GKST) + (size_t)item * 8192; bf16_t* VTg = (bf16_t*)(p.ws + WS_GVT) + (size_t)item * 16384; float* DECg = (float*)(p.ws + WS_GDEC) + (size_t)item * 128;
    __syncthreads();
    if (tid < 256) ((float4*)GLR)[tid] = ((const float4*)(glr + (size_t)t0 * 16))[tid];
    float wcol[16];
#pragma unroll
    for (int r = 0; r < 16; ++r) wcol[r] = p.wgu[r * 1024 + h * 128 + (tid & 127)];
    const float bias = p.bg[h * 128 + (tid & 127)];
    __syncthreads();
    {   const int d = tid & 127, part = tid >> 7; float la[16]; float run = 0.f;
#pragma unroll
        for (int i = 0; i < 16; ++i) { const float* gr = GLR + (part * 16 + i) * 16; float z = bias;
#pragma unroll
            for (int r = 0; r < 16; ++r) z = fmaf(gr[r], wcol[r], z);
            const float ls = fminf(z, 0.f) - __logf(1.f + __expf(-fabsf(z)));
            run += ls * (1.f / 16.f); la[i] = run; }
        TOT[part * 128 + d] = run;
        __syncthreads();
        float off = 0.f;
        for (int pp = 0; pp < part; ++pp) off += TOT[pp * 128 + d];
#pragma unroll
        for (int i = 0; i < 16; ++i) BC[(part * 16 + i) * 128 + d] = la[i] + off;
    }
    __syncthreads();
    if (tid < 128) DECg[tid] = __expf(BC[63 * 128 + tid]);
    for (int c = tid; c < 1024; c += 512) { const int s = c >> 4, dd = (c & 15) * 8;
        const bf16_t* pr = proj + (size_t)(t0 + s) * PROJW + h * 128 + dd;
        const uint4 qv = *(const uint4*)pr, kv = *(const uint4*)(pr + 1024);
        const unsigned qa[4] = {qv.x, qv.y, qv.z, qv.w}, ka[4] = {kv.x, kv.y, kv.z, kv.w};
        unsigned qo[4], ko[4];
#pragma unroll
        for (int i = 0; i < 4; ++i) {
            const float bc0 = BC[s * 128 + dd + 2 * i], bc1 = BC[s * 128 + dd + 2 * i + 1], bl0 = BC[63 * 128 + dd + 2 * i], bl1 = BC[63 * 128 + dd + 2 * i + 1];
            const float q0 = bf2f(qa[i] & 0xffff), q1 = bf2f(qa[i] >> 16), k0 = bf2f(ka[i] & 0xffff), k1 = bf2f(ka[i] >> 16);
            qo[i] = cvt_pk_bf16(q0 * 0.08838834764831845f * __expf(bc0), q1 * 0.08838834764831845f * __expf(bc1));
            ko[i] = cvt_pk_bf16(k0 * __expf(-bc0), k1 * __expf(-bc1));
            KST[(dd + 2 * i) * 72 + s] = f2bf(k0 * __expf(bl0 - bc0)); KST[(dd + 2 * i + 1) * 72 + s] = f2bf(k1 * __expf(bl1 - bc1)); }
        *(uint4*)(QDg + s * 128 + dd) = make_uint4(qo[0], qo[1], qo[2], qo[3]); *(uint4*)(KIg + s * 128 + dd) = make_uint4(ko[0], ko[1], ko[2], ko[3]); }
    for (int c = tid; c < 2048; c += 512) { const int s = c >> 5, e0 = (c & 31) * 8;
        const uint4 vv = *(const uint4*)(proj + (size_t)(t0 + s) * PROJW + 2048 + h * 256 + e0);
        const unsigned va[4] = {vv.x, vv.y, vv.z, vv.w};
#pragma unroll
        for (int i = 0; i < 4; ++i) { VT[(e0 + 2 * i) * 72 + s] = (bf16_t)(va[i] & 0xffff); VT[(e0 + 2 * i + 1) * 72 + s] = (bf16_t)(va[i] >> 16); } }
    __syncthreads();
    for (int c = tid; c < 1024; c += 512) { const int d = c >> 3, c8 = (c & 7) * 8; *(uint4*)(KSTg + d * 64 + c8) = *(const uint4*)(KST + d * 72 + c8); }
    for (int c = tid; c < 2048; c += 512) { const int e = c >> 3, c8 = (c & 7) * 8; *(uint4*)(VTg + e * 64 + c8) = *(const uint4*)(VT + e * 72 + c8); }
}
constexpr int GL_QD = 0, GL_KI = 17408, GL_KST = 34816, GL_VT = 53248, GL_ATT = 62464, GL_ST = 71680;
__device__ __forceinline__ void gla_item(const Params& p, unsigned char* sm, int item) {
    const int tid = threadIdx.x, lane = tid & 63, w = tid >> 6, fr = lane & 15, fq = lane >> 4;
    const int dvs = item & 3, h = (item >> 2) & 7, b = item >> 5;
    bf16_t* QD = (bf16_t*)(sm + GL_QD); bf16_t* KI = (bf16_t*)(sm + GL_KI); bf16_t* KST = (bf16_t*)(sm + GL_KST); bf16_t* VT = (bf16_t*)(sm + GL_VT);
    bf16_t* ATT = (bf16_t*)(sm + GL_ATT); bf16_t* ST = (bf16_t*)(sm + GL_ST);
    float* OG = (float*)(p.ws + WS_OG);
    const bf16_t* QDg = (const bf16_t*)(p.ws + WS_GQD); const bf16_t* KIg = (const bf16_t*)(p.ws + WS_GKI); const bf16_t* KSTg = (const bf16_t*)(p.ws + WS_GKST);
    const bf16_t* VTg = (const bf16_t*)(p.ws + WS_GVT); const float* DECg = (const float*)(p.ws + WS_GDEC);
    __syncthreads();
    for (int i = tid; i < 64 * 136 / 2; i += 512) ((unsigned*)ST)[i] = 0u;
    f32x4 Sacc[4];
#pragma unroll
    for (int i = 0; i < 4; ++i) Sacc[i] = (f32x4){0.f, 0.f, 0.f, 0.f};
    uint4 rq0, rq1, rk0, rk1, rs0, rs1, rv; float rd0, rd1, rd2, rd3;
#define GLA_FETCH(n_) do { const size_t it_ = (size_t)((b * 32 + (n_)) * 8 + h); \
        rq0 = *(const uint4*)(QDg + it_ * 8192 + tid * 8); rq1 = *(const uint4*)(QDg + it_ * 8192 + (tid + 512) * 8); \
        rk0 = *(const uint4*)(KIg + it_ * 8192 + tid * 8); rk1 = *(const uint4*)(KIg + it_ * 8192 + (tid + 512) * 8); \
        rs0 = *(const uint4*)(KSTg + it_ * 8192 + tid * 8); rs1 = *(const uint4*)(KSTg + it_ * 8192 + (tid + 512) * 8); \
        rv = *(const uint4*)(VTg + it_ * 16384 + (size_t)(dvs * 64) * 64 + tid * 8); \
        const float* dp_ = DECg + it_ * 128 + w * 16 + fq * 4; rd0 = dp_[0]; rd1 = dp_[1]; rd2 = dp_[2]; rd3 = dp_[3]; } while (0)
    GLA_FETCH(0);
    for (int n = 0; n < 32; ++n) {
        const int t0 = b * SEQL + n * 64;
        __syncthreads();
        { const int c0 = tid, c1 = tid + 512;
          *(uint4*)(QD + (c0 >> 4) * 136 + (c0 & 15) * 8) = rq0; *(uint4*)(QD + (c1 >> 4) * 136 + (c1 & 15) * 8) = rq1;
          *(uint4*)(KI + (c0 >> 4) * 136 + (c0 & 15) * 8) = rk0; *(uint4*)(KI + (c1 >> 4) * 136 + (c1 & 15) * 8) = rk1;
          *(uint4*)(KST + (c0 >> 3) * 72 + (c0 & 7) * 8) = rs0; *(uint4*)(KST + (c1 >> 3) * 72 + (c1 & 7) * 8) = rs1;
          *(uint4*)(VT + (tid >> 3) * 72 + (tid & 7) * 8) = rv; }
        const float dec[4] = {rd0, rd1, rd2, rd3};
        __syncthreads();
        if (n + 1 < 32) GLA_FETCH(n + 1);
        f32x4 oacc[2];
#pragma unroll
        for (int ti = 0; ti < 2; ++ti) { const int tile = 2 * w + ti, qt = tile >> 2, xt = tile & 3;
            f32x4 a = (f32x4){0.f, 0.f, 0.f, 0.f}, o = (f32x4){0.f, 0.f, 0.f, 0.f};
#pragma unroll
            for (int ks = 0; ks < 4; ++ks) { const bf16x8 af = *(const bf16x8*)(QD + (qt * 16 + fr) * 136 + ks * 32 + fq * 8);
                const bf16x8 bk = *(const bf16x8*)(KI + (xt * 16 + fr) * 136 + ks * 32 + fq * 8), bs = *(const bf16x8*)(ST + (xt * 16 + fr) * 136 + ks * 32 + fq * 8);
                a = MFMA16(af, bk, a); o = MFMA16(af, bs, o); }
#pragma unroll
            for (int j = 0; j < 4; ++j) { const int qq = qt * 16 + fq * 4 + j, ss = xt * 16 + fr; ATT[qq * 72 + ss] = f2bf(ss <= qq ? a[j] : 0.f); }
            oacc[ti] = o; }
        __syncthreads();
#pragma unroll
        for (int ti = 0; ti < 2; ++ti) { const int tile = 2 * w + ti, qt = tile >> 2, et = tile & 3; f32x4 o = oacc[ti];
#pragma unroll
            for (int ks = 0; ks < 2; ++ks) { const bf16x8 af = *(const bf16x8*)(ATT + (qt * 16 + fr) * 72 + ks * 32 + fq * 8), bv = *(const bf16x8*)(VT + (et * 16 + fr) * 72 + ks * 32 + fq * 8); o = MFMA16(af, bv, o); }
#pragma unroll
            for (int j = 0; j < 4; ++j) OG[(size_t)(t0 + qt * 16 + fq * 4 + j) * 2048 + h * 256 + dvs * 64 + et * 16 + fr] = o[j]; }
#pragma unroll
        for (int et = 0; et < 4; ++et) { f32x4 sv = Sacc[et];
#pragma unroll
            for (int j = 0; j < 4; ++j) sv[j] *= dec[j];
#pragma unroll
            for (int ks = 0; ks < 2; ++ks) { const bf16x8 af = *(const bf16x8*)(KST + (w * 16 + fr) * 72 + ks * 32 + fq * 8), bv = *(const bf16x8*)(VT + (et * 16 + fr) * 72 + ks * 32 + fq * 8); sv = MFMA16(af, bv, sv); }
            Sacc[et] = sv;
            uint2 pk; pk.x = cvt_pk_bf16(sv[0], sv[1]); pk.y = cvt_pk_bf16(sv[2], sv[3]);
            *(uint2*)(ST + (et * 16 + fr) * 136 + w * 16 + fq * 4) = pk; }
    }
}

constexpr int MB_KT = 0, MB_VT = 17408, MB_P = 35840, MB_MISC = 54272;
__device__ __forceinline__ void moba_item(const Params& p, unsigned char* sm, int item) {
    const int tid = threadIdx.x, lane = tid & 63, w = tid >> 6, fr = lane & 15, fq = lane >> 4;
    const int qt = 15 - (item >> 6), bh = item & 63, b = bh >> 4, h = bh & 15, q0 = qt * 128, blk = qt >> 1;
    const bf16_t* QNp = (const bf16_t*)(p.ws + WS_QN) + (size_t)bh * SEQL * 128; const bf16_t* KNp = (const bf16_t*)(p.ws + WS_KN) + (size_t)bh * SEQL * 128;
    const bf16_t* VTp = (const bf16_t*)(p.ws + WS_VTM) + (size_t)bh * 128 * SEQL; const float* KMp = (const float*)(p.ws + WS_KM) + (size_t)bh * 8 * 128;
    bf16_t* MIX = (bf16_t*)(p.ws + WS_MIX);
    bf16_t* KT = (bf16_t*)(sm + MB_KT); bf16_t* VT = (bf16_t*)(sm + MB_VT); bf16_t* Pw = (bf16_t*)(sm + MB_P) + w * 16 * 72; unsigned* bm = (unsigned*)(sm + MB_MISC);
    float* KMS = (float*)(sm + MB_MISC + 1024);
    __syncthreads();
    if (tid < blk * 32) ((float4*)KMS)[tid] = ((const float4*)KMp)[tid];
    if (tid == 0) *bm = 0u;
    __syncthreads();
    bf16x8 qf[4];
    { const bf16_t* qrow = QNp + (size_t)(q0 + w * 16 + fr) * 128;
#pragma unroll
      for (int ks = 0; ks < 4; ++ks) qf[ks] = *(const bf16x8*)(qrow + ks * 32 + fq * 8); }
    unsigned mask = 0u;
    { float g1 = -INFINITY, g2 = -INFINITY, g3 = -INFINITY; int i1 = -1, i2 = -1, i3 = -1;
      for (int n = 0; n < blk; ++n) { float part = 0.f;
#pragma unroll
          for (int ks = 0; ks < 4; ++ks) { const float* km = KMS + n * 128 + ks * 32 + fq * 8;
#pragma unroll
              for (int i = 0; i < 8; ++i) part = fmaf(bf2f((unsigned short)qf[ks][i]), km[i], part); }
          part += __shfl_xor(part, 16); part += __shfl_xor(part, 32);
          if (part > g1) { g3 = g2; i3 = i2; g2 = g1; i2 = i1; g1 = part; i1 = n; } else if (part > g2) { g3 = g2; i3 = i2; g2 = part; i2 = n; } else if (part > g3) { g3 = part; i3 = n; } }
      if (i1 >= 0) mask |= 1u << i1; if (i2 >= 0) mask |= 1u << i2; if (i3 >= 0) mask |= 1u << i3; }
    unsigned rm[4];
#pragma unroll
    for (int j = 0; j < 4; ++j) rm[j] = (unsigned)__shfl((int)mask, fq * 4 + j);
    { unsigned wm = mask;
#pragma unroll
      for (int o = 1; o < 16; o <<= 1) wm |= (unsigned)__shfl_xor((int)wm, o);
      if (lane == 0) atomicOr(bm, wm); }
    __syncthreads();
    const unsigned anym = *bm;
    f32x4 oacc[8];
#pragma unroll
    for (int i = 0; i < 8; ++i) oacc[i] = (f32x4){0.f, 0.f, 0.f, 0.f};
    float mrow[4] = {-1e30f, -1e30f, -1e30f, -1e30f}, lrow[4] = {0.f, 0.f, 0.f, 0.f};
    const int ntile = (q0 + 128) >> 6;
#define MB_NEXT(k_) do { while ((k_) < ntile && ((k_) >> 2) < blk && !((anym >> ((k_) >> 2)) & 1u)) ++(k_); } while (0)
    uint4 rka, rkb, rva, rvb;
#define MB_FETCH(k_) do { const int c0 = tid, c1 = tid + 512; \
        rka = *(const uint4*)(KNp + (size_t)((k_) * 64 + (c0 >> 4)) * 128 + (c0 & 15) * 8); rkb = *(const uint4*)(KNp + (size_t)((k_) * 64 + (c1 >> 4)) * 128 + (c1 & 15) * 8); \
        rva = *(const uint4*)(VTp + (size_t)(c0 >> 3) * SEQL + (k_) * 64 + (c0 & 7) * 8); rvb = *(const uint4*)(VTp + (size_t)(c1 >> 3) * SEQL + (k_) * 64 + (c1 & 7) * 8); } while (0)
    int kt = 0; MB_NEXT(kt);
    MB_FETCH(kt);
    while (kt < ntile) {
        const int kb = kt >> 2;
        __syncthreads();
        { const int c0 = tid, c1 = tid + 512, r0 = c0 >> 4, r1 = c1 >> 4;
          *(uint4*)(KT + ((r0 & 3) * 16 + (r0 >> 2)) * 136 + (c0 & 15) * 8) = rka; *(uint4*)(KT + ((r1 & 3) * 16 + (r1 >> 2)) * 136 + (c1 & 15) * 8) = rkb;
          *(uint4*)(VT + (c0 >> 3) * 72 + (c0 & 7) * 8) = rva; *(uint4*)(VT + (c1 >> 3) * 72 + (c1 & 7) * 8) = rvb; }
        __syncthreads();
        int nk = kt + 1; MB_NEXT(nk);
        if (nk < ntile) MB_FETCH(nk);
        f32x4 s[4];
#pragma unroll
        for (int g = 0; g < 4; ++g) s[g] = (f32x4){0.f, 0.f, 0.f, 0.f};
#pragma unroll
        for (int ks = 0; ks < 4; ++ks)
#pragma unroll
            for (int g = 0; g < 4; ++g) { const bf16x8 bk = *(const bf16x8*)(KT + (g * 16 + fr) * 136 + ks * 32 + fq * 8); s[g] = MFMA16(qf[ks], bk, s[g]); }
        float alpha[4]; bool resc = false;
#pragma unroll
        for (int j = 0; j < 4; ++j) { const int qpos = q0 + w * 16 + fq * 4 + j; const bool past = kb < blk; const bool rowok = past ? (((rm[j] >> kb) & 1u) != 0u) : true;
            float mx = -1e30f;
#pragma unroll
            for (int g = 0; g < 4; ++g) { const int kpos = kt * 64 + 4 * fr + g; const bool ok = rowok && (past || kpos <= qpos); const float sv = ok ? s[g][j] : -1e30f; s[g][j] = sv; mx = fmaxf(mx, sv); }
            mx = row16_max(mx);
            const float mnew = fmaxf(mrow[j], mx); alpha[j] = __builtin_amdgcn_exp2f(mrow[j] - mnew); resc = resc || (mnew != mrow[j]); mrow[j] = mnew;
            float rs = 0.f;
#pragma unroll
            for (int g = 0; g < 4; ++g) { const float pv = __builtin_amdgcn_exp2f(s[g][j] - mnew); s[g][j] = pv; rs += pv; }
            lrow[j] = lrow[j] * alpha[j] + rs;
            uint2 pk; pk.x = cvt_pk_bf16(s[0][j], s[1][j]); pk.y = cvt_pk_bf16(s[2][j], s[3][j]);
            *(uint2*)(Pw + (fq * 4 + j) * 72 + 4 * fr) = pk; }
        if (__ballot(resc)) {
#pragma unroll
            for (int j = 0; j < 4; ++j)
#pragma unroll
                for (int dt = 0; dt < 8; ++dt) oacc[dt][j] *= alpha[j]; }
        LDS_WAIT();
        bf16x8 pf[2];
#pragma unroll
        for (int ks = 0; ks < 2; ++ks) pf[ks] = *(const bf16x8*)(Pw + fr * 72 + ks * 32 + fq * 8);
#pragma unroll
        for (int dt = 0; dt < 8; ++dt)
#pragma unroll
            for (int ks = 0; ks < 2; ++ks) { const bf16x8 bv = *(const bf16x8*)(VT + (dt * 16 + fr) * 72 + ks * 32 + fq * 8); oacc[dt] = MFMA16(pf[ks], bv, oacc[dt]); }
        kt = nk;
    }
    float inv[4];
#pragma unroll
    for (int j = 0; j < 4; ++j) inv[j] = 1.f / row16_sum(lrow[j]);
#pragma unroll
    for (int dt = 0; dt < 8; ++dt)
#pragma unroll
        for (int j = 0; j < 4; ++j) MIX[(size_t)(b * SEQL + q0 + w * 16 + fq * 4 + j) * DM + 2048 + h * 128 + dt * 16 + fr] = f2bf(oacc[dt][j] * inv[j]);
}

__device__ __forceinline__ void gla_final(const Params& p) {
    const int tid = threadIdx.x, lane = tid & 63, w = tid >> 6;
    const float* OG = (const float*)(p.ws + WS_OG); const bf16_t* proj = (const bf16_t*)(p.ws + WS_PROJ); bf16_t* MIX = (bf16_t*)(p.ws + WS_MIX);
    const float4 gn = ((const float4*)p.glang)[lane];
    for (int it = blockIdx.x * 8 + w; it < NTOK * 8; it += gridDim.x * 8) { const int t = it >> 3, h = it & 7;
        const float4 o = ((const float4*)(OG + (size_t)t * 2048 + h * 256))[lane];
        const float r = rsqrtf(wave_sum((o.x * o.x + o.y * o.y) + (o.z * o.z + o.w * o.w)) * (1.f / 256.f) + 1e-6f);
        const uint2 gv = ((const uint2*)(proj + (size_t)t * PROJW + 4096 + h * 256))[lane];
        const float g0 = bf2f(gv.x & 0xffff), g1 = bf2f(gv.x >> 16), g2 = bf2f(gv.y & 0xffff), g3 = bf2f(gv.y >> 16);
        const float y0 = ((o.x * r) * gn.x) * (g0 / (1.f + __expf(-g0))), y1 = ((o.y * r) * gn.y) * (g1 / (1.f + __expf(-g1)));
        const float y2 = ((o.z * r) * gn.z) * (g2 / (1.f + __expf(-g2))), y3 = ((o.w * r) * gn.w) * (g3 / (1.f + __expf(-g3)));
        uint2 ov; ov.x = cvt_pk_bf16(y0, y1); ov.y = cvt_pk_bf16(y2, y3);
        ((uint2*)(MIX + (size_t)t * DM + h * 256))[lane] = ov; }
}

template <int N> __device__ __forceinline__ void bitonic_desc(unsigned (&x)[N]) {
#pragma unroll
    for (int k = 2; k <= N; k <<= 1)
#pragma unroll
        for (int j = k >> 1; j > 0; j >>= 1)
#pragma unroll
            for (int i = 0; i < N; ++i) { const int l = i ^ j;
                if (l > i) { const unsigned a = x[i], b = x[l], mx = a > b ? a : b, mn = a > b ? b : a;
                    if ((i & k) == 0) { x[i] = mx; x[l] = mn; } else { x[i] = mn; x[l] = mx; } } }
}
__device__ __forceinline__ void merge16(unsigned (&x)[16], int mask) {
    unsigned y[16];
#pragma unroll
    for (int i = 0; i < 16; ++i) y[i] = (unsigned)__shfl_xor((int)x[15 - i], mask);
#pragma unroll
    for (int i = 0; i < 16; ++i) x[i] = x[i] > y[i] ? x[i] : y[i];
    bitonic_desc<16>(x);
}
__device__ __forceinline__ unsigned mono(float f) { const unsigned u = __float_as_uint(f); return (u & 0x80000000u) ? ~u : (u | 0x80000000u); }
__device__ __forceinline__ float unmono(unsigned k) { return __uint_as_float((k & 0x80000000u) ? (k & 0x7fffffffu) : ~k); }
__device__ __forceinline__ void split_bf16(const float4 a, const float4 b, bf16x8& hi, bf16x8& lo) {
    const float x[8] = {a.x, a.y, a.z, a.w, b.x, b.y, b.z, b.w}; unsigned h[4], l[4];
#pragma unroll
    for (int i = 0; i < 4; ++i) { h[i] = cvt_pk_bf16(x[2 * i], x[2 * i + 1]); l[i] = cvt_pk_bf16(x[2 * i] - bf2f(h[i] & 0xffff), x[2 * i + 1] - bf2f(h[i] >> 16)); }
    hi = __builtin_bit_cast(bf16x8, make_uint4(h[0], h[1], h[2], h[3])); lo = __builtin_bit_cast(bf16x8, make_uint4(l[0], l[1], l[2], l[3]));
}
struct PairTab { int n; int i[64], j[64]; };
constexpr PairTab make_pairs() { PairTab t{}; t.n = 0; for (int a = 0; a < 16; ++a) for (int b = 0; b < 16; ++b) if ((a + 1) * (b + 1) <= 16) { t.i[t.n] = a; t.j[t.n] = b; ++t.n; } return t; }
__device__ __forceinline__ void peer_head(const Params& p, unsigned char* sm, int t0, int h, int lane, unsigned char* ibuf, int* LE, float* LG) {
    const int fr = lane & 15, fq = lane >> 4;
    const float* Q = (const float*)(p.ws + WS_Q); const bf16_t* KH = (const bf16_t*)(p.ws + WS_KH); const bf16_t* KL = (const bf16_t*)(p.ws + WS_KL);
    unsigned kk[2][16];
#pragma unroll
    for (int pp = 0; pp < 2; ++pp) {
        bf16x8 qh[4], ql[4];
        { const float* qr = Q + (size_t)(t0 + fr) * 2048 + h * 256 + pp * 128 + fq * 8;
#pragma unroll
          for (int ks = 0; ks < 4; ++ks) split_bf16(*(const float4*)(qr + ks * 32), *(const float4*)(qr + ks * 32 + 4), qh[ks], ql[ks]); }
        unsigned x[32];
#pragma unroll
        for (int n = 0; n < 8; ++n) { const size_t ko = ((size_t)(h * 2 + pp) * 128 + n * 16 + fr) * 128 + fq * 8; f32x4 acc = (f32x4){0.f, 0.f, 0.f, 0.f};
#pragma unroll
            for (int ks = 0; ks < 4; ++ks) { const bf16x8 kh = *(const bf16x8*)(KH + ko + ks * 32), kl = *(const bf16x8*)(KL + ko + ks * 32);
                acc = MFMA16(kh, qh[ks], acc); acc = MFMA16(kl, qh[ks], acc); acc = MFMA16(kh, ql[ks], acc); }
#pragma unroll
            for (int j = 0; j < 4; ++j) x[n * 4 + j] = (mono(acc[j]) & ~0x7Fu) | (unsigned)(n * 16 + fq * 4 + j); }
        bitonic_desc<32>(x);
#pragma unroll
        for (int i = 0; i < 16; ++i) kk[pp][i] = x[i];
        merge16(kk[pp], 16); merge16(kk[pp], 32);
    }
    constexpr PairTab PT = make_pairs();
    float v1[16], v2[16];
#pragma unroll
    for (int i = 0; i < 16; ++i) { v1[i] = unmono(kk[0][i] & ~0x7Fu); v2[i] = unmono(kk[1][i] & ~0x7Fu); }
    unsigned y[16];
#pragma unroll
    for (int c = 0; c < 16; ++c) { unsigned cand = 0u;
#pragma unroll
        for (int q = 0; q < 4; ++q) { const int idx = 4 * c + q;
            if (idx < PT.n) { const unsigned key = (mono(v1[PT.i[idx]] + v2[PT.j[idx]]) & ~0xFFu) | (unsigned)(PT.i[idx] * 16 + PT.j[idx]); cand = (fq == q) ? key : cand; } }
        y[c] = cand; }
    bitonic_desc<16>(y); merge16(y, 16); merge16(y, 32);
    if (fq == 0) {
#pragma unroll
        for (int c4 = 0; c4 < 4; ++c4) { unsigned w1 = 0u, w2 = 0u;
#pragma unroll
            for (int b = 0; b < 4; ++b) { w1 |= (kk[0][c4 * 4 + b] & 0x7Fu) << (8 * b); w2 |= (kk[1][c4 * 4 + b] & 0x7Fu) << (8 * b); }
            ((unsigned*)ibuf)[fr * 8 + c4] = w1; ((unsigned*)ibuf)[fr * 8 + 4 + c4] = w2; }
    }
    LDS_WAIT();
    if (fq == 0) { const float s0 = unmono(y[0] & ~0xFFu); float ex[16], sum = 0.f;
#pragma unroll
        for (int c = 0; c < 16; ++c) { ex[c] = __expf(unmono(y[c] & ~0xFFu) - s0); sum += ex[c]; }
        const float inv = 1.f / sum;
#pragma unroll
        for (int c = 0; c < 16; ++c) { const unsigned code = y[c] & 0xFFu; const int e = (int)ibuf[fr * 32 + (code >> 4)] * 128 + (int)ibuf[fr * 32 + 16 + (code & 15u)];
            LE[fr * 128 + h * 16 + c] = e; LG[fr * 128 + h * 16 + c] = ex[c] * inv; }
    }
}
constexpr int PE_IB = 0, PE_LE = 4096, PE_LG = 12288;
__device__ __forceinline__ void peer_item(const Params& p, unsigned char* sm, int item) {
    const int tid = threadIdx.x, lane = tid & 63, w = tid >> 6;
    const int t0 = item * 16;
    int* LE = (int*)(sm + PE_LE); float* LG = (float*)(sm + PE_LG); unsigned char* W = p.ws + WS_W;
    __syncthreads();
    { uint4* gz = (uint4*)(W + (size_t)t0 * NEXP) + tid; const uint4 z = make_uint4(0u, 0u, 0u, 0u);
#pragma unroll 8
      for (int i = 0; i < 32; ++i) gz[i * 512] = z; }
    peer_head(p, sm, t0, w, lane, sm + PE_IB + w * 512, LE, LG);
    asm volatile("s_waitcnt vmcnt(0)" ::: "memory");
    __syncthreads();
#pragma unroll
    for (int ti = 0; ti < 2; ++ti) { const int t = w * 2 + ti; const int* le = LE + t * 128; const float* lg = LG + t * 128;
        const int e0 = le[lane], e1 = le[lane + 64]; float g0 = 0.f, g1 = 0.f; bool f0 = true, f1 = true;
#pragma unroll 4
        for (int j4 = 0; j4 < 128; j4 += 4) { const int4 ev = *(const int4*)(le + j4); const float4 gv = *(const float4*)(lg + j4);
            const int ea[4] = {ev.x, ev.y, ev.z, ev.w}; const float ga[4] = {gv.x, gv.y, gv.z, gv.w};
#pragma unroll
            for (int q = 0; q < 4; ++q) { const int j = j4 + q;
                if (ea[q] == e0) { g0 += ga[q]; f0 = f0 && (j >= lane); }
                if (ea[q] == e1) { g1 += ga[q]; f1 = f1 && (j >= lane + 64); } } }
        unsigned char* wr = W + (size_t)(t0 + t) * NEXP;
        if (f0) wr[e0] = (unsigned char)(pk4_fp8(g0 * SC_G, 0.f, 0.f, 0.f) & 0xffu);
        if (f1) wr[e1] = (unsigned char)(pk4_fp8(g1 * SC_G, 0.f, 0.f, 0.f) & 0xffu); }
}

#define XB_TMO      128
#define XB_XCNT(j)  (256  + 64 * (j))
#define XB_XSUB(j)  (1280 + 64 * (j))
#define XB_XGEN(j)  (2304 + 64 * (j))
#define XB_TOP      3328
#define XB_TOPGEN   3392
#define XCD_BAR_WORDS 3456
#define XB_SPIN_CAP (1u << 18)
#define LAS __attribute__((address_space(3)))

__device__ __forceinline__ unsigned xb_ld(unsigned* p)              { return __hip_atomic_load(p, __ATOMIC_RELAXED, __HIP_MEMORY_SCOPE_AGENT); }
__device__ __forceinline__ unsigned xb_add(unsigned* p, unsigned v) { return __hip_atomic_fetch_add(p, v, __ATOMIC_RELAXED, __HIP_MEMORY_SCOPE_AGENT); }
__device__ __forceinline__ unsigned xb_xcc_id() { return (unsigned)__builtin_amdgcn_s_getreg((3 << 11) | 20) & 0xFu; }
#define XB_SPIN(cond, bar) do { unsigned _sp = 0; while (cond) { __builtin_amdgcn_s_sleep(1); \
    if ((++_sp & 255u) == 0u) { if (xb_ld(&(bar)[XB_TMO])) break; if (_sp > XB_SPIN_CAP) { atomicAdd(&(bar)[XB_TMO], 1u); break; } } } } while (0)

struct XcdBarrier {
    unsigned* bar; unsigned x;
    volatile LAS unsigned* st;
};

__device__ __forceinline__ XcdBarrier xcd_barrier_post(unsigned* bar, volatile LAS unsigned* st) {
    XcdBarrier b; b.bar = bar; b.x = xb_xcc_id(); b.st = st;
    if (threadIdx.x == 0) (void)xb_add(&bar[XB_XCNT(b.x)], 1u);
    return b;
}
__device__ __forceinline__ void xcd_barrier_complete(unsigned* bar, unsigned x, unsigned& nloc, unsigned& nx) {
    const unsigned G = gridDim.x * gridDim.y * gridDim.z;
    unsigned sum, cnt, mine, sp = 0u;
    for (;;) {
        sum = 0u; cnt = 0u; mine = 0u;
#pragma unroll
        for (unsigned j = 0; j < 16; ++j) { const unsigned c = xb_ld(&bar[XB_XCNT(j)]); sum += c; cnt += (c > 0u) ? 1u : 0u; mine = (j == x) ? c : mine; }
        if (sum == G) break;
        __builtin_amdgcn_s_sleep(1);
        if ((++sp & 255u) == 0u) { if (xb_ld(&bar[XB_TMO])) break; if (sp > XB_SPIN_CAP) { atomicAdd(&bar[XB_TMO], 1u); break; } }
    }
    nloc = mine > 0u ? mine : 1u; nx = cnt > 0u ? cnt : 1u;
}

__device__ __forceinline__ void xcd_barrier(const XcdBarrier& b) {
    asm volatile("s_waitcnt vmcnt(0)" ::: "memory");
    __syncthreads();
    if (threadIdx.x == 0) {
        unsigned* bar = b.bar;
        __builtin_amdgcn_s_waitcnt(0);
        unsigned nloc = b.st[0], nx = b.st[1];
        if (nloc == 0u) { xcd_barrier_complete(bar, b.x, nloc, nx); b.st[0] = nloc; b.st[1] = nx; }
        const unsigned old = xb_add(&bar[XB_XSUB(b.x)], 1u);
        const unsigned gen = old / nloc;
        if (old + 1u == (gen + 1u) * nloc) {
            __builtin_amdgcn_fence(__ATOMIC_RELEASE, "agent");
            asm volatile("s_waitcnt vmcnt(0)" ::: "memory");
            const unsigned og = xb_add(&bar[XB_TOP], 1u);
            const unsigned tg = og / nx;
            if (og + 1u == (tg + 1u) * nx) xb_add(&bar[XB_TOPGEN], 1u);
            else XB_SPIN(xb_ld(&bar[XB_TOPGEN]) == tg, bar);
            __builtin_amdgcn_fence(__ATOMIC_ACQUIRE, "agent");
            xb_add(&bar[XB_XGEN(b.x)], 1u);
            asm volatile("s_waitcnt vmcnt(0)" ::: "memory");
        } else {
            XB_SPIN(xb_ld(&bar[XB_XGEN(b.x)]) == gen, bar);
            __builtin_amdgcn_fence(__ATOMIC_ACQUIRE, "agent");
            asm volatile("s_waitcnt vmcnt(0)" ::: "memory");
        }
    }
    __syncthreads();
}

__global__ void __launch_bounds__(512, 2) hymba_fwd(Params p) {
    extern __shared__ __attribute__((aligned(16))) unsigned char smem[];
    cg::grid_group grid = cg::this_grid();
    volatile int& s_item = *(volatile int*)(smem + 131072);
    volatile LAS unsigned* bst = (volatile LAS unsigned*)(smem + 131072 + 8);
    if (threadIdx.x == 0) { bst[0] = 0u; bst[1] = 0u; }
    __syncthreads();
    XcdBarrier xb; xb.bar = (unsigned*)(p.ws + WS_CTRL); xb.x = 0u; xb.st = bst;
    const int tid = threadIdx.x, lane = tid & 63, w = tid >> 6;
    const int G = gridDim.x, c = blockIdx.x;
    unsigned* ctrl = (unsigned*)(p.ws + WS_CTRL) + 3584;
#define PH_ON(n) (p.ph_lo <= (n) && (n) < p.ph_hi)
#define PH_SYNC(n) if ((n) > p.ph_lo && (n) < p.ph_hi) { if ((n) == 1) { grid.sync(); xb = xcd_barrier_post((unsigned*)(p.ws + WS_CTRL), bst); } else xcd_barrier(xb); }
    if (PH_ON(0)) { if (c == 0) for (int i = tid; i < 4096; i += 512) ((unsigned*)(p.ws + WS_CTRL))[i] = 0u;
        phase_prep(p, smem); }
    PH_SYNC(1);
    if (PH_ON(1)) {
        { pg8::Gemm g{(const bf16_t*)(p.ws + WS_HB), (const bf16_t*)(p.ws + WS_WINT), NTOK, 6144, DM}; pg8::StaticOrder S; S.init(NTOK, 6144, G, c);
          EpiProj E{(bf16_t*)(p.ws + WS_PROJ), 0, 1.f}; pg8::gemm_phase<EpiProj, pg8::StaticOrder, false>((PG8_LAS unsigned char*)smem, g, S, E, nullptr); }
        { pg8::Gemm g{(const bf16_t*)(p.ws + WS_HB8), (const bf16_t*)(p.ws + WS_WINT8), NTOK, 6144, DM / 2}; pg8::StaticOrder S; S.init(NTOK, 6144, G, c);
          EpiProj E{(bf16_t*)(p.ws + WS_PROJ), 6144, 1.f / (SC_X * SC_U)}; pg8::gemm_phase<EpiProj, pg8::StaticOrder, false, true>((PG8_LAS unsigned char*)smem, g, S, E, nullptr); }
        for (int j = c * 8 + w; j < NTOK / 16; j += G * 8) glr_job(p, j, lane); }
    PH_SYNC(2);
    if (PH_ON(2)) { for (int it = c; it < 512; it += G) moba_prep_item(p, smem, it);
        for (int it = c; it < 1024; it += G) gla_prep_item(p, smem, it); }
    PH_SYNC(3);
    if (PH_ON(3)) for (;;) { __syncthreads(); if (tid == 0) s_item = (int)atomicAdd(ctrl, 1u); __syncthreads(); const int it = s_item; if (it >= 128 + 1024) break;
        if (it < 128) gla_item(p, smem, it); else moba_item(p, smem, it - 128); }
    PH_SYNC(4);
    if (PH_ON(4)) gla_final(p);
    PH_SYNC(5);
    if (PH_ON(5)) { pg8::Gemm g{(const bf16_t*)(p.ws + WS_MIX), (const bf16_t*)(p.ws + WS_WOUTT), NTOK, DM, DM}; pg8::StaticOrder S; S.init(NTOK, DM, G, c);
        EpiRes E{p.out, p.x, DM}; pg8::gemm_phase<EpiRes, pg8::StaticOrder, false>((PG8_LAS unsigned char*)smem, g, S, E, nullptr); }
    PH_SYNC(6);
    if (PH_ON(6)) { bf16_t* HB = (bf16_t*)(p.ws + WS_HB);
        for (int r = c * 8 + w; r < NTOK; r += G * 8) rms_row<true>(p.out + (size_t)r * DM, p.g2, HB + (size_t)r * DM, (unsigned*)(p.ws + WS_HB8) + (size_t)r * (DM / 4), lane);
        (void)0; }
    PH_SYNC(7);
    if (PH_ON(7)) { pg8::Gemm g{(const bf16_t*)(p.ws + WS_HB), (const bf16_t*)(p.ws + WS_WPQT), NTOK, 2048, DM}; pg8::StaticOrder S; S.init(NTOK, 2048, G, c);
        EpiF32 E{(float*)(p.ws + WS_Q), 2048}; pg8::gemm_phase<EpiF32, pg8::StaticOrder, false>((PG8_LAS unsigned char*)smem, g, S, E, nullptr); }
    PH_SYNC(8);
    if (PH_ON(8)) for (int it = c; it < NTOK / 16; it += G) peer_item(p, smem, it);
    PH_SYNC(9);
    if (PH_ON(9)) { pg8::Gemm g{(const bf16_t*)(p.ws + WS_HB8), (const bf16_t*)(p.ws + WS_UB), NTOK, NEXP, DM / 2}; pg8::StaticOrder S; S.init(NTOK, NEXP, G, c);
        EpiPeerW8 E{p.ws + WS_W, p.ws + WS_W8}; pg8::gemm_phase<EpiPeerW8, pg8::StaticOrder, false, true>((PG8_LAS unsigned char*)smem, g, S, E, nullptr); }
    PH_SYNC(10);
    if (PH_ON(10)) { pg8::Gemm g{(const bf16_t*)(p.ws + WS_W8), (const bf16_t*)(p.ws + WS_VTB), NTOK, DM, NEXP / 2}; pg8::StaticOrder S; S.init(NTOK, DM, G, c);
        EpiResSc E{p.out, p.out, DM, 1.f / (SC_W * SC_V)}; pg8::gemm_phase<EpiResSc, pg8::StaticOrder, false, true>((PG8_LAS unsigned char*)smem, g, S, E, nullptr); }
}

#ifndef MK_PER_PHASE
#define MK_PER_PHASE 0
#endif
extern "C" void kernel_launch(void* const* d_in, const int* in_sizes, int n_in, void* d_out, int out_size, void* d_ws, size_t ws_size, hipStream_t stream) {
    static int grid = 0;
    if (grid == 0) {
        if (n_in != 14 || out_size != NTOK * DM || ws_size < WS_END) { fprintf(stderr, "kernel_launch: unexpected shapes (n_in %d out %d ws %zu)\n", n_in, out_size, ws_size); grid = -1; return; }
        int dev = 0, cus = 0, per_cu = 0;
        hipGetDevice(&dev); hipDeviceGetAttribute(&cus, hipDeviceAttributeMultiprocessorCount, dev);
        if (hipFuncSetAttribute((const void*)hymba_fwd, hipFuncAttributeMaxDynamicSharedMemorySize, LDS_BYTES) != hipSuccess) { fprintf(stderr, "kernel_launch: hipFuncSetAttribute failed\n"); grid = -1; return; }
        if (hipOccupancyMaxActiveBlocksPerMultiprocessor(&per_cu, (const void*)hymba_fwd, 512, LDS_BYTES) != hipSuccess || per_cu < 1) { fprintf(stderr, "kernel_launch: occupancy query failed (%d)\n", per_cu); grid = -1; return; }
        grid = cus * (per_cu > 1 ? 1 : per_cu);
        fprintf(stderr, "kernel_launch: %d CUs, %d blocks/CU by query, grid %d\n", cus, per_cu, grid);
    }
    if (grid < 0) return;
    Params p{};
    p.x = (const float*)d_in[0]; p.g1 = (const float*)d_in[1]; p.win = (const float*)d_in[2]; p.wgu = (const float*)d_in[3]; p.bg = (const float*)d_in[4]; p.glang = (const float*)d_in[5];
    p.qng = (const float*)d_in[6]; p.kng = (const float*)d_in[7]; p.wout = (const float*)d_in[8]; p.g2 = (const float*)d_in[9]; p.wpq = (const float*)d_in[10]; p.pkeys = (const float*)d_in[11];
    p.pu = (const float*)d_in[12]; p.pv = (const float*)d_in[13]; p.out = (float*)d_out; p.ws = (unsigned char*)d_ws;
#if MK_PER_PHASE
    for (int ph = 0; ph < NPHASE; ++ph) { p.ph_lo = ph; p.ph_hi = ph + 1; void* args[] = {&p};
        hipError_t e = hipLaunchCooperativeKernel((const void*)hymba_fwd, dim3(grid), dim3(512), args, LDS_BYTES, stream);
        if (e != hipSuccess) { fprintf(stderr, "cooperative launch failed: %s\n", hipGetErrorString(e)); break; } }
#else
    p.ph_lo = 0; p.ph_hi = NPHASE; void* args[] = {&p};
    hipError_t e = hipLaunchCooperativeKernel((const void*)hymba_fwd, dim3(grid), dim3(512), args, LDS_BYTES, stream);
    if (e != hipSuccess) fprintf(stderr, "cooperative launch failed: %s (grid %d)\n", hipGetErrorString(e), grid);
#endif
}
```

```cpp
#include <hip/hip_runtime.h>
#include <hip/hip_cooperative_groups.h>
#include <cstdio>
#include <cstdint>
namespace cg = cooperative_groups;
namespace pg8 {
#define PG8_LAS __attribute__((address_space(3)))
typedef unsigned short bf16_t;
typedef short bf16x8 __attribute__((ext_vector_type(8)));
typedef float f32x4 __attribute__((ext_vector_type(4)));
typedef unsigned u32x4 __attribute__((ext_vector_type(4)));
constexpr int BM = 256, BK = 64, HALF = 128, HTB = HALF * BK * 2  , STAGE_BYTES = 8 * HTB, NXCD = 8, WGM = 8;

__host__ __device__ __forceinline__ int lds_byte(int r, int c) { const int st = (r >> 4) * 2 + (c >> 5), rr = r & 15, cc = c & 31, ob = rr * 64 + cc * 2; return st * 1024 + (ob ^ (((ob >> 9) & 1) << 5)); }
__host__ __device__ __forceinline__ void stage_rc(int b, int& R, int& C) { const int st = b / 1024, sb = b % 1024, swz = sb ^ (((sb >> 9) & 1) << 5); R = (st >> 1) * 16 + swz / 64; C = (st & 1) * 32 + (swz % 64) / 2; }
__host__ __device__ __forceinline__ int perm32(int rho) { const int n = rho >> 4, i = rho & 15; return 8 * (i >> 2) + 4 * n + (i & 3); }

struct Unit { int pm, pn; };
struct Gemm { const bf16_t* A; const bf16_t* Bt; int M, N, K; };

struct StaticOrder {
    int nM, nN, nwg, G, c;
    __host__ __device__ void init(int M, int N, int G_, int c_) { nM = M / BM; nN = N / BM; nwg = nM * nN; G = G_; c = c_; }
    __host__ __device__ bool next(int i, Unit& u) const {
        const long L = (long)i * G + c; if (L >= nwg) return false;
        int wgid = (int)L; { const int q = nwg / NXCD, r = nwg % NXCD, xcd = wgid % NXCD, off = wgid / NXCD; wgid = (xcd < r ? xcd * (q + 1) : r * (q + 1) + (xcd - r) * q) + off; }
        const int nig = WGM * nN, gid = wgid / nig, fm = gid * WGM, gsz = (nM - fm) < WGM ? (nM - fm) : WGM;
        u.pm = fm + ((wgid % nig) % gsz); u.pn = (wgid % nig) / gsz; return true;
    }
    __device__ __forceinline__ void a_ready(const Unit&) const {}
    __device__ __forceinline__ void done(const Unit&) const {}
};
typedef __bf16 bf16x2_t __attribute__((ext_vector_type(2)));
typedef float f32x2c_t __attribute__((ext_vector_type(2)));
__device__ __forceinline__ unsigned cvt_pk_bf16(float lo, float hi) { f32x2c_t v = {lo, hi}; bf16x2_t b = __builtin_convertvector(v, bf16x2_t); return __builtin_bit_cast(unsigned, b); }
typedef float f32x2 __attribute__((ext_vector_type(2)));
__device__ __forceinline__ f32x2 gelu_pk(f32x2 v) {
    const f32x2 av = __builtin_elementwise_abs(v), d = av * 0.2316418882f + 1.0f;
    f32x2 t; t.x = __builtin_amdgcn_rcpf(d.x); t.y = __builtin_amdgcn_rcpf(d.y);
    f32x2 q = t * 0.5307027145f + (-0.7265760135f); q = q * t + 0.7107068705f; q = q * t + (-0.142248368f); q = q * t + 0.127414796f; q = q * t;
    const f32x2 s = (v * v) * (-0.72134752044f);
    f32x2 e; e.x = __builtin_amdgcn_exp2f(s.x); e.y = __builtin_amdgcn_exp2f(s.y);
    const f32x2 m = v * (q * e), r = v - m;
    f32x2 o; o.x = v.x < 0.f ? m.x : r.x; o.y = v.y < 0.f ? m.y : r.y; return o;
}

typedef int i32x4 __attribute__((ext_vector_type(4)));
typedef int i32x8 __attribute__((ext_vector_type(8)));
__device__ __forceinline__ i32x8 cat16(const bf16x8 a, const bf16x8 b) { const i32x4 lo = __builtin_bit_cast(i32x4, a), hi = __builtin_bit_cast(i32x4, b); return __builtin_shufflevector(lo, hi, 0, 1, 2, 3, 4, 5, 6, 7); }
template <bool F8> __device__ __forceinline__ void mma_block(f32x4 (&accb)[4][2], const bf16x8 (&At)[4][2], const bf16x8 (&Bt)[2][2], const i32x8 (&At8)[4], const i32x8 (&Bt8)[2]) {
    if constexpr (F8) {
#pragma unroll
        for (int m = 0; m < 4; ++m)
#pragma unroll
            for (int n = 0; n < 2; ++n) asm volatile("v_mfma_f32_16x16x128_f8f6f4 %0, %1, %2, %0" : "+v"(accb[m][n]) : "v"(Bt8[n]), "v"(At8[m]));
    } else {
#pragma unroll
        for (int m = 0; m < 4; ++m)
#pragma unroll
            for (int n = 0; n < 2; ++n)
#pragma unroll
                for (int k = 0; k < 2; ++k) accb[m][n] = __builtin_amdgcn_mfma_f32_16x16x32_bf16(Bt[n][k], At[m][k], accb[m][n], 0, 0, 0);
    }
}
template <class Epi, class Sched, bool STAMP = false, bool F8 = false>
__device__ __forceinline__ void gemm_phase(PG8_LAS unsigned char* lds, const Gemm g, const Sched& S, const Epi& E, unsigned long long* stamps) {
    const int tid = threadIdx.x, wid = __builtin_amdgcn_readfirstlane(tid >> 6), lane = tid & 63, wr = wid >> 2, wc = wid & 3, fr = lane & 15, fq = lane >> 4;
    const int K = g.K, nt = K / BK;
    int ts_lo = 0, ts_hi = 0, nts = 0; const unsigned long long rt_entry = STAMP ? (unsigned long long)wall_clock64() : 0ull;
#define PG8_STAMP() do { if (STAMP && wid == 0 && nts < 64) { const unsigned long long _c = (unsigned long long)clock64(); \
        ts_lo = (lane == nts) ? (int)(unsigned)_c : ts_lo; ts_hi = (lane == nts) ? (int)(unsigned)(_c >> 32) : ts_hi; ++nts; } } while (0)
    PG8_STAMP();
    unsigned voffA[2], voffB[2];
#pragma unroll
    for (int i = 0; i < 2; ++i) { int R, C; stage_rc(tid * 16 + i * 8192, R, C); const int Rb = Epi::PERM ? ((R & ~31) + perm32(R & 31)) : R;
        voffA[i] = (unsigned)(R * K + C) * 2u; voffB[i] = (unsigned)(Rb * K + C) * 2u; }
    const size_t kstep = (size_t)(BK * 2);
    const size_t hstep = (size_t)HALF * K * 2;
    const size_t tstep = 2 * hstep;
    const unsigned ldsw = (unsigned)wid * 1024u;
    const int aoff = lds_byte(wr * 64 + fr, fq * 8), boff = lds_byte(wc * 32 + fr, fq * 8);
#define PG8_SA(b, h) (((b) * 2 + (h)) * HTB)
#define PG8_SB(b, h) ((4 + (b) * 2 + (h)) * HTB)
#define PG8_STAGE(bufoff, gbase, voff) do { _Pragma("unroll") for (int _i = 0; _i < 2; ++_i) \
        __builtin_amdgcn_global_load_lds((const unsigned*)((const char*)(gbase) + (voff)[_i]), (PG8_LAS unsigned*)(lds + (bufoff) + ldsw + _i * 8192), 16, 0, 0); } while (0)
#define PG8_LDA(dst, b, h) do { _Pragma("unroll") for (int m = 0; m < 4; ++m) { if constexpr (F8) dst##8[m] = cat16(*(const PG8_LAS bf16x8*)(lds + PG8_SA(b, h) + aoff + m * 2048), *(const PG8_LAS bf16x8*)(lds + PG8_SA(b, h) + aoff + m * 2048 + 1024)); else { _Pragma("unroll") for (int k = 0; k < 2; ++k) dst[m][k] = *(const PG8_LAS bf16x8*)(lds + PG8_SA(b, h) + aoff + m * 2048 + k * 1024); } } } while (0)
#define PG8_LDB(dst, b, h) do { _Pragma("unroll") for (int n = 0; n < 2; ++n) { if constexpr (F8) dst##8[n] = cat16(*(const PG8_LAS bf16x8*)(lds + PG8_SB(b, h) + boff + n * 2048), *(const PG8_LAS bf16x8*)(lds + PG8_SB(b, h) + boff + n * 2048 + 1024)); else { _Pragma("unroll") for (int k = 0; k < 2; ++k) dst[n][k] = *(const PG8_LAS bf16x8*)(lds + PG8_SB(b, h) + boff + n * 2048 + k * 1024); } } } while (0)
#define PG8_MMA(ai, bj, At, Bt) do { __builtin_amdgcn_s_setprio(1); mma_block<F8>(acc[ai][bj], At, Bt, At##8, Bt##8); __builtin_amdgcn_s_setprio(0); } while (0)
#define PG8_WAIT_V(n) asm volatile("s_waitcnt vmcnt(" #n ")" ::: "memory")
#define PG8_WAIT_L(n) asm volatile("s_waitcnt lgkmcnt(" #n ")" ::: "memory")
#define PG8_BAR __builtin_amdgcn_s_barrier()
#define PG8_SCHED __builtin_amdgcn_sched_barrier(0)
    Unit cur, nxt; int ui = 0;
    if (!S.next(0, cur)) return;
    f32x4 acc[2][2][4][2];
#pragma unroll
    for (int a = 0; a < 2; ++a)
#pragma unroll
        for (int b = 0; b < 2; ++b)
#pragma unroll
            for (int m = 0; m < 4; ++m)
#pragma unroll
                for (int n = 0; n < 2; ++n) acc[a][b][m][n] = (f32x4){0.f, 0.f, 0.f, 0.f};
    bf16x8 At[4][2], B0[2][2], B1[2][2]; i32x8 At8[4], B08[2], B18[2];
    const char* cA = (const char*)g.A + (size_t)cur.pm * tstep; const char* cB = (const char*)g.Bt + (size_t)cur.pn * tstep;
    S.a_ready(cur);
    PG8_STAGE(PG8_SB(0, 0), cB, voffB); PG8_STAGE(PG8_SA(0, 0), cA, voffA); PG8_STAGE(PG8_SB(0, 1), cB + hstep, voffB); PG8_STAGE(PG8_SA(0, 1), cA + hstep, voffA);
    if (wr == 1) PG8_BAR;
    PG8_WAIT_V(4); PG8_BAR;
    PG8_STAGE(PG8_SB(1, 0), cB + kstep, voffB); PG8_STAGE(PG8_SA(1, 0), cA + kstep, voffA); PG8_STAGE(PG8_SB(1, 1), cB + hstep + kstep, voffB);
    PG8_WAIT_V(6); PG8_BAR;
    PG8_STAMP();
    for (;;) {
        const bool has_next = S.next(ui + 1, nxt);
        const char* nA = has_next ? (const char*)g.A + (size_t)nxt.pm * tstep : cA; const char* nB = has_next ? (const char*)g.Bt + (size_t)nxt.pn * tstep : cB;
        for (int t = 0; t < nt; t += 2) {
            const bool last = (t == nt - 2);
            const char* a1 = cA + (size_t)(t + 1) * kstep;
            const char* a2 = last ? nA : cA + (size_t)(t + 2) * kstep; const char* b2 = last ? nB : cB + (size_t)(t + 2) * kstep;
            const char* a3 = a2 + kstep; const char* b3 = b2 + kstep;
            if (last && has_next) S.a_ready(nxt);
            PG8_LDB(B0, 0, 0); PG8_SCHED; PG8_LDA(At, 0, 0); PG8_STAGE(PG8_SA(1, 1), a1 + hstep, voffA);
            PG8_WAIT_L(8); PG8_BAR; PG8_WAIT_L(0); PG8_MMA(0, 0, At, B0); PG8_BAR; PG8_SCHED;
            PG8_LDB(B1, 0, 1); PG8_STAGE(PG8_SB(0, 0), b2, voffB);
            PG8_BAR; PG8_WAIT_L(0); PG8_MMA(0, 1, At, B1); PG8_BAR;
            PG8_LDA(At, 0, 1); PG8_STAGE(PG8_SA(0, 0), a2, voffA);
            PG8_BAR; PG8_WAIT_L(0); PG8_MMA(1, 0, At, B0); PG8_BAR; PG8_SCHED;
            PG8_STAGE(PG8_SB(0, 1), b2 + hstep, voffB);
            PG8_WAIT_V(6); PG8_BAR; PG8_MMA(1, 1, At, B1); PG8_BAR;
            PG8_LDB(B0, 1, 0); PG8_SCHED; PG8_LDA(At, 1, 0); PG8_STAGE(PG8_SA(0, 1), a2 + hstep, voffA);
            PG8_WAIT_L(8); PG8_BAR; PG8_WAIT_L(0); PG8_MMA(0, 0, At, B0); PG8_BAR; PG8_SCHED;
            PG8_LDB(B1, 1, 1); PG8_STAGE(PG8_SB(1, 0), b3, voffB);
            PG8_BAR; PG8_WAIT_L(0); PG8_MMA(0, 1, At, B1); PG8_BAR;
            PG8_LDA(At, 1, 1); PG8_STAGE(PG8_SA(1, 0), a3, voffA);
            PG8_BAR; PG8_WAIT_L(0); PG8_MMA(1, 0, At, B0); PG8_BAR; PG8_SCHED;
            PG8_STAGE(PG8_SB(1, 1), b3 + hstep, voffB);
            PG8_WAIT_V(6); PG8_BAR; PG8_MMA(1, 1, At, B1); PG8_BAR;
        }
        PG8_STAMP();
        if constexpr (!Epi::AFTER_DRAIN) { E(acc, cur, wr, wc, fr, fq); S.done(cur); }
        PG8_STAMP();
        if (!has_next) break;
#pragma unroll
        for (int a = 0; a < 2; ++a)
#pragma unroll
            for (int b = 0; b < 2; ++b)
#pragma unroll
                for (int m = 0; m < 4; ++m)
#pragma unroll
                    for (int n = 0; n < 2; ++n) acc[a][b][m][n] = (f32x4){0.f, 0.f, 0.f, 0.f};
        cur = nxt; cA = nA; cB = nB; ++ui;
    }
    PG8_WAIT_V(0);
    if (wr == 0) PG8_BAR;
    PG8_BAR;
    if constexpr (Epi::AFTER_DRAIN) { E.fused(acc, cur, wr, wc, fr, fq, lds, wid, lane); S.done(cur); }
    PG8_STAMP();
    if (STAMP && wid == 0) { stamps[lane] = lane < nts ? (((unsigned long long)(unsigned)ts_hi << 32) | (unsigned)ts_lo) : 0ull;
        if (lane == 62) stamps[62] = rt_entry; if (lane == 63) stamps[63] = (unsigned long long)wall_clock64(); }
#undef PG8_STAMP
#undef PG8_SA
#undef PG8_SB
#undef PG8_STAGE
#undef PG8_LDA
#undef PG8_LDB
#undef PG8_MMA
#undef PG8_WAIT_V
#undef PG8_WAIT_L
#undef PG8_BAR
#undef PG8_SCHED
}
}

using pg8::bf16_t; using pg8::bf16x8; using pg8::f32x4; using pg8::f32x2; using pg8::cvt_pk_bf16; using pg8::Unit;
typedef unsigned long long u64;

constexpr int NTOK = 8192, DM = 4096, SEQL = 2048;
constexpr int NIN = 12304, NINP = 12544, PROJW = 12288;
constexpr int NEXP = 16384;
constexpr size_t MiB = 1024ull * 1024ull;
constexpr size_t WS_CTRL = 0, WS_KM = 1 * MiB, WS_GLR = 2 * MiB, WS_WINT = 4 * MiB, WS_WOUTT = 102 * MiB, WS_WPQT = 134 * MiB, WS_UB = 150 * MiB, WS_VTB = 278 * MiB,
                 WS_HB = 406 * MiB, WS_MIX = 470 * MiB, WS_OG = 534 * MiB, WS_PROJ = 598 * MiB, WS_QN = 790 * MiB, WS_KN = 822 * MiB, WS_VTM = 854 * MiB, WS_HB8 = 886 * MiB, WS_END = 918 * MiB;
constexpr size_t WS_W = WS_PROJ;
constexpr size_t WS_W8 = WS_MIX;
constexpr size_t WS_WINT8 = WS_UB + 64 * MiB;
constexpr size_t WS_KH = 2 * MiB + 512 * 1024, WS_KL = 3 * MiB;
constexpr size_t WS_Q = WS_OG;
constexpr int LDS_BYTES = 131072 + 16;
constexpr int NPHASE = 11;

struct Params {
    const float *x, *g1, *win, *wgu, *bg, *glang, *qng, *kng, *wout, *g2, *wpq, *pkeys, *pu, *pv;
    float* out; unsigned char* ws; int ph_lo, ph_hi;
};

__device__ __forceinline__ float bf2f(unsigned short b) { return __uint_as_float(((unsigned)b) << 16); }
__device__ __forceinline__ unsigned short f2bf(float f) { unsigned u = __float_as_uint(f); u += 0x7FFFu + ((u >> 16) & 1u); return (unsigned short)(u >> 16); }
constexpr float SC_X = 16.f, SC_U = 1024.f, SC_W = 64.f, SC_V = 128.f;
__device__ __forceinline__ float clamp_f8(float x) { return __builtin_fminf(__builtin_fmaxf(x, -448.f), 448.f); }
__device__ __forceinline__ unsigned pk4_fp8(float a, float b, float c, float d) {
    int r = __builtin_amdgcn_cvt_pk_fp8_f32(clamp_f8(a), clamp_f8(b), 0, false); r = __builtin_amdgcn_cvt_pk_fp8_f32(clamp_f8(c), clamp_f8(d), r, true); return (unsigned)r; }
__device__ __forceinline__ float row16_max(float v) {
    v = fmaxf(v, __builtin_bit_cast(float, __builtin_amdgcn_update_dpp(0, __builtin_bit_cast(int, v), 0xB1, 0xF, 0xF, true)));
    v = fmaxf(v, __builtin_bit_cast(float, __builtin_amdgcn_update_dpp(0, __builtin_bit_cast(int, v), 0x4E, 0xF, 0xF, true)));
    v = fmaxf(v, __builtin_bit_cast(float, __builtin_amdgcn_update_dpp(0, __builtin_bit_cast(int, v), 0x141, 0xF, 0xF, true)));
    v = fmaxf(v, __builtin_bit_cast(float, __builtin_amdgcn_update_dpp(0, __builtin_bit_cast(int, v), 0x140, 0xF, 0xF, true)));
    return v;
}
__device__ __forceinline__ float row16_sum(float v) {
    v += __builtin_bit_cast(float, __builtin_amdgcn_update_dpp(0, __builtin_bit_cast(int, v), 0xB1, 0xF, 0xF, true));
    v += __builtin_bit_cast(float, __builtin_amdgcn_update_dpp(0, __builtin_bit_cast(int, v), 0x4E, 0xF, 0xF, true));
    v += __builtin_bit_cast(float, __builtin_amdgcn_update_dpp(0, __builtin_bit_cast(int, v), 0x141, 0xF, 0xF, true));
    v += __builtin_bit_cast(float, __builtin_amdgcn_update_dpp(0, __builtin_bit_cast(int, v), 0x140, 0xF, 0xF, true));
    return v;
}
__device__ __forceinline__ float wave_sum(float v) { v = row16_sum(v); v += __shfl_xor(v, 16); v += __shfl_xor(v, 32); return v; }
#define LDS_WAIT() asm volatile("s_waitcnt lgkmcnt(0)" ::: "memory")
#define MFMA16(a, b, c) __builtin_amdgcn_mfma_f32_16x16x32_bf16((a), (b), (c), 0, 0, 0)

__device__ __forceinline__ int win_remap(int n) { return n < 6144 ? n : (n < 6160 ? 12288 + (n - 6144) : n - 16); }
__device__ __forceinline__ void transpose_item(const float* W, int K, int N, int ld, bf16_t* WT, unsigned* T, int item, int lane, bool remap) {
    const int nblk = (N + 63) >> 6, kb = item / nblk, nb = item - kb * nblk, k0 = 64 * kb, n0 = 64 * nb;
    const int r4 = lane >> 4, cc = lane & 15, nn = n0 + 4 * cc; const bool ok = nn < N;
    float4 v[16];
#pragma unroll
    for (int jj = 0; jj < 8; ++jj)
#pragma unroll
        for (int bb = 0; bb < 2; ++bb) { const int kk = 8 * jj + 2 * r4 + bb; v[2 * jj + bb] = ok ? *(const float4*)(W + (size_t)(k0 + kk) * ld + nn) : make_float4(0.f, 0.f, 0.f, 0.f); }
#pragma unroll
    for (int jj = 0; jj < 8; ++jj) { const float4 a = v[2 * jj], bq = v[2 * jj + 1]; const int kw = 4 * jj + r4;
        T[(4 * cc + 0) * 33 + kw] = cvt_pk_bf16(a.x, bq.x); T[(4 * cc + 1) * 33 + kw] = cvt_pk_bf16(a.y, bq.y);
        T[(4 * cc + 2) * 33 + kw] = cvt_pk_bf16(a.z, bq.z); T[(4 * cc + 3) * 33 + kw] = cvt_pk_bf16(a.w, bq.w); }
    LDS_WAIT();
    const int kc = lane & 7;
#pragma unroll
    for (int jr = 0; jr < 8; ++jr) { const int n = (lane >> 3) + 8 * jr, ns = n0 + n; const unsigned* tp = T + n * 33 + 4 * kc;
        uint4 o; o.x = tp[0]; o.y = tp[1]; o.z = tp[2]; o.w = tp[3];
        if (ns < N) { const int nd = remap ? win_remap(ns) : ns; *(uint4*)(WT + (size_t)nd * K + k0 + 8 * kc) = o; } }
    LDS_WAIT();
}
__device__ __forceinline__ void transpose_item8(const float* W, int K, int N, int ld, unsigned char* WT, unsigned* T, int item, int lane, float sc) {
    const int nblk = (N + 63) >> 6, kb = item / nblk, nb = item - kb * nblk, k0 = 64 * kb, n0 = 64 * nb;
    const int r4 = lane >> 4, cc = lane & 15, nn = n0 + 4 * cc;
    float4 v[16];
#pragma unroll
    for (int jj = 0; jj < 4; ++jj)
#pragma unroll
        for (int bb = 0; bb < 4; ++bb) { const int kk = 16 * jj + 4 * r4 + bb; v[4 * jj + bb] = *(const float4*)(W + (size_t)(k0 + kk) * ld + nn); }
#pragma unroll
    for (int jj = 0; jj < 4; ++jj) { const float4 a = v[4 * jj], b = v[4 * jj + 1], c = v[4 * jj + 2], d = v[4 * jj + 3]; const int kw = 4 * jj + r4;
        T[(4 * cc + 0) * 17 + kw] = pk4_fp8(a.x * sc, b.x * sc, c.x * sc, d.x * sc); T[(4 * cc + 1) * 17 + kw] = pk4_fp8(a.y * sc, b.y * sc, c.y * sc, d.y * sc);
        T[(4 * cc + 2) * 17 + kw] = pk4_fp8(a.z * sc, b.z * sc, c.z * sc, d.z * sc); T[(4 * cc + 3) * 17 + kw] = pk4_fp8(a.w * sc, b.w * sc, c.w * sc, d.w * sc); }
    LDS_WAIT();
    const int kc = lane & 3;
#pragma unroll
    for (int jr = 0; jr < 4; ++jr) { const int n = (lane >> 2) + 16 * jr; const unsigned* tp = T + n * 17 + 4 * kc;
        uint4 o; o.x = tp[0]; o.y = tp[1]; o.z = tp[2]; o.w = tp[3];
        *(uint4*)(WT + (size_t)(n0 + n) * K + k0 + 16 * kc) = o; }
    LDS_WAIT();
}
template <bool F8OUT> __device__ __forceinline__ void rms_row(const float* xrow, const float* g, bf16_t* orow, unsigned* orow8, int lane) {
    const float4* xr = (const float4*)xrow + lane; float4 v[16]; float s = 0.f;
#pragma unroll
    for (int j = 0; j < 16; ++j) { v[j] = xr[64 * j]; s += (v[j].x * v[j].x + v[j].y * v[j].y) + (v[j].z * v[j].z + v[j].w * v[j].w); }
    const float r = rsqrtf(wave_sum(s) * (1.f / DM) + 1e-6f);
    const float4* gr = (const float4*)g + lane; uint2* o8 = (uint2*)orow + lane;
#pragma unroll
    for (int j = 0; j < 16; ++j) { const float4 gg = gr[64 * j]; const float y0 = (v[j].x * r) * gg.x, y1 = (v[j].y * r) * gg.y, y2 = (v[j].z * r) * gg.z, y3 = (v[j].w * r) * gg.w;
        uint2 o; o.x = cvt_pk_bf16(y0, y1); o.y = cvt_pk_bf16(y2, y3); o8[64 * j] = o;
        if (F8OUT) orow8[64 * j + lane] = pk4_fp8(y0 * SC_X, y1 * SC_X, y2 * SC_X, y3 * SC_X); }
}
__device__ __forceinline__ void phase_prep(const Params& p, unsigned char* sm) {
    const int tid = threadIdx.x, lane = tid & 63, w = tid >> 6;
    unsigned* scr = (unsigned*)(sm + w * 8704);
    const int gw = blockIdx.x * 8 + w, NGW = gridDim.x * 8;
    constexpr int I_WIN = 64 * 97, I_WIN8 = 64 * 96, I_WOUT = 64 * 64, I_WPQ = 64 * 32, I_PV = 256 * 64, I_PU = NEXP, I_X = NTOK;
    constexpr int NITEMS = I_WIN + I_WIN8 + I_WOUT + I_WPQ + I_PV + I_PU + I_X;
    bf16_t* WinT = (bf16_t*)(p.ws + WS_WINT); bf16_t* WoutT = (bf16_t*)(p.ws + WS_WOUTT); bf16_t* WpqT = (bf16_t*)(p.ws + WS_WPQT);
    unsigned* UB8 = (unsigned*)(p.ws + WS_UB); unsigned char* VTB8 = p.ws + WS_VTB; bf16_t* HB = (bf16_t*)(p.ws + WS_HB);
    { unsigned* KH = (unsigned*)(p.ws + WS_KH); unsigned* KL = (unsigned*)(p.ws + WS_KL);
      for (int i = blockIdx.x * 512 + tid; i < 8 * 2 * 128 * 128 / 2; i += gridDim.x * 512) { const float2 v = ((const float2*)p.pkeys)[i];
          const unsigned h = cvt_pk_bf16(v.x, v.y); KH[i] = h; KL[i] = cvt_pk_bf16(v.x - bf2f(h & 0xffff), v.y - bf2f(h >> 16)); } }
    for (int it = NITEMS - 1 - gw; it >= 0; it -= NGW) {
        int r = it;
        if (r < I_X) { rms_row<true>(p.x + (size_t)r * DM, p.g1, HB + (size_t)r * DM, (unsigned*)(p.ws + WS_HB8) + (size_t)r * (DM / 4), lane); continue; } r -= I_X;
        if (r < I_WIN) { transpose_item(p.win, DM, 6160, NIN, WinT, scr, r, lane, true); continue; } r -= I_WIN;
        if (r < I_WIN8) { transpose_item8(p.win + 6160, DM, 6144, NIN, p.ws + WS_WINT8, scr, r, lane, SC_U); continue; } r -= I_WIN8;
        if (r < I_WOUT) { transpose_item(p.wout, DM, DM, DM, WoutT, scr, r, lane, false); continue; } r -= I_WOUT;
        if (r < I_WPQ) { transpose_item(p.wpq, DM, 2048, 2048, WpqT, scr, r, lane, false); continue; } r -= I_WPQ;
        if (r < I_PV) { transpose_item8(p.pv, NEXP, DM, DM, VTB8, scr, r, lane, SC_V); continue; } r -= I_PV;
        { const float4* src = (const float4*)(p.pu + (size_t)r * DM) + lane; unsigned* dst = UB8 + (size_t)r * (DM / 4) + lane;
          float4 v[16];
#pragma unroll
          for (int j = 0; j < 16; ++j) v[j] = src[64 * j];
#pragma unroll
          for (int j = 0; j < 16; ++j) dst[64 * j] = pk4_fp8(v[j].x * SC_U, v[j].y * SC_U, v[j].z * SC_U, v[j].w * SC_U); }
    }
}

struct EpiProj {
    static constexpr bool PERM = true, AFTER_DRAIN = false;
    bf16_t* P; int coff; float sc;
    __device__ __forceinline__ void operator()(const f32x4 (&acc)[2][2][4][2], const Unit& u, int wr, int wc, int fr, int fq) const {
        const int row0 = u.pm * 256 + wr * 64 + fr, col0 = coff + u.pn * 256 + wc * 32 + 8 * fq;
#pragma unroll
        for (int ai = 0; ai < 2; ++ai)
#pragma unroll
            for (int m = 0; m < 4; ++m) { bf16_t* rowp = P + (size_t)(row0 + ai * 128 + m * 16) * PROJW + col0;
#pragma unroll
                for (int bj = 0; bj < 2; ++bj) { const f32x4 v0 = acc[ai][bj][m][0] * sc, v1 = acc[ai][bj][m][1] * sc;
                    uint4 o; o.x = cvt_pk_bf16(v0[0], v0[1]); o.y = cvt_pk_bf16(v0[2], v0[3]); o.z = cvt_pk_bf16(v1[0], v1[1]); o.w = cvt_pk_bf16(v1[2], v1[3]);
                    *(uint4*)(rowp + bj * 128) = o; } }
    }
};
struct EpiRes {
    static constexpr bool PERM = false, AFTER_DRAIN = false;
    float* C; const float* R; int ldc;
    __device__ __forceinline__ void operator()(const f32x4 (&acc)[2][2][4][2], const Unit& u, int wr, int wc, int fr, int fq) const {
        const int row0 = u.pm * 256 + wr * 64 + fr, col0 = u.pn * 256 + wc * 32 + 4 * fq;
#pragma unroll
        for (int ai = 0; ai < 2; ++ai)
#pragma unroll
            for (int m = 0; m < 4; ++m) { const size_t ro = (size_t)(row0 + ai * 128 + m * 16) * ldc + col0;
#pragma unroll
                for (int bj = 0; bj < 2; ++bj)
#pragma unroll
                    for (int n = 0; n < 2; ++n) { const f32x4 r = *(const f32x4*)(R + ro + bj * 128 + n * 16); *(f32x4*)(C + ro + bj * 128 + n * 16) = r + acc[ai][bj][m][n]; } }
    }
};
struct EpiF32 {
    static constexpr bool PERM = false, AFTER_DRAIN = false;
    float* C; int ldc;
    __device__ __forceinline__ void operator()(const f32x4 (&acc)[2][2][4][2], const Unit& u, int wr, int wc, int fr, int fq) const {
        const int row0 = u.pm * 256 + wr * 64 + fr, col0 = u.pn * 256 + wc * 32 + 4 * fq;
#pragma unroll
        for (int ai = 0; ai < 2; ++ai)
#pragma unroll
            for (int m = 0; m < 4; ++m) { float* rowp = C + (size_t)(row0 + ai * 128 + m * 16) * ldc + col0;
#pragma unroll
                for (int bj = 0; bj < 2; ++bj)
#pragma unroll
                    for (int n = 0; n < 2; ++n) *(f32x4*)(rowp + bj * 128 + n * 16) = acc[ai][bj][m][n]; }
    }
};
struct EpiResSc {
    static constexpr bool PERM = false, AFTER_DRAIN = false;
    float* C; const float* R; int ldc; float sc;
    __device__ __forceinline__ void operator()(const f32x4 (&acc)[2][2][4][2], const Unit& u, int wr, int wc, int fr, int fq) const {
        const int row0 = u.pm * 256 + wr * 64 + fr, col0 = u.pn * 256 + wc * 32 + 4 * fq;
#pragma unroll
        for (int ai = 0; ai < 2; ++ai)
#pragma unroll
            for (int m = 0; m < 4; ++m) { const size_t ro = (size_t)(row0 + ai * 128 + m * 16) * ldc + col0;
#pragma unroll
                for (int bj = 0; bj < 2; ++bj)
#pragma unroll
                    for (int n = 0; n < 2; ++n) { const f32x4 r = *(const f32x4*)(R + ro + bj * 128 + n * 16); *(f32x4*)(C + ro + bj * 128 + n * 16) = r + acc[ai][bj][m][n] * sc; } }
    }
};
constexpr float SC_G = 128.f;
struct EpiPeerW8 {
    static constexpr bool PERM = true, AFTER_DRAIN = false;
    const unsigned char* Gw; unsigned char* W8;
    __device__ __forceinline__ void operator()(const f32x4 (&acc)[2][2][4][2], const Unit& u, int wr, int wc, int fr, int fq) const {
        const int row0 = u.pm * 256 + wr * 64 + fr, col0 = u.pn * 256 + wc * 32 + 8 * fq; constexpr float isc = 1.f / (SC_X * SC_U), gsc = SC_W / SC_G;
#pragma unroll
        for (int ai = 0; ai < 2; ++ai)
#pragma unroll
            for (int m = 0; m < 4; ++m) { const size_t ro = (size_t)(row0 + ai * 128 + m * 16) * NEXP + col0;
#pragma unroll
                for (int bj = 0; bj < 2; ++bj) { const uint2 gv = *(const uint2*)(Gw + ro + bj * 128); uint2 o = make_uint2(0u, 0u);
                    if ((gv.x | gv.y) != 0u) {
                        const f32x4 v0 = acc[ai][bj][m][0] * isc, v1 = acc[ai][bj][m][1] * isc;
                        const f32x2 a = pg8::gelu_pk((f32x2){v0[0], v0[1]}), b = pg8::gelu_pk((f32x2){v0[2], v0[3]}), c = pg8::gelu_pk((f32x2){v1[0], v1[1]}), d = pg8::gelu_pk((f32x2){v1[2], v1[3]});
                        const int gx = (int)gv.x, gy = (int)gv.y;
                        o.x = pk4_fp8(a.x * __builtin_amdgcn_cvt_f32_fp8(gx, 0) * gsc, a.y * __builtin_amdgcn_cvt_f32_fp8(gx, 1) * gsc, b.x * __builtin_amdgcn_cvt_f32_fp8(gx, 2) * gsc, b.y * __builtin_amdgcn_cvt_f32_fp8(gx, 3) * gsc);
                        o.y = pk4_fp8(c.x * __builtin_amdgcn_cvt_f32_fp8(gy, 0) * gsc, c.y * __builtin_amdgcn_cvt_f32_fp8(gy, 1) * gsc, d.x * __builtin_amdgcn_cvt_f32_fp8(gy, 2) * gsc, d.y * __builtin_amdgcn_cvt_f32_fp8(gy, 3) * gsc); }
                    *(uint2*)(W8 + ro + bj * 128) = o; } }
    }
};

constexpr float QSCALE = 0.08838834764831845f * 1.4426950408889634f;
__device__ __forceinline__ void moba_prep_item(const Params& p, unsigned char* sm, int item) {
    const int tid = threadIdx.x, lane = tid & 63, w = tid >> 6;
    const int blk = item & 7, h = (item >> 3) & 15, b = item >> 7, bh = b * 16 + h;
    const bf16_t* proj = (const bf16_t*)(p.ws + WS_PROJ);
    bf16_t* QN = (bf16_t*)(p.ws + WS_QN); bf16_t* KN = (bf16_t*)(p.ws + WS_KN); bf16_t* VTM = (bf16_t*)(p.ws + WS_VTM); float* KM = (float*)(p.ws + WS_KM);
    bf16_t* VL = (bf16_t*)sm;
    float* KMS = (float*)(sm + 67584);
    const int d0 = 2 * lane;
    const float gq0 = p.qng[d0], gq1 = p.qng[d0 + 1], gk0 = p.kng[d0], gk1 = p.kng[d0 + 1];
    const int fi = d0 & 15;
    const float inv0 = exp2f(-(float)fi * (18.931568569324174f / 16.f)), inv1 = exp2f(-(float)(fi + 1) * (18.931568569324174f / 16.f));
    float km0 = 0.f, km1 = 0.f;
    __syncthreads();
    for (int t4 = 0; t4 < 32; t4 += 4) {
        unsigned qva[4], kva[4], vva[4];
#pragma unroll
        for (int u = 0; u < 4; ++u) { const int tt = w + 8 * (t4 + u); const bf16_t* pr = proj + ((size_t)b * SEQL + blk * 256 + tt) * PROJW;
            qva[u] = *(const unsigned*)(pr + 6144 + h * 128 + d0); kva[u] = *(const unsigned*)(pr + 8192 + h * 128 + d0); vva[u] = *(const unsigned*)(pr + 10240 + h * 128 + d0); }
#pragma unroll
        for (int u = 0; u < 4; ++u) { const int tt = w + 8 * (t4 + u); const int pos = blk * 256 + tt; const unsigned qv = qva[u], kv = kva[u], vv = vva[u];
        float q0 = bf2f(qv & 0xffff), q1 = bf2f(qv >> 16), k0 = bf2f(kv & 0xffff), k1 = bf2f(kv >> 16);
        const float rq = rsqrtf(wave_sum(q0 * q0 + q1 * q1) * (1.f / 128.f) + 1e-6f), rk = rsqrtf(wave_sum(k0 * k0 + k1 * k1) * (1.f / 128.f) + 1e-6f);
        q0 = (q0 * rq) * gq0; q1 = (q1 * rq) * gq1; k0 = (k0 * rk) * gk0; k1 = (k1 * rk) * gk1;
        const float pq0 = __shfl_xor(q0, 8), pq1 = __shfl_xor(q1, 8), pk0 = __shfl_xor(k0, 8), pk1 = __shfl_xor(k1, 8);
        if (lane < 16) {
            float a0 = (float)pos * inv0, a1 = (float)pos * inv1;
            float n0 = rintf(a0 * 0.15915494309189535f), n1 = rintf(a1 * 0.15915494309189535f);
            a0 = fmaf(-n0, 6.2831854820251465f, a0); a0 = fmaf(-n0, -1.7484555e-7f, a0);
            a1 = fmaf(-n1, 6.2831854820251465f, a1); a1 = fmaf(-n1, -1.7484555e-7f, a1);
            const float c0 = __cosf(a0), s0 = __sinf(a0), c1 = __cosf(a1), s1 = __sinf(a1);
            if (lane < 8) { q0 = q0 * c0 - pq0 * s0; q1 = q1 * c1 - pq1 * s1; k0 = k0 * c0 - pk0 * s0; k1 = k1 * c1 - pk1 * s1; }
            else          { q0 = q0 * c0 + pq0 * s0; q1 = q1 * c1 + pq1 * s1; k0 = k0 * c0 + pk0 * s0; k1 = k1 * c1 + pk1 * s1; }
        }
        km0 += k0; km1 += k1;
        const size_t o = ((size_t)bh * SEQL + pos) * 128 + d0;
        *(unsigned*)(QN + o) = cvt_pk_bf16(q0 * QSCALE, q1 * QSCALE);
        *(unsigned*)(KN + o) = cvt_pk_bf16(k0, k1);
        VL[d0 * 264 + tt] = (bf16_t)(vv & 0xffff); VL[(d0 + 1) * 264 + tt] = (bf16_t)(vv >> 16);
        } }
    KMS[w * 128 + d0] = km0; KMS[w * 128 + d0 + 1] = km1;
    __syncthreads();
    if (tid < 128) { float s = 0.f;
#pragma unroll
        for (int i = 0; i < 8; ++i) s += KMS[i * 128 + tid];
        KM[((size_t)bh * 8 + blk) * 128 + tid] = s * (1.f / 256.f); }
    for (int c = tid; c < 128 * 32; c += 512) { const int d = c >> 5, c8 = (c & 31) * 8;
        *(uint4*)(VTM + ((size_t)bh * 128 + d) * SEQL + blk * 256 + c8) = *(const uint4*)(VL + d * 264 + c8); }
}

__device__ __forceinline__ void glr_job(const Params& p, int job, int lane) {
    const int fr = lane & 15, fq = lane >> 4;
    const bf16_t* a = (const bf16_t*)(p.ws + WS_HB) + (size_t)(job * 16 + fr) * DM + fq * 8;
    const bf16_t* b = (const bf16_t*)(p.ws + WS_WINT) + (size_t)(12288 + fr) * DM + fq * 8;
    f32x4 acc0 = (f32x4){0.f, 0.f, 0.f, 0.f}, acc1 = acc0;
#pragma unroll 4
    for (int ks = 0; ks < 128; ks += 2) { const bf16x8 a0 = *(const bf16x8*)(a + ks * 32), b0 = *(const bf16x8*)(b + ks * 32), a1 = *(const bf16x8*)(a + ks * 32 + 32), b1 = *(const bf16x8*)(b + ks * 32 + 32);
        acc0 = MFMA16(a0, b0, acc0); acc1 = MFMA16(a1, b1, acc1); }
    float* glr = (float*)(p.ws + WS_GLR);
#pragma unroll
    for (int j = 0; j < 4; ++j) glr[(size_t)(job * 16 + fq * 4 + j) * 16 + fr] = acc0[j] + acc1[j];
}

constexpr size_t WS_GQD = WS_VTB + 64 * MiB, WS_GKI = WS_GQD + 16 * MiB, WS_GKST = WS_GKI + 16 * MiB, WS_GDEC = WS_GKST + 16 * MiB, WS_GVT = WS_HB8;
constexpr int GP_BC = 0, GP_GLR = 32768, GP_TOT = 36864, GP_KST = 38912, GP_VT = 57344;
__device__ __forceinline__ void gla_prep_item(const Params& p, unsigned char* sm, int item) {
    const int tid = threadIdx.x;
    const int h = item & 7, ch = item >> 3, t0 = ch * 64;
    float* BC = (float*)(sm + GP_BC); float* GLR = (float*)(sm + GP_GLR); float* TOT = (float*)(sm + GP_TOT); bf16_t* KST = (bf16_t*)(sm + GP_KST); bf16_t* VT = (bf16_t*)(sm + GP_VT);
    const bf16_t* proj = (const bf16_t*)(p.ws + WS_PROJ); const float* glr = (const float*)(p.ws + WS_GLR);
    bf16_t* QDg = (bf16_t*)(p.ws + WS_GQD) + (size_t)item * 8192; bf16_t* KIg = (bf16_t*)(p.ws + WS_GKI) + (size_t)item * 8192;
    bf16_t* KSTg = (bf16_t*)(p.ws + WS_GKST) + (size_t)item * 8192; bf16_t* VTg = (bf16_t*)(p.ws + WS_GVT) + (size_t)item * 16384; float* DECg = (float*)(p.ws + WS_GDEC) + (size_t)item * 128;
    __syncthreads();
    if (tid < 256) ((float4*)GLR)[tid] = ((const float4*)(glr + (size_t)t0 * 16))[tid];
    float wcol[16];
#pragma unroll
    for (int r = 0; r < 16; ++r) wcol[r] = p.wgu[r * 1024 + h * 128 + (tid & 127)];
    const float bias = p.bg[h * 128 + (tid & 127)];
    __syncthreads();
    {   const int d = tid & 127, part = tid >> 7; float la[16]; float run = 0.f;
#pragma unroll
        for (int i = 0; i < 16; ++i) { const float* gr = GLR + (part * 16 + i) * 16; float z = bias;
#pragma unroll
            for (int r = 0; r < 16; ++r) z = fmaf(gr[r], wcol[r], z);
            const float ls = fminf(z, 0.f) - __logf(1.f + __expf(-fabsf(z)));
            run += ls * (1.f / 16.f); la[i] = run; }
        TOT[part * 128 + d] = run;
        __syncthreads();
        float off = 0.f;
        for (int pp = 0; pp < part; ++pp) off += TOT[pp * 128 + d];
#pragma unroll
        for (int i = 0; i < 16; ++i) BC[(part * 16 + i) * 128 + d] = la[i] + off;
    }
    __syncthreads();
    if (tid < 128) DECg[tid] = __expf(BC[63 * 128 + tid]);
    for (int c = tid; c < 1024; c += 512) { const int s = c >> 4, dd = (c & 15) * 8;
        const bf16_t* pr = proj + (size_t)(t0 + s) * PROJW + h * 128 + dd;
        const uint4 qv = *(const uint4*)pr, kv = *(const uint4*)(pr + 1024);
        const unsigned qa[4] = {qv.x, qv.y, qv.z, qv.w}, ka[4] = {kv.x, kv.y, kv.z, kv.w};
        unsigned qo[4], ko[4];
#pragma unroll
        for (int i = 0; i < 4; ++i) {
            const float bc0 = BC[s * 128 + dd + 2 * i], bc1 = BC[s * 128 + dd + 2 * i + 1], bl0 = BC[63 * 128 + dd + 2 * i], bl1 = BC[63 * 128 + dd + 2 * i + 1];
            const float q0 = bf2f(qa[i] & 0xffff), q1 = bf2f(qa[i] >> 16), k0 = bf2f(ka[i] & 0xffff), k1 = bf2f(ka[i] >> 16);
            qo[i] = cvt_pk_bf16(q0 * 0.08838834764831845f * __expf(bc0), q1 * 0.08838834764831845f * __expf(bc1));
            ko[i] = cvt_pk_bf16(k0 * __expf(-bc0), k1 * __expf(-bc1));
            KST[(dd + 2 * i) * 72 + s] = f2bf(k0 * __expf(bl0 - bc0)); KST[(dd + 2 * i + 1) * 72 + s] = f2bf(k1 * __expf(bl1 - bc1)); }
        *(uint4*)(QDg + s * 128 + dd) = make_uint4(qo[0], qo[1], qo[2], qo[3]); *(uint4*)(KIg + s * 128 + dd) = make_uint4(ko[0], ko[1], ko[2], ko[3]); }
    for (int c = tid; c < 2048; c += 512) { const int s = c & 63, e0 = (c >> 6) * 8;
        const uint4 vv = *(const uint4*)(proj + (size_t)(t0 + s) * PROJW + 2048 + h * 256 + e0);
        const unsigned va[4] = {vv.x, vv.y, vv.z, vv.w};
#pragma unroll
        for (int i = 0; i < 4; ++i) { VT[(e0 + 2 * i) * 72 + s] = (bf16_t)(va[i] & 0xffff); VT[(e0 + 2 * i + 1) * 72 + s] = (bf16_t)(va[i] >> 16); } }
    __syncthreads();
    for (int c = tid; c < 1024; c += 512) { const int d = c >> 3, c8 = (c & 7) * 8; *(uint4*)(KSTg + d * 64 + c8) = *(const uint4*)(KST + d * 72 + c8); }
    for (int c = tid; c < 2048; c += 512) { const int e = c >> 3, c8 = (c & 7) * 8; *(uint4*)(VTg + e * 64 + c8) = *(const uint4*)(VT + e * 72 + c8); }
}
constexpr int GL_QD = 0, GL_KI = 17408, GL_KST = 34816, GL_VT = 53248, GL_ATT = 62464, GL_ST = 71680;
__device__ __forceinline__ void gla_item(const Params& p, unsigned char* sm, int item) {
    const int tid = threadIdx.x, lane = tid & 63, w = tid >> 6, fr = lane & 15, fq = lane >> 4;
    const int dvs = item & 3, h = (item >> 2) & 7, b = item >> 5;
    bf16_t* QD = (bf16_t*)(sm + GL_QD); bf16_t* KI = (bf16_t*)(sm + GL_KI); bf16_t* KST = (bf16_t*)(sm + GL_KST); bf16_t* VT = (bf16_t*)(sm + GL_VT);
    bf16_t* ATT = (bf16_t*)(sm + GL_ATT); bf16_t* ST = (bf16_t*)(sm + GL_ST);
    float* OG = (float*)(p.ws + WS_OG);
    const bf16_t* QDg = (const bf16_t*)(p.ws + WS_GQD); const bf16_t* KIg = (const bf16_t*)(p.ws + WS_GKI); const bf16_t* KSTg = (const bf16_t*)(p.ws + WS_GKST);
    const bf16_t* VTg = (const bf16_t*)(p.ws + WS_GVT); const float* DECg = (const float*)(p.ws + WS_GDEC);
    __syncthreads();
    for (int i = tid; i < 64 * 136 / 2; i += 512) ((unsigned*)ST)[i] = 0u;
    f32x4 Sacc[4];
#pragma unroll
    for (int i = 0; i < 4; ++i) Sacc[i] = (f32x4){0.f, 0.f, 0.f, 0.f};
    uint4 rq0, rq1, rk0, rk1, rs0, rs1, rv; float rd0, rd1, rd2, rd3;
#define GLA_FETCH(n_) do { const size_t it_ = (size_t)((b * 32 + (n_)) * 8 + h); \
        rq0 = *(const uint4*)(QDg + it_ * 8192 + tid * 8); rq1 = *(const uint4*)(QDg + it_ * 8192 + (tid + 512) * 8); \
        rk0 = *(const uint4*)(KIg + it_ * 8192 + tid * 8); rk1 = *(const uint4*)(KIg + it_ * 8192 + (tid + 512) * 8); \
        rs0 = *(const uint4*)(KSTg + it_ * 8192 + tid * 8); rs1 = *(const uint4*)(KSTg + it_ * 8192 + (tid + 512) * 8); \
        rv = *(const uint4*)(VTg + it_ * 16384 + (size_t)(dvs * 64) * 64 + tid * 8); \
        const float* dp_ = DECg + it_ * 128 + w * 16 + fq * 4; rd0 = dp_[0]; rd1 = dp_[1]; rd2 = dp_[2]; rd3 = dp_[3]; } while (0)
    GLA_FETCH(0);
    for (int n = 0; n < 32; ++n) {
        const int t0 = b * SEQL + n * 64;
        __syncthreads();
        { const int c0 = tid, c1 = tid + 512;
          *(uint4*)(QD + (c0 >> 4) * 136 + (c0 & 15) * 8) = rq0; *(uint4*)(QD + (c1 >> 4) * 136 + (c1 & 15) * 8) = rq1;
          *(uint4*)(KI + (c0 >> 4) * 136 + (c0 & 15) * 8) = rk0; *(uint4*)(KI + (c1 >> 4) * 136 + (c1 & 15) * 8) = rk1;
          *(uint4*)(KST + (c0 >> 3) * 72 + (c0 & 7) * 8) = rs0; *(uint4*)(KST + (c1 >> 3) * 72 + (c1 & 7) * 8) = rs1;
          *(uint4*)(VT + (tid >> 3) * 72 + (tid & 7) * 8) = rv; }
        const float dec[4] = {rd0, rd1, rd2, rd3};
        __syncthreads();
        if (n + 1 < 32) GLA_FETCH(n + 1);
        f32x4 oacc[2];
#pragma unroll
        for (int ti = 0; ti < 2; ++ti) { const int tile = 2 * w + ti, qt = tile >> 2, xt = tile & 3;
            f32x4 a = (f32x4){0.f, 0.f, 0.f, 0.f}, o = (f32x4){0.f, 0.f, 0.f, 0.f};
#pragma unroll
            for (int ks = 0; ks < 4; ++ks) { const bf16x8 af = *(const bf16x8*)(QD + (qt * 16 + fr) * 136 + ks * 32 + fq * 8);
                const bf16x8 bk = *(const bf16x8*)(KI + (xt * 16 + fr) * 136 + ks * 32 + fq * 8), bs = *(const bf16x8*)(ST + (xt * 16 + fr) * 136 + ks * 32 + fq * 8);
                a = MFMA16(af, bk, a); o = MFMA16(af, bs, o); }
#pragma unroll
            for (int j = 0; j < 4; ++j) { const int qq = qt * 16 + fq * 4 + j, ss = xt * 16 + fr; ATT[qq * 72 + ss] = f2bf(ss <= qq ? a[j] : 0.f); }
            oacc[ti] = o; }
        __syncthreads();
#pragma unroll
        for (int ti = 0; ti < 2; ++ti) { const int tile = 2 * w + ti, qt = tile >> 2, et = tile & 3; f32x4 o = oacc[ti];
#pragma unroll
            for (int ks = 0; ks < 2; ++ks) { const bf16x8 af = *(const bf16x8*)(ATT + (qt * 16 + fr) * 72 + ks * 32 + fq * 8), bv = *(const bf16x8*)(VT + (et * 16 + fr) * 72 + ks * 32 + fq * 8); o = MFMA16(af, bv, o); }
#pragma unroll
            for (int j = 0; j < 4; ++j) OG[(size_t)(t0 + qt * 16 + fq * 4 + j) * 2048 + h * 256 + dvs * 64 + et * 16 + fr] = o[j]; }
#pragma unroll
        for (int et = 0; et < 4; ++et) { f32x4 sv = Sacc[et];
#pragma unroll
            for (int j = 0; j < 4; ++j) sv[j] *= dec[j];
#pragma unroll
            for (int ks = 0; ks < 2; ++ks) { const bf16x8 af = *(const bf16x8*)(KST + (w * 16 + fr) * 72 + ks * 32 + fq * 8), bv = *(const bf16x8*)(VT + (et * 16 + fr) * 72 + ks * 32 + fq * 8); sv = MFMA16(af, bv, sv); }
            Sacc[et] = sv;
            uint2 pk; pk.x = cvt_pk_bf16(sv[0], sv[1]); pk.y = cvt_pk_bf16(sv[2], sv[3]);
            *(uint2*)(ST + (et * 16 + fr) * 136 + w * 16 + fq * 4) = pk; }
    }
}

constexpr int MB_KT = 0, MB_VT = 17408, MB_P = 35840, MB_MISC = 54272;
__device__ __forceinline__ void moba_item(const Params& p, unsigned char* sm, int item) {
    const int tid = threadIdx.x, lane = tid & 63, w = tid >> 6, fr = lane & 15, fq = lane >> 4;
    const int qt = 15 - (item >> 6), bh = item & 63, b = bh >> 4, h = bh & 15, q0 = qt * 128, blk = qt >> 1;
    const bf16_t* QNp = (const bf16_t*)(p.ws + WS_QN) + (size_t)bh * SEQL * 128; const bf16_t* KNp = (const bf16_t*)(p.ws + WS_KN) + (size_t)bh * SEQL * 128;
    const bf16_t* VTp = (const bf16_t*)(p.ws + WS_VTM) + (size_t)bh * 128 * SEQL; const float* KMp = (const float*)(p.ws + WS_KM) + (size_t)bh * 8 * 128;
    bf16_t* MIX = (bf16_t*)(p.ws + WS_MIX);
    bf16_t* KT = (bf16_t*)(sm + MB_KT); bf16_t* VT = (bf16_t*)(sm + MB_VT); bf16_t* Pw = (bf16_t*)(sm + MB_P) + w * 16 * 72; unsigned* bm = (unsigned*)(sm + MB_MISC);
    float* KMS = (float*)(sm + MB_MISC + 1024);
    __syncthreads();
    if (tid < blk * 32) ((float4*)KMS)[tid] = ((const float4*)KMp)[tid];
    if (tid == 0) *bm = 0u;
    __syncthreads();
    bf16x8 qf[4];
    { const bf16_t* qrow = QNp + (size_t)(q0 + w * 16 + fr) * 128;
#pragma unroll
      for (int ks = 0; ks < 4; ++ks) qf[ks] = *(const bf16x8*)(qrow + ks * 32 + fq * 8); }
    unsigned mask = 0u;
    { float g1 = -INFINITY, g2 = -INFINITY, g3 = -INFINITY; int i1 = -1, i2 = -1, i3 = -1;
      for (int n = 0; n < blk; ++n) { float part = 0.f;
#pragma unroll
          for (int ks = 0; ks < 4; ++ks) { const float* km = KMS + n * 128 + ks * 32 + fq * 8;
#pragma unroll
              for (int i = 0; i < 8; ++i) part = fmaf(bf2f((unsigned short)qf[ks][i]), km[i], part); }
          part += __shfl_xor(part, 16); part += __shfl_xor(part, 32);
          if (part > g1) { g3 = g2; i3 = i2; g2 = g1; i2 = i1; g1 = part; i1 = n; } else if (part > g2) { g3 = g2; i3 = i2; g2 = part; i2 = n; } else if (part > g3) { g3 = part; i3 = n; } }
      if (i1 >= 0) mask |= 1u << i1; if (i2 >= 0) mask |= 1u << i2; if (i3 >= 0) mask |= 1u << i3; }
    unsigned rm[4];
#pragma unroll
    for (int j = 0; j < 4; ++j) rm[j] = (unsigned)__shfl((int)mask, fq * 4 + j);
    { unsigned wm = mask;
#pragma unroll
      for (int o = 1; o < 16; o <<= 1) wm |= (unsigned)__shfl_xor((int)wm, o);
      if (lane == 0) atomicOr(bm, wm); }
    __syncthreads();
    const unsigned anym = *bm;
    f32x4 oacc[8];
#pragma unroll
    for (int i = 0; i < 8; ++i) oacc[i] = (f32x4){0.f, 0.f, 0.f, 0.f};
    float mrow[4] = {-1e30f, -1e30f, -1e30f, -1e30f}, lrow[4] = {0.f, 0.f, 0.f, 0.f};
    const int ntile = (q0 + 128) >> 6;
#define MB_NEXT(k_) do { while ((k_) < ntile && ((k_) >> 2) < blk && !((anym >> ((k_) >> 2)) & 1u)) ++(k_); } while (0)
    uint4 rka, rkb, rva, rvb;
#define MB_FETCH(k_) do { const int c0 = tid, c1 = tid + 512; \
        rka = *(const uint4*)(KNp + (size_t)((k_) * 64 + (c0 >> 4)) * 128 + (c0 & 15) * 8); rkb = *(const uint4*)(KNp + (size_t)((k_) * 64 + (c1 >> 4)) * 128 + (c1 & 15) * 8); \
        rva = *(const uint4*)(VTp + (size_t)(c0 >> 3) * SEQL + (k_) * 64 + (c0 & 7) * 8); rvb = *(const uint4*)(VTp + (size_t)(c1 >> 3) * SEQL + (k_) * 64 + (c1 & 7) * 8); } while (0)
    int kt = 0; MB_NEXT(kt);
    MB_FETCH(kt);
    while (kt < ntile) {
        const int kb = kt >> 2;
        __syncthreads();
        { const int c0 = tid, c1 = tid + 512, r0 = c0 >> 4, r1 = c1 >> 4;
          *(uint4*)(KT + ((r0 & 3) * 16 + (r0 >> 2)) * 136 + (c0 & 15) * 8) = rka; *(uint4*)(KT + ((r1 & 3) * 16 + (r1 >> 2)) * 136 + (c1 & 15) * 8) = rkb;
          *(uint4*)(VT + (c0 >> 3) * 72 + (c0 & 7) * 8) = rva; *(uint4*)(VT + (c1 >> 3) * 72 + (c1 & 7) * 8) = rvb; }
        __syncthreads();
        int nk = kt + 1; MB_NEXT(nk);
        if (nk < ntile) MB_FETCH(nk);
        f32x4 s[4];
#pragma unroll
        for (int g = 0; g < 4; ++g) s[g] = (f32x4){0.f, 0.f, 0.f, 0.f};
#pragma unroll
        for (int ks = 0; ks < 4; ++ks)
#pragma unroll
            for (int g = 0; g < 4; ++g) { const bf16x8 bk = *(const bf16x8*)(KT + (g * 16 + fr) * 136 + ks * 32 + fq * 8); s[g] = MFMA16(qf[ks], bk, s[g]); }
        float alpha[4]; bool resc = false;
#pragma unroll
        for (int j = 0; j < 4; ++j) { const int qpos = q0 + w * 16 + fq * 4 + j; const bool past = kb < blk; const bool rowok = past ? (((rm[j] >> kb) & 1u) != 0u) : true;
            float mx = -1e30f;
#pragma unroll
            for (int g = 0; g < 4; ++g) { const int kpos = kt * 64 + 4 * fr + g; const bool ok = rowok && (past || kpos <= qpos); const float sv = ok ? s[g][j] : -1e30f; s[g][j] = sv; mx = fmaxf(mx, sv); }
            mx = row16_max(mx);
            const float mnew = fmaxf(mrow[j], mx); alpha[j] = __builtin_amdgcn_exp2f(mrow[j] - mnew); resc = resc || (mnew != mrow[j]); mrow[j] = mnew;
            float rs = 0.f;
#pragma unroll
            for (int g = 0; g < 4; ++g) { const float pv = __builtin_amdgcn_exp2f(s[g][j] - mnew); s[g][j] = pv; rs += pv; }
            lrow[j] = lrow[j] * alpha[j] + rs;
            uint2 pk; pk.x = cvt_pk_bf16(s[0][j], s[1][j]); pk.y = cvt_pk_bf16(s[2][j], s[3][j]);
            *(uint2*)(Pw + (fq * 4 + j) * 72 + 4 * fr) = pk; }
        if (__ballot(resc)) {
#pragma unroll
            for (int j = 0; j < 4; ++j)
#pragma unroll
                for (int dt = 0; dt < 8; ++dt) oacc[dt][j] *= alpha[j]; }
        LDS_WAIT();
        bf16x8 pf[2];
#pragma unroll
        for (int ks = 0; ks < 2; ++ks) pf[ks] = *(const bf16x8*)(Pw + fr * 72 + ks * 32 + fq * 8);
#pragma unroll
        for (int dt = 0; dt < 8; ++dt)
#pragma unroll
            for (int ks = 0; ks < 2; ++ks) { const bf16x8 bv = *(const bf16x8*)(VT + (dt * 16 + fr) * 72 + ks * 32 + fq * 8); oacc[dt] = MFMA16(pf[ks], bv, oacc[dt]); }
        kt = nk;
    }
    float inv[4];
#pragma unroll
    for (int j = 0; j < 4; ++j) inv[j] = 1.f / row16_sum(lrow[j]);
#pragma unroll
    for (int dt = 0; dt < 8; ++dt)
#pragma unroll
        for (int j = 0; j < 4; ++j) MIX[(size_t)(b * SEQL + q0 + w * 16 + fq * 4 + j) * DM + 2048 + h * 128 + dt * 16 + fr] = f2bf(oacc[dt][j] * inv[j]);
}

__device__ __forceinline__ void gla_final(const Params& p) {
    const int tid = threadIdx.x, lane = tid & 63, w = tid >> 6;
    const float* OG = (const float*)(p.ws + WS_OG); const bf16_t* proj = (const bf16_t*)(p.ws + WS_PROJ); bf16_t* MIX = (bf16_t*)(p.ws + WS_MIX);
    const float4 gn = ((const float4*)p.glang)[lane];
    for (int it = blockIdx.x * 8 + w; it < NTOK * 8; it += gridDim.x * 8) { const int t = it >> 3, h = it & 7;
        const float4 o = ((const float4*)(OG + (size_t)t * 2048 + h * 256))[lane];
        const float r = rsqrtf(wave_sum((o.x * o.x + o.y * o.y) + (o.z * o.z + o.w * o.w)) * (1.f / 256.f) + 1e-6f);
        const uint2 gv = ((const uint2*)(proj + (size_t)t * PROJW + 4096 + h * 256))[lane];
        const float g0 = bf2f(gv.x & 0xffff), g1 = bf2f(gv.x >> 16), g2 = bf2f(gv.y & 0xffff), g3 = bf2f(gv.y >> 16);
        const float y0 = ((o.x * r) * gn.x) * (g0 / (1.f + __expf(-g0))), y1 = ((o.y * r) * gn.y) * (g1 / (1.f + __expf(-g1)));
        const float y2 = ((o.z * r) * gn.z) * (g2 / (1.f + __expf(-g2))), y3 = ((o.w * r) * gn.w) * (g3 / (1.f + __expf(-g3)));
        uint2 ov; ov.x = cvt_pk_bf16(y0, y1); ov.y = cvt_pk_bf16(y2, y3);
        ((uint2*)(MIX + (size_t)t * DM + h * 256))[lane] = ov; }
}

template <int N> __device__ __forceinline__ void bitonic_desc(unsigned (&x)[N]) {
#pragma unroll
    for (int k = 2; k <= N; k <<= 1)
#pragma unroll
        for (int j = k >> 1; j > 0; j >>= 1)
#pragma unroll
            for (int i = 0; i < N; ++i) { const int l = i ^ j;
                if (l > i) { const unsigned a = x[i], b = x[l], mx = a > b ? a : b, mn = a > b ? b : a;
                    if ((i & k) == 0) { x[i] = mx; x[l] = mn; } else { x[i] = mn; x[l] = mx; } } }
}
__device__ __forceinline__ void merge16(unsigned (&x)[16], int mask) {
    unsigned y[16];
#pragma unroll
    for (int i = 0; i < 16; ++i) y[i] = (unsigned)__shfl_xor((int)x[15 - i], mask);
#pragma unroll
    for (int i = 0; i < 16; ++i) x[i] = x[i] > y[i] ? x[i] : y[i];
    bitonic_desc<16>(x);
}
__device__ __forceinline__ unsigned mono(float f) { const unsigned u = __float_as_uint(f); return (u & 0x80000000u) ? ~u : (u | 0x80000000u); }
__device__ __forceinline__ float unmono(unsigned k) { return __uint_as_float((k & 0x80000000u) ? (k & 0x7fffffffu) : ~k); }
__device__ __forceinline__ void split_bf16(const float4 a, const float4 b, bf16x8& hi, bf16x8& lo) {
    const float x[8] = {a.x, a.y, a.z, a.w, b.x, b.y, b.z, b.w}; unsigned h[4], l[4];
#pragma unroll
    for (int i = 0; i < 4; ++i) { h[i] = cvt_pk_bf16(x[2 * i], x[2 * i + 1]); l[i] = cvt_pk_bf16(x[2 * i] - bf2f(h[i] & 0xffff), x[2 * i + 1] - bf2f(h[i] >> 16)); }
    hi = __builtin_bit_cast(bf16x8, make_uint4(h[0], h[1], h[2], h[3])); lo = __builtin_bit_cast(bf16x8, make_uint4(l[0], l[1], l[2], l[3]));
}
struct PairTab { int n; int i[64], j[64]; };
constexpr PairTab make_pairs() { PairTab t{}; t.n = 0; for (int a = 0; a < 16; ++a) for (int b = 0; b < 16; ++b) if ((a + 1) * (b + 1) <= 16) { t.i[t.n] = a; t.j[t.n] = b; ++t.n; } return t; }
__device__ __forceinline__ void peer_head(const Params& p, unsigned char* sm, int t0, int h, int lane, unsigned char* ibuf, int* LE, float* LG) {
    const int fr = lane & 15, fq = lane >> 4;
    const float* Q = (const float*)(p.ws + WS_Q); const bf16_t* KH = (const bf16_t*)(p.ws + WS_KH); const bf16_t* KL = (const bf16_t*)(p.ws + WS_KL);
    unsigned kk[2][16];
#pragma unroll
    for (int pp = 0; pp < 2; ++pp) {
        bf16x8 qh[4], ql[4];
        { const float* qr = Q + (size_t)(t0 + fr) * 2048 + h * 256 + pp * 128 + fq * 8;
#pragma unroll
          for (int ks = 0; ks < 4; ++ks) split_bf16(*(const float4*)(qr + ks * 32), *(const float4*)(qr + ks * 32 + 4), qh[ks], ql[ks]); }
        unsigned x[32];
#pragma unroll
        for (int n = 0; n < 8; ++n) { const size_t ko = ((size_t)(h * 2 + pp) * 128 + n * 16 + fr) * 128 + fq * 8; f32x4 acc = (f32x4){0.f, 0.f, 0.f, 0.f};
#pragma unroll
            for (int ks = 0; ks < 4; ++ks) { const bf16x8 kh = *(const bf16x8*)(KH + ko + ks * 32), kl = *(const bf16x8*)(KL + ko + ks * 32);
                acc = MFMA16(kh, qh[ks], acc); acc = MFMA16(kl, qh[ks], acc); acc = MFMA16(kh, ql[ks], acc); }
#pragma unroll
            for (int j = 0; j < 4; ++j) x[n * 4 + j] = (mono(acc[j]) & ~0x7Fu) | (unsigned)(n * 16 + fq * 4 + j); }
        bitonic_desc<32>(x);
#pragma unroll
        for (int i = 0; i < 16; ++i) kk[pp][i] = x[i];
        merge16(kk[pp], 16); merge16(kk[pp], 32);
    }
    constexpr PairTab PT = make_pairs();
    float v1[16], v2[16];
#pragma unroll
    for (int i = 0; i < 16; ++i) { v1[i] = unmono(kk[0][i] & ~0x7Fu); v2[i] = unmono(kk[1][i] & ~0x7Fu); }
    unsigned y[16];
#pragma unroll
    for (int c = 0; c < 16; ++c) { unsigned cand = 0u;
#pragma unroll
        for (int q = 0; q < 4; ++q) { const int idx = 4 * c + q;
            if (idx < PT.n) { const unsigned key = (mono(v1[PT.i[idx]] + v2[PT.j[idx]]) & ~0xFFu) | (unsigned)(PT.i[idx] * 16 + PT.j[idx]); cand = (fq == q) ? key : cand; } }
        y[c] = cand; }
    bitonic_desc<16>(y); merge16(y, 16); merge16(y, 32);
    if (fq == 0) {
#pragma unroll
        for (int c4 = 0; c4 < 4; ++c4) { unsigned w1 = 0u, w2 = 0u;
#pragma unroll
            for (int b = 0; b < 4; ++b) { w1 |= (kk[0][c4 * 4 + b] & 0x7Fu) << (8 * b); w2 |= (kk[1][c4 * 4 + b] & 0x7Fu) << (8 * b); }
            ((unsigned*)ibuf)[fr * 8 + c4] = w1; ((unsigned*)ibuf)[fr * 8 + 4 + c4] = w2; }
    }
    LDS_WAIT();
    if (fq == 0) { const float s0 = unmono(y[0] & ~0xFFu); float ex[16], sum = 0.f;
#pragma unroll
        for (int c = 0; c < 16; ++c) { ex[c] = __expf(unmono(y[c] & ~0xFFu) - s0); sum += ex[c]; }
        const float inv = 1.f / sum;
#pragma unroll
        for (int c = 0; c < 16; ++c) { const unsigned code = y[c] & 0xFFu; const int e = (int)ibuf[fr * 32 + (code >> 4)] * 128 + (int)ibuf[fr * 32 + 16 + (code & 15u)];
            LE[fr * 128 + h * 16 + c] = e; LG[fr * 128 + h * 16 + c] = ex[c] * inv; }
    }
}
constexpr int PE_IB = 0, PE_LE = 4096, PE_LG = 12288;
__device__ __forceinline__ void peer_item(const Params& p, unsigned char* sm, int item) {
    const int tid = threadIdx.x, lane = tid & 63, w = tid >> 6;
    const int t0 = item * 16;
    int* LE = (int*)(sm + PE_LE); float* LG = (float*)(sm + PE_LG); unsigned char* W = p.ws + WS_W;
    __syncthreads();
    { uint4* gz = (uint4*)(W + (size_t)t0 * NEXP) + tid; const uint4 z = make_uint4(0u, 0u, 0u, 0u);
#pragma unroll 8
      for (int i = 0; i < 32; ++i) gz[i * 512] = z; }
    peer_head(p, sm, t0, w, lane, sm + PE_IB + w * 512, LE, LG);
    asm volatile("s_waitcnt vmcnt(0)" ::: "memory");
    __syncthreads();
#pragma unroll
    for (int ti = 0; ti < 2; ++ti) { const int t = w * 2 + ti; const int* le = LE + t * 128; const float* lg = LG + t * 128;
        const int e0 = le[lane], e1 = le[lane + 64]; float g0 = 0.f, g1 = 0.f; bool f0 = true, f1 = true;
#pragma unroll 4
        for (int j4 = 0; j4 < 128; j4 += 4) { const int4 ev = *(const int4*)(le + j4); const float4 gv = *(const float4*)(lg + j4);
            const int ea[4] = {ev.x, ev.y, ev.z, ev.w}; const float ga[4] = {gv.x, gv.y, gv.z, gv.w};
#pragma unroll
            for (int q = 0; q < 4; ++q) { const int j = j4 + q;
                if (ea[q] == e0) { g0 += ga[q]; f0 = f0 && (j >= lane); }
                if (ea[q] == e1) { g1 += ga[q]; f1 = f1 && (j >= lane + 64); } } }
        unsigned char* wr = W + (size_t)(t0 + t) * NEXP;
        if (f0) wr[e0] = (unsigned char)(pk4_fp8(g0 * SC_G, 0.f, 0.f, 0.f) & 0xffu);
        if (f1) wr[e1] = (unsigned char)(pk4_fp8(g1 * SC_G, 0.f, 0.f, 0.f) & 0xffu); }
}

#define XB_TMO      128
#define XB_XCNT(j)  (256  + 64 * (j))
#define XB_XSUB(j)  (1280 + 64 * (j))
#define XB_XGEN(j)  (2304 + 64 * (j))
#define XB_TOP      3328
#define XB_TOPGEN   3392
#define XCD_BAR_WORDS 3456
#define XB_SPIN_CAP (1u << 18)
#define LAS __attribute__((address_space(3)))

__device__ __forceinline__ unsigned xb_ld(unsigned* p)              { return __hip_atomic_load(p, __ATOMIC_RELAXED, __HIP_MEMORY_SCOPE_AGENT); }
__device__ __forceinline__ unsigned xb_add(unsigned* p, unsigned v) { return __hip_atomic_fetch_add(p, v, __ATOMIC_RELAXED, __HIP_MEMORY_SCOPE_AGENT); }
__device__ __forceinline__ unsigned xb_xcc_id() { return (unsigned)__builtin_amdgcn_s_getreg((3 << 11) | 20) & 0xFu; }
#define XB_SPIN(cond, bar) do { unsigned _sp = 0; while (cond) { __builtin_amdgcn_s_sleep(1); \
    if ((++_sp & 255u) == 0u) { if (xb_ld(&(bar)[XB_TMO])) break; if (_sp > XB_SPIN_CAP) { atomicAdd(&(bar)[XB_TMO], 1u); break; } } } } while (0)

struct XcdBarrier {
    unsigned* bar; unsigned x;
    volatile LAS unsigned* st;
};

__device__ __forceinline__ XcdBarrier xcd_barrier_post(unsigned* bar, volatile LAS unsigned* st) {
    XcdBarrier b; b.bar = bar; b.x = xb_xcc_id(); b.st = st;
    if (threadIdx.x == 0) (void)xb_add(&bar[XB_XCNT(b.x)], 1u);
    return b;
}
__device__ __forceinline__ void xcd_barrier_complete(unsigned* bar, unsigned x, unsigned& nloc, unsigned& nx) {
    const unsigned G = gridDim.x * gridDim.y * gridDim.z;
    unsigned sum, cnt, mine, sp = 0u;
    for (;;) {
        sum = 0u; cnt = 0u; mine = 0u;
#pragma unroll
        for (unsigned j = 0; j < 16; ++j) { const unsigned c = xb_ld(&bar[XB_XCNT(j)]); sum += c; cnt += (c > 0u) ? 1u : 0u; mine = (j == x) ? c : mine; }
        if (sum == G) break;
        __builtin_amdgcn_s_sleep(1);
        if ((++sp & 255u) == 0u) { if (xb_ld(&bar[XB_TMO])) break; if (sp > XB_SPIN_CAP) { atomicAdd(&bar[XB_TMO], 1u); break; } }
    }
    nloc = mine > 0u ? mine : 1u; nx = cnt > 0u ? cnt : 1u;
}

__device__ __forceinline__ void xcd_barrier(const XcdBarrier& b) {
    asm volatile("s_waitcnt vmcnt(0)" ::: "memory");
    __syncthreads();
    if (threadIdx.x == 0) {
        unsigned* bar = b.bar;
        __builtin_amdgcn_s_waitcnt(0);
        unsigned nloc = b.st[0], nx = b.st[1];
        if (nloc == 0u) { xcd_barrier_complete(bar, b.x, nloc, nx); b.st[0] = nloc; b.st[1] = nx; }
        const unsigned old = xb_add(&bar[XB_XSUB(b.x)], 1u);
        const unsigned gen = old / nloc;
        if (old + 1u == (gen + 1u) * nloc) {
            __builtin_amdgcn_fence(__ATOMIC_RELEASE, "agent");
            asm volatile("s_waitcnt vmcnt(0)" ::: "memory");
            const unsigned og = xb_add(&bar[XB_TOP], 1u);
            const unsigned tg = og / nx;
            if (og + 1u == (tg + 1u) * nx) xb_add(&bar[XB_TOPGEN], 1u);
            else XB_SPIN(xb_ld(&bar[XB_TOPGEN]) == tg, bar);
            __builtin_amdgcn_fence(__ATOMIC_ACQUIRE, "agent");
            xb_add(&bar[XB_XGEN(b.x)], 1u);
            asm volatile("s_waitcnt vmcnt(0)" ::: "memory");
        } else {
            XB_SPIN(xb_ld(&bar[XB_XGEN(b.x)]) == gen, bar);
            __builtin_amdgcn_fence(__ATOMIC_ACQUIRE, "agent");
            asm volatile("s_waitcnt vmcnt(0)" ::: "memory");
        }
    }
    __syncthreads();
}

__global__ void __launch_bounds__(512, 2) hymba_fwd(Params p) {
    extern __shared__ __attribute__((aligned(16))) unsigned char smem[];
    cg::grid_group grid = cg::this_grid();
    volatile int& s_item = *(volatile int*)(smem + 131072);
    volatile LAS unsigned* bst = (volatile LAS unsigned*)(smem + 131072 + 8);
    if (threadIdx.x == 0) { bst[0] = 0u; bst[1] = 0u; }
    __syncthreads();
    XcdBarrier xb; xb.bar = (unsigned*)(p.ws + WS_CTRL); xb.x = 0u; xb.st = bst;
    const int tid = threadIdx.x, lane = tid & 63, w = tid >> 6;
    const int G = gridDim.x, c = blockIdx.x;
    unsigned* ctrl = (unsigned*)(p.ws + WS_CTRL) + 3584;
#define PH_ON(n) (p.ph_lo <= (n) && (n) < p.ph_hi)
#define PH_SYNC(n) if ((n) > p.ph_lo && (n) < p.ph_hi) { if ((n) == 1) { grid.sync(); xb = xcd_barrier_post((unsigned*)(p.ws + WS_CTRL), bst); } else xcd_barrier(xb); }
    if (PH_ON(0)) { if (c == 0) for (int i = tid; i < 4096; i += 512) ((unsigned*)(p.ws + WS_CTRL))[i] = 0u;
        phase_prep(p, smem); }
    PH_SYNC(1);
    if (PH_ON(1)) {
        { pg8::Gemm g{(const bf16_t*)(p.ws + WS_HB), (const bf16_t*)(p.ws + WS_WINT), NTOK, 6144, DM}; pg8::StaticOrder S; S.init(NTOK, 6144, G, c);
          EpiProj E{(bf16_t*)(p.ws + WS_PROJ), 0, 1.f}; pg8::gemm_phase<EpiProj, pg8::StaticOrder, false>((PG8_LAS unsigned char*)smem, g, S, E, nullptr); }
        { pg8::Gemm g{(const bf16_t*)(p.ws + WS_HB8), (const bf16_t*)(p.ws + WS_WINT8), NTOK, 6144, DM / 2}; pg8::StaticOrder S; S.init(NTOK, 6144, G, c);
          EpiProj E{(bf16_t*)(p.ws + WS_PROJ), 6144, 1.f / (SC_X * SC_U)}; pg8::gemm_phase<EpiProj, pg8::StaticOrder, false, true>((PG8_LAS unsigned char*)smem, g, S, E, nullptr); }
        for (int j = c * 8 + w; j < NTOK / 16; j += G * 8) glr_job(p, j, lane); }
    PH_SYNC(2);
    if (PH_ON(2)) { for (int it = c; it < 512; it += G) moba_prep_item(p, smem, it);
        for (int it = c; it < 1024; it += G) gla_prep_item(p, smem, it); }
    PH_SYNC(3);
    if (PH_ON(3)) for (;;) { __syncthreads(); if (tid == 0) s_item = (int)atomicAdd(ctrl, 1u); __syncthreads(); const int it = s_item; if (it >= 128 + 1024) break;
        if (it < 128) gla_item(p, smem, it); else moba_item(p, smem, it - 128); }
    PH_SYNC(4);
    if (PH_ON(4)) gla_final(p);
    PH_SYNC(5);
    if (PH_ON(5)) { pg8::Gemm g{(const bf16_t*)(p.ws + WS_MIX), (const bf16_t*)(p.ws + WS_WOUTT), NTOK, DM, DM}; pg8::StaticOrder S; S.init(NTOK, DM, G, c);
        EpiRes E{p.out, p.x, DM}; pg8::gemm_phase<EpiRes, pg8::StaticOrder, false>((PG8_LAS unsigned char*)smem, g, S, E, nullptr); }
    PH_SYNC(6);
    if (PH_ON(6)) { bf16_t* HB = (bf16_t*)(p.ws + WS_HB);
        for (int r = c * 8 + w; r < NTOK; r += G * 8) rms_row<true>(p.out + (size_t)r * DM, p.g2, HB + (size_t)r * DM, (unsigned*)(p.ws + WS_HB8) + (size_t)r * (DM / 4), lane);
        (void)0; }
    PH_SYNC(7);
    if (PH_ON(7)) { pg8::Gemm g{(const bf16_t*)(p.ws + WS_HB), (const bf16_t*)(p.ws + WS_WPQT), NTOK, 2048, DM}; pg8::StaticOrder S; S.init(NTOK, 2048, G, c);
        EpiF32 E{(float*)(p.ws + WS_Q), 2048}; pg8::gemm_phase<EpiF32, pg8::StaticOrder, false>((PG8_LAS unsigned char*)smem, g, S, E, nullptr); }
    PH_SYNC(8);
    if (PH_ON(8)) for (int it = c; it < NTOK / 16; it += G) peer_item(p, smem, it);
    PH_SYNC(9);
    if (PH_ON(9)) { pg8::Gemm g{(const bf16_t*)(p.ws + WS_HB8), (const bf16_t*)(p.ws + WS_UB), NTOK, NEXP, DM / 2}; pg8::StaticOrder S; S.init(NTOK, NEXP, G, c);
        EpiPeerW8 E{p.ws + WS_W, p.ws + WS_W8}; pg8::gemm_phase<EpiPeerW8, pg8::StaticOrder, false, true>((PG8_LAS unsigned char*)smem, g, S, E, nullptr); }
    PH_SYNC(10);
    if (PH_ON(10)) { pg8::Gemm g{(const bf16_t*)(p.ws + WS_W8), (const bf16_t*)(p.ws + WS_VTB), NTOK, DM, NEXP / 2}; pg8::StaticOrder S; S.init(NTOK, DM, G, c);
        EpiResSc E{p.out, p.out, DM, 1.f / (SC_W * SC_V)}; pg8::gemm_phase<EpiResSc, pg8::StaticOrder, false, true>((PG8_LAS unsigned char*)smem, g, S, E, nullptr); }
}

#ifndef MK_PER_PHASE
#define MK_PER_PHASE 0
#endif
extern "C" void kernel_launch(void* const* d_in, const int* in_sizes, int n_in, void* d_out, int out_size, void* d_ws, size_t ws_size, hipStream_t stream) {
    static int grid = 0;
    if (grid == 0) {
        if (n_in != 14 || out_size != NTOK * DM || ws_size < WS_END) { fprintf(stderr, "kernel_launch: unexpected shapes (n_in %d out %d ws %zu)\n", n_in, out_size, ws_size); grid = -1; return; }
        int dev = 0, cus = 0, per_cu = 0;
        hipGetDevice(&dev); hipDeviceGetAttribute(&cus, hipDeviceAttributeMultiprocessorCount, dev);
        if (hipFuncSetAttribute((const void*)hymba_fwd, hipFuncAttributeMaxDynamicSharedMemorySize, LDS_BYTES) != hipSuccess) { fprintf(stderr, "kernel_launch: hipFuncSetAttribute failed\n"); grid = -1; return; }
        if (hipOccupancyMaxActiveBlocksPerMultiprocessor(&per_cu, (const void*)hymba_fwd, 512, LDS_BYTES) != hipSuccess || per_cu < 1) { fprintf(stderr, "kernel_launch: occupancy query failed (%d)\n", per_cu); grid = -1; return; }
        grid = cus * (per_cu > 1 ? 1 : per_cu);
        fprintf(stderr, "kernel_launch: %d CUs, %d blocks/CU by query, grid %d\n", cus, per_cu, grid);
    }
    if (grid < 0) return;
    Params p{};
    p.x = (const float*)d_in[0]; p.g1 = (const float*)d_in[1]; p.win = (const float*)d_in[2]; p.wgu = (const float*)d_in[3]; p.bg = (const float*)d_in[4]; p.glang = (const float*)d_in[5];
    p.qng = (const float*)d_in[6]; p.kng = (const float*)d_in[7]; p.wout = (const float*)d_in[8]; p.g2 = (const float*)d_in[9]; p.wpq = (const float*)d_in[10]; p.pkeys = (const float*)d_in[11];
    p.pu = (const float*)d_in[12]; p.pv = (const float*)d_in[13]; p.out = (float*)d_out; p.ws = (unsigned char*)d_ws;
#if MK_PER_PHASE
    for (int ph = 0; ph < NPHASE; ++ph) { p.ph_lo = ph; p.ph_hi = ph + 1; void* args[] = {&p};
        hipError_t e = hipLaunchCooperativeKernel((const void*)hymba_fwd, dim3(grid), dim3(512), args, LDS_BYTES, stream);
        if (e != hipSuccess) { fprintf(stderr, "cooperative launch failed: %s\n", hipGetErrorString(e)); break; } }
#else
    p.ph_lo = 0; p.ph_hi = NPHASE; void* args[] = {&p};
    hipError_t e = hipLaunchCooperativeKernel((const void*)hymba_fwd, dim3(grid), dim3(512), args, LDS_BYTES, stream);
    if (e != hipSuccess) fprintf(stderr, "cooperative launch failed: %s (grid %d)\n", hipGetErrorString(e), grid);
#endif
}
```

```cpp
#include <hip/hip_runtime.h>
#include <hip/hip_cooperative_groups.h>
#include <cstdio>
#include <cstdint>
namespace cg = cooperative_groups;
namespace pg8 {
#define PG8_LAS __attribute__((address_space(3)))
typedef unsigned short bf16_t;
typedef short bf16x8 __attribute__((ext_vector_type(8)));
typedef float f32x4 __attribute__((ext_vector_type(4)));
typedef unsigned u32x4 __attribute__((ext_vector_type(4)));
constexpr int BM = 256, BK = 64, HALF = 128, HTB = HALF * BK * 2  , STAGE_BYTES = 8 * HTB, NXCD = 8, WGM = 8;

__host__ __device__ __forceinline__ int lds_byte(int r, int c) { const int st = (r >> 4) * 2 + (c >> 5), rr = r & 15, cc = c & 31, ob = rr * 64 + cc * 2; return st * 1024 + (ob ^ (((ob >> 9) & 1) << 5)); }
__host__ __device__ __forceinline__ void stage_rc(int b, int& R, int& C) { const int st = b / 1024, sb = b % 1024, swz = sb ^ (((sb >> 9) & 1) << 5); R = (st >> 1) * 16 + swz / 64; C = (st & 1) * 32 + (swz % 64) / 2; }
__host__ __device__ __forceinline__ int perm32(int rho) { const int n = rho >> 4, i = rho & 15; return 8 * (i >> 2) + 4 * n + (i & 3); }

struct Unit { int pm, pn; };
struct Gemm { const bf16_t* A; const bf16_t* Bt; int M, N, K; };

struct StaticOrder {
    int nM, nN, nwg, G, c;
    __host__ __device__ void init(int M, int N, int G_, int c_) { nM = M / BM; nN = N / BM; nwg = nM * nN; G = G_; c = c_; }
    __host__ __device__ bool next(int i, Unit& u) const {
        const long L = (long)i * G + c; if (L >= nwg) return false;
        int wgid = (int)L; { const int q = nwg / NXCD, r = nwg % NXCD, xcd = wgid % NXCD, off = wgid / NXCD; wgid = (xcd < r ? xcd * (q + 1) : r * (q + 1) + (xcd - r) * q) + off; }
        const int nig = WGM * nN, gid = wgid / nig, fm = gid * WGM, gsz = (nM - fm) < WGM ? (nM - fm) : WGM;
        u.pm = fm + ((wgid % nig) % gsz); u.pn = (wgid % nig) / gsz; return true;
    }
    __device__ __forceinline__ void a_ready(const Unit&) const {}
    __device__ __forceinline__ void done(const Unit&) const {}
};
typedef __bf16 bf16x2_t __attribute__((ext_vector_type(2)));
typedef float f32x2c_t __attribute__((ext_vector_type(2)));
__device__ __forceinline__ unsigned cvt_pk_bf16(float lo, float hi) { f32x2c_t v = {lo, hi}; bf16x2_t b = __builtin_convertvector(v, bf16x2_t); return __builtin_bit_cast(unsigned, b); }
typedef float f32x2 __attribute__((ext_vector_type(2)));
__device__ __forceinline__ f32x2 gelu_pk(f32x2 v) {
    const f32x2 av = __builtin_elementwise_abs(v), d = av * 0.2316418882f + 1.0f;
    f32x2 t; t.x = __builtin_amdgcn_rcpf(d.x); t.y = __builtin_amdgcn_rcpf(d.y);
    f32x2 q = t * 0.5307027145f + (-0.7265760135f); q = q * t + 0.7107068705f; q = q * t + (-0.142248368f); q = q * t + 0.127414796f; q = q * t;
    const f32x2 s = (v * v) * (-0.72134752044f);
    f32x2 e; e.x = __builtin_amdgcn_exp2f(s.x); e.y = __builtin_amdgcn_exp2f(s.y);
    const f32x2 m = v * (q * e), r = v - m;
    f32x2 o; o.x = v.x < 0.f ? m.x : r.x; o.y = v.y < 0.f ? m.y : r.y; return o;
}

typedef int i32x4 __attribute__((ext_vector_type(4)));
typedef int i32x8 __attribute__((ext_vector_type(8)));
__device__ __forceinline__ i32x8 cat16(const bf16x8 a, const bf16x8 b) { const i32x4 lo = __builtin_bit_cast(i32x4, a), hi = __builtin_bit_cast(i32x4, b); return __builtin_shufflevector(lo, hi, 0, 1, 2, 3, 4, 5, 6, 7); }
template <bool F8> __device__ __forceinline__ void mma_block(f32x4 (&accb)[4][2], const bf16x8 (&At)[4][2], const bf16x8 (&Bt)[2][2], const i32x8 (&At8)[4], const i32x8 (&Bt8)[2]) {
    if constexpr (F8) {
#pragma unroll
        for (int m = 0; m < 4; ++m)
#pragma unroll
            for (int n = 0; n < 2; ++n) asm volatile("v_mfma_f32_16x16x128_f8f6f4 %0, %1, %2, %0" : "+v"(accb[m][n]) : "v"(Bt8[n]), "v"(At8[m]));
    } else {
#pragma unroll
        for (int m = 0; m < 4; ++m)
#pragma unroll
            for (int n = 0; n < 2; ++n)
#pragma unroll
                for (int k = 0; k < 2; ++k) accb[m][n] = __builtin_amdgcn_mfma_f32_16x16x32_bf16(Bt[n][k], At[m][k], accb[m][n], 0, 0, 0);
    }
}
template <class Epi, class Sched, bool STAMP = false, bool F8 = false>
__device__ __forceinline__ void gemm_phase(PG8_LAS unsigned char* lds, const Gemm g, const Sched& S, const Epi& E, unsigned long long* stamps) {
    const int tid = threadIdx.x, wid = __builtin_amdgcn_readfirstlane(tid >> 6), lane = tid & 63, wr = wid >> 2, wc = wid & 3, fr = lane & 15, fq = lane >> 4;
    const int K = g.K, nt = K / BK;
    int ts_lo = 0, ts_hi = 0, nts = 0; const unsigned long long rt_entry = STAMP ? (unsigned long long)wall_clock64() : 0ull;
#define PG8_STAMP() do { if (STAMP && wid == 0 && nts < 64) { const unsigned long long _c = (unsigned long long)clock64(); \
        ts_lo = (lane == nts) ? (int)(unsigned)_c : ts_lo; ts_hi = (lane == nts) ? (int)(unsigned)(_c >> 32) : ts_hi; ++nts; } } while (0)
    PG8_STAMP();
    unsigned voffA[2], voffB[2];
#pragma unroll
    for (int i = 0; i < 2; ++i) { int R, C; stage_rc(tid * 16 + i * 8192, R, C); const int Rb = Epi::PERM ? ((R & ~31) + perm32(R & 31)) : R;
        voffA[i] = (unsigned)(R * K + C) * 2u; voffB[i] = (unsigned)(Rb * K + C) * 2u; }
    const size_t kstep = (size_t)(BK * 2);
    const size_t hstep = (size_t)HALF * K * 2;
    const size_t tstep = 2 * hstep;
    const unsigned ldsw = (unsigned)wid * 1024u;
    const int aoff = lds_byte(wr * 64 + fr, fq * 8), boff = lds_byte(wc * 32 + fr, fq * 8);
#define PG8_SA(b, h) (((b) * 2 + (h)) * HTB)
#define PG8_SB(b, h) ((4 + (b) * 2 + (h)) * HTB)
#define PG8_STAGE(bufoff, gbase, voff) do { _Pragma("unroll") for (int _i = 0; _i < 2; ++_i) \
        __builtin_amdgcn_global_load_lds((const unsigned*)((const char*)(gbase) + (voff)[_i]), (PG8_LAS unsigned*)(lds + (bufoff) + ldsw + _i * 8192), 16, 0, 0); } while (0)
#define PG8_LDA(dst, b, h) do { _Pragma("unroll") for (int m = 0; m < 4; ++m) { if constexpr (F8) dst##8[m] = cat16(*(const PG8_LAS bf16x8*)(lds + PG8_SA(b, h) + aoff + m * 2048), *(const PG8_LAS bf16x8*)(lds + PG8_SA(b, h) + aoff + m * 2048 + 1024)); else { _Pragma("unroll") for (int k = 0; k < 2; ++k) dst[m][k] = *(const PG8_LAS bf16x8*)(lds + PG8_SA(b, h) + aoff + m * 2048 + k * 1024); } } } while (0)
#define PG8_LDB(dst, b, h) do { _Pragma("unroll") for (int n = 0; n < 2; ++n) { if constexpr (F8) dst##8[n] = cat16(*(const PG8_LAS bf16x8*)(lds + PG8_SB(b, h) + boff + n * 2048), *(const PG8_LAS bf16x8*)(lds + PG8_SB(b, h) + boff + n * 2048 + 1024)); else { _Pragma("unroll") for (int k = 0; k < 2; ++k) dst[n][k] = *(const PG8_LAS bf16x8*)(lds + PG8_SB(b, h) + boff + n * 2048 + k * 1024); } } } while (0)
#define PG8_MMA(ai, bj, At, Bt) do { __builtin_amdgcn_s_setprio(1); mma_block<F8>(acc[ai][bj], At, Bt, At##8, Bt##8); __builtin_amdgcn_s_setprio(0); } while (0)
#define PG8_WAIT_V(n) asm volatile("s_waitcnt vmcnt(" #n ")" ::: "memory")
#define PG8_WAIT_L(n) asm volatile("s_waitcnt lgkmcnt(" #n ")" ::: "memory")
#define PG8_BAR __builtin_amdgcn_s_barrier()
#define PG8_SCHED __builtin_amdgcn_sched_barrier(0)
    Unit cur, nxt; int ui = 0;
    if (!S.next(0, cur)) return;
    f32x4 acc[2][2][4][2];
#pragma unroll
    for (int a = 0; a < 2; ++a)
#pragma unroll
        for (int b = 0; b < 2; ++b)
#pragma unroll
            for (int m = 0; m < 4; ++m)
#pragma unroll
                for (int n = 0; n < 2; ++n) acc[a][b][m][n] = (f32x4){0.f, 0.f, 0.f, 0.f};
    bf16x8 At[4][2], B0[2][2], B1[2][2]; i32x8 At8[4], B08[2], B18[2];
    const char* cA = (const char*)g.A + (size_t)cur.pm * tstep; const char* cB = (const char*)g.Bt + (size_t)cur.pn * tstep;
    S.a_ready(cur);
    PG8_STAGE(PG8_SB(0, 0), cB, voffB); PG8_STAGE(PG8_SA(0, 0), cA, voffA); PG8_STAGE(PG8_SB(0, 1), cB + hstep, voffB); PG8_STAGE(PG8_SA(0, 1), cA + hstep, voffA);
    if (wr == 1) PG8_BAR;
    PG8_WAIT_V(4); PG8_BAR;
    PG8_STAGE(PG8_SB(1, 0), cB + kstep, voffB); PG8_STAGE(PG8_SA(1, 0), cA + kstep, voffA); PG8_STAGE(PG8_SB(1, 1), cB + hstep + kstep, voffB);
    PG8_WAIT_V(6); PG8_BAR;
    PG8_STAMP();
    for (;;) {
        const bool has_next = S.next(ui + 1, nxt);
        const char* nA = has_next ? (const char*)g.A + (size_t)nxt.pm * tstep : cA; const char* nB = has_next ? (const char*)g.Bt + (size_t)nxt.pn * tstep : cB;
        for (int t = 0; t < nt; t += 2) {
            const bool last = (t == nt - 2);
            const char* a1 = cA + (size_t)(t + 1) * kstep;
            const char* a2 = last ? nA : cA + (size_t)(t + 2) * kstep; const char* b2 = last ? nB : cB + (size_t)(t + 2) * kstep;
            const char* a3 = a2 + kstep; const char* b3 = b2 + kstep;
            if (last && has_next) S.a_ready(nxt);
            PG8_LDB(B0, 0, 0); PG8_SCHED; PG8_LDA(At, 0, 0); PG8_STAGE(PG8_SA(1, 1), a1 + hstep, voffA);
            PG8_WAIT_L(8); PG8_BAR; PG8_WAIT_L(0); PG8_MMA(0, 0, At, B0); PG8_BAR; PG8_SCHED;
            PG8_LDB(B1, 0, 1); PG8_STAGE(PG8_SB(0, 0), b2, voffB);
            PG8_BAR; PG8_WAIT_L(0); PG8_MMA(0, 1, At, B1); PG8_BAR;
            PG8_LDA(At, 0, 1); PG8_STAGE(PG8_SA(0, 0), a2, voffA);
            PG8_BAR; PG8_WAIT_L(0); PG8_MMA(1, 0, At, B0); PG8_BAR; PG8_SCHED;
            PG8_STAGE(PG8_SB(0, 1), b2 + hstep, voffB);
            PG8_WAIT_V(6); PG8_BAR; PG8_MMA(1, 1, At, B1); PG8_BAR;
            PG8_LDB(B0, 1, 0); PG8_SCHED; PG8_LDA(At, 1, 0); PG8_STAGE(PG8_SA(0, 1), a2 + hstep, voffA);
            PG8_WAIT_L(8); PG8_BAR; PG8_WAIT_L(0); PG8_MMA(0, 0, At, B0); PG8_BAR; PG8_SCHED;
            PG8_LDB(B1, 1, 1); PG8_STAGE(PG8_SB(1, 0), b3, voffB);
            PG8_BAR; PG8_WAIT_L(0); PG8_MMA(0, 1, At, B1); PG8_BAR;
            PG8_LDA(At, 1, 1); PG8_STAGE(PG8_SA(1, 0), a3, voffA);
            PG8_BAR; PG8_WAIT_L(0); PG8_MMA(1, 0, At, B0); PG8_BAR; PG8_SCHED;
            PG8_STAGE(PG8_SB(1, 1), b3 + hstep, voffB);
            PG8_WAIT_V(6); PG8_BAR; PG8_MMA(1, 1, At, B1); PG8_BAR;
        }
        PG8_STAMP();
        if constexpr (!Epi::AFTER_DRAIN) { E(acc, cur, wr, wc, fr, fq); S.done(cur); }
        PG8_STAMP();
        if (!has_next) break;
#pragma unroll
        for (int a = 0; a < 2; ++a)
#pragma unroll
            for (int b = 0; b < 2; ++b)
#pragma unroll
                for (int m = 0; m < 4; ++m)
#pragma unroll
                    for (int n = 0; n < 2; ++n) acc[a][b][m][n] = (f32x4){0.f, 0.f, 0.f, 0.f};
        cur = nxt; cA = nA; cB = nB; ++ui;
    }
    PG8_WAIT_V(0);
    if (wr == 0) PG8_BAR;
    PG8_BAR;
    if constexpr (Epi::AFTER_DRAIN) { E.fused(acc, cur, wr, wc, fr, fq, lds, wid, lane); S.done(cur); }
    PG8_STAMP();
    if (STAMP && wid == 0) { stamps[lane] = lane < nts ? (((unsigned long long)(unsigned)ts_hi << 32) | (unsigned)ts_lo) : 0ull;
        if (lane == 62) stamps[62] = rt_entry; if (lane == 63) stamps[63] = (unsigned long long)wall_clock64(); }
#undef PG8_STAMP
#undef PG8_SA
#undef PG8_SB
#undef PG8_STAGE
#undef PG8_LDA
#undef PG8_LDB
#undef PG8_MMA
#undef PG8_WAIT_V
#undef PG8_WAIT_L
#undef PG8_BAR
#undef PG8_SCHED
}
}

using pg8::bf16_t; using pg8::bf16x8; using pg8::f32x4; using pg8::f32x2; using pg8::cvt_pk_bf16; using pg8::Unit;
typedef unsigned long long u64;

constexpr int NTOK = 8192, DM = 4096, SEQL = 2048;
constexpr int NIN = 12304, NINP = 12544, PROJW = 12288;
constexpr int NEXP = 16384;
constexpr size_t MiB = 1024ull * 1024ull;
constexpr size_t WS_CTRL = 0, WS_KM = 1 * MiB, WS_GLR = 2 * MiB, WS_WINT = 4 * MiB, WS_WOUTT = 102 * MiB, WS_WPQT = 134 * MiB, WS_UB = 150 * MiB, WS_VTB = 278 * MiB,
                 WS_HB = 406 * MiB, WS_MIX = 470 * MiB, WS_OG = 534 * MiB, WS_PROJ = 598 * MiB, WS_QN = 790 * MiB, WS_KN = 822 * MiB, WS_VTM = 854 * MiB, WS_HB8 = 886 * MiB, WS_END = 918 * MiB;
constexpr size_t WS_W = WS_PROJ;
constexpr size_t WS_W8 = WS_MIX;
constexpr size_t WS_WINT8 = WS_UB + 64 * MiB;
constexpr size_t WS_KH = 2 * MiB + 512 * 1024, WS_KL = 3 * MiB;
constexpr size_t WS_Q = WS_OG;
constexpr int LDS_BYTES = 131072 + 16;
constexpr int NPHASE = 11;

struct Params {
    const float *x, *g1, *win, *wgu, *bg, *glang, *qng, *kng, *wout, *g2, *wpq, *pkeys, *pu, *pv;
    float* out; unsigned char* ws; int ph_lo, ph_hi;
};

__device__ __forceinline__ float bf2f(unsigned short b) { return __uint_as_float(((unsigned)b) << 16); }
__device__ __forceinline__ unsigned short f2bf(float f) { unsigned u = __float_as_uint(f); u += 0x7FFFu + ((u >> 16) & 1u); return (unsigned short)(u >> 16); }
constexpr float SC_X = 16.f, SC_U = 1024.f, SC_W = 64.f, SC_V = 128.f;
__device__ __forceinline__ float clamp_f8(float x) { return __builtin_fminf(__builtin_fmaxf(x, -448.f), 448.f); }
__device__ __forceinline__ unsigned pk4_fp8(float a, float b, float c, float d) {
    int r = __builtin_amdgcn_cvt_pk_fp8_f32(clamp_f8(a), clamp_f8(b), 0, false); r = __builtin_amdgcn_cvt_pk_fp8_f32(clamp_f8(c), clamp_f8(d), r, true); return (unsigned)r; }
__device__ __forceinline__ float row16_max(float v) {
    v = fmaxf(v, __builtin_bit_cast(float, __builtin_amdgcn_update_dpp(0, __builtin_bit_cast(int, v), 0xB1, 0xF, 0xF, true)));
    v = fmaxf(v, __builtin_bit_cast(float, __builtin_amdgcn_update_dpp(0, __builtin_bit_cast(int, v), 0x4E, 0xF, 0xF, true)));
    v = fmaxf(v, __builtin_bit_cast(float, __builtin_amdgcn_update_dpp(0, __builtin_bit_cast(int, v), 0x141, 0xF, 0xF, true)));
    v = fmaxf(v, __builtin_bit_cast(float, __builtin_amdgcn_update_dpp(0, __builtin_bit_cast(int, v), 0x140, 0xF, 0xF, true)));
    return v;
}
__device__ __forceinline__ float row16_sum(float v) {
    v += __builtin_bit_cast(float, __builtin_amdgcn_update_dpp(0, __builtin_bit_cast(int, v), 0xB1, 0xF, 0xF, true));
    v += __builtin_bit_cast(float, __builtin_amdgcn_update_dpp(0, __builtin_bit_cast(int, v), 0x4E, 0xF, 0xF, true));
    v += __builtin_bit_cast(float, __builtin_amdgcn_update_dpp(0, __builtin_bit_cast(int, v), 0x141, 0xF, 0xF, true));
    v += __builtin_bit_cast(float, __builtin_amdgcn_update_dpp(0, __builtin_bit_cast(int, v), 0x140, 0xF, 0xF, true));
    return v;
}
__device__ __forceinline__ float wave_sum(float v) { v = row16_sum(v); v += __shfl_xor(v, 16); v += __shfl_xor(v, 32); return v; }
#define LDS_WAIT() asm volatile("s_waitcnt lgkmcnt(0)" ::: "memory")
#define MFMA16(a, b, c) __builtin_amdgcn_mfma_f32_16x16x32_bf16((a), (b), (c), 0, 0, 0)

__device__ __forceinline__ int win_remap(int n) { return n < 6144 ? n : (n < 6160 ? 12288 + (n - 6144) : n - 16); }
__device__ __forceinline__ void transpose_item(const float* W, int K, int N, int ld, bf16_t* WT, unsigned* T, int item, int lane, bool remap) {
    const int nblk = (N + 63) >> 6, kb = item / nblk, nb = item - kb * nblk, k0 = 64 * kb, n0 = 64 * nb;
    const int r4 = lane >> 4, cc = lane & 15, nn = n0 + 4 * cc; const bool ok = nn < N;
    float4 v[16];
#pragma unroll
    for (int jj = 0; jj < 8; ++jj)
#pragma unroll
        for (int bb = 0; bb < 2; ++bb) { const int kk = 8 * jj + 2 * r4 + bb; v[2 * jj + bb] = ok ? *(const float4*)(W + (size_t)(k0 + kk) * ld + nn) : make_float4(0.f, 0.f, 0.f, 0.f); }
#pragma unroll
    for (int jj = 0; jj < 8; ++jj) { const float4 a = v[2 * jj], bq = v[2 * jj + 1]; const int kw = 4 * jj + r4;
        T[(4 * cc + 0) * 33 + kw] = cvt_pk_bf16(a.x, bq.x); T[(4 * cc + 1) * 33 + kw] = cvt_pk_bf16(a.y, bq.y);
        T[(4 * cc + 2) * 33 + kw] = cvt_pk_bf16(a.z, bq.z); T[(4 * cc + 3) * 33 + kw] = cvt_pk_bf16(a.w, bq.w); }
    LDS_WAIT();
    const int kc = lane & 7;
#pragma unroll
    for (int jr = 0; jr < 8; ++jr) { const int n = (lane >> 3) + 8 * jr, ns = n0 + n; const unsigned* tp = T + n * 33 + 4 * kc;
        uint4 o; o.x = tp[0]; o.y = tp[1]; o.z = tp[2]; o.w = tp[3];
        if (ns < N) { const int nd = remap ? win_remap(ns) : ns; *(uint4*)(WT + (size_t)nd * K + k0 + 8 * kc) = o; } }
    LDS_WAIT();
}
__device__ __forceinline__ void transpose_item8(const float* W, int K, int N, int ld, unsigned char* WT, unsigned* T, int item, int lane, float sc) {
    const int nblk = (N + 63) >> 6, kb = item / nblk, nb = item - kb * nblk, k0 = 64 * kb, n0 = 64 * nb;
    const int r4 = lane >> 4, cc = lane & 15, nn = n0 + 4 * cc;
    float4 v[16];
#pragma unroll
    for (int jj = 0; jj < 4; ++jj)
#pragma unroll
        for (int bb = 0; bb < 4; ++bb) { const int kk = 16 * jj + 4 * r4 + bb; v[4 * jj + bb] = *(const float4*)(W + (size_t)(k0 + kk) * ld + nn); }
#pragma unroll
    for (int jj = 0; jj < 4; ++jj) { const float4 a = v[4 * jj], b = v[4 * jj + 1], c = v[4 * jj + 2], d = v[4 * jj + 3]; const int kw = 4 * jj + r4;
        T[(4 * cc + 0) * 17 + kw] = pk4_fp8(a.x * sc, b.x * sc, c.x * sc, d.x * sc); T[(4 * cc + 1) * 17 + kw] = pk4_fp8(a.y * sc, b.y * sc, c.y * sc, d.y * sc);
        T[(4 * cc + 2) * 17 + kw] = pk4_fp8(a.z * sc, b.z * sc, c.z * sc, d.z * sc); T[(4 * cc + 3) * 17 + kw] = pk4_fp8(a.w * sc, b.w * sc, c.w * sc, d.w * sc); }
    LDS_WAIT();
    const int kc = lane & 3;
#pragma unroll
    for (int jr = 0; jr < 4; ++jr) { const int n = (lane >> 2) + 16 * jr; const unsigned* tp = T + n * 17 + 4 * kc;
        uint4 o; o.x = tp[0]; o.y = tp[1]; o.z = tp[2]; o.w = tp[3];
        *(uint4*)(WT + (size_t)(n0 + n) * K + k0 + 16 * kc) = o; }
    LDS_WAIT();
}
template <bool F8OUT> __device__ __forceinline__ void rms_row(const float* xrow, const float* g, bf16_t* orow, unsigned* orow8, int lane) {
    const float4* xr = (const float4*)xrow + lane; float4 v[16]; float s = 0.f;
#pragma unroll
    for (int j = 0; j < 16; ++j) { v[j] = xr[64 * j]; s += (v[j].x * v[j].x + v[j].y * v[j].y) + (v[j].z * v[j].z + v[j].w * v[j].w); }
    const float r = rsqrtf(wave_sum(s) * (1.f / DM) + 1e-6f);
    const float4* gr = (const float4*)g + lane; uint2* o8 = (uint2*)orow + lane;
#pragma unroll
    for (int j = 0; j < 16; ++j) { const float4 gg = gr[64 * j]; const float y0 = (v[j].x * r) * gg.x, y1 = (v[j].y * r) * gg.y, y2 = (v[j].z * r) * gg.z, y3 = (v[j].w * r) * gg.w;
        uint2 o; o.x = cvt_pk_bf16(y0, y1); o.y = cvt_pk_bf16(y2, y3); o8[64 * j] = o;
        if (F8OUT) orow8[64 * j + lane] = pk4_fp8(y0 * SC_X, y1 * SC_X, y2 * SC_X, y3 * SC_X); }
}
__device__ __forceinline__ void phase_prep(const Params& p, unsigned char* sm) {
    const int tid = threadIdx.x, lane = tid & 63, w = tid >> 6;
    unsigned* scr = (unsigned*)(sm + w * 8704);
    const int gw = blockIdx.x * 8 + w, NGW = gridDim.x * 8;
    constexpr int I_WIN = 64 * 97, I_WIN8 = 64 * 96, I_WOUT = 64 * 64, I_WPQ = 64 * 32, I_PV = 256 * 64, I_PU = NEXP, I_X = NTOK;
    constexpr int NITEMS = I_WIN + I_WIN8 + I_WOUT + I_WPQ + I_PV + I_PU + I_X;
    bf16_t* WinT = (bf16_t*)(p.ws + WS_WINT); bf16_t* WoutT = (bf16_t*)(p.ws + WS_WOUTT); bf16_t* WpqT = (bf16_t*)(p.ws + WS_WPQT);
    unsigned* UB8 = (unsigned*)(p.ws + WS_UB); unsigned char* VTB8 = p.ws + WS_VTB; bf16_t* HB = (bf16_t*)(p.ws + WS_HB);
    { unsigned* KH = (unsigned*)(p.ws + WS_KH); unsigned* KL = (unsigned*)(p.ws + WS_KL);
      for (int i = blockIdx.x * 512 + tid; i < 8 * 2 * 128 * 128 / 2; i += gridDim.x * 512) { const float2 v = ((const float2*)p.pkeys)[i];
          const unsigned h = cvt_pk_bf16(v.x, v.y); KH[i] = h; KL[i] = cvt_pk_bf16(v.x - bf2f(h & 0xffff), v.y - bf2f(h >> 16)); } }
    for (int it = NITEMS - 1 - gw; it >= 0; it -= NGW) {
        int r = it;
        if (r < I_X) { rms_row<true>(p.x + (size_t)r * DM, p.g1, HB + (size_t)r * DM, (unsigned*)(p.ws + WS_HB8) + (size_t)r * (DM / 4), lane); continue; } r -= I_X;
        if (r < I_WIN) { transpose_item(p.win, DM, 6160, NIN, WinT, scr, r, lane, true); continue; } r -= I_WIN;
        if (r < I_WIN8) { transpose_item8(p.win + 6160, DM, 6144, NIN, p.ws + WS_WINT8, scr, r, lane, SC_U); continue; } r -= I_WIN8;
        if (r < I_WOUT) { transpose_item(p.wout, DM, DM, DM, WoutT, scr, r, lane, false); continue; } r -= I_WOUT;
        if (r < I_WPQ) { transpose_item(p.wpq, DM, 2048, 2048, WpqT, scr, r, lane, false); continue; } r -= I_WPQ;
        if (r < I_PV) { transpose_item8(p.pv, NEXP, DM, DM, VTB8, scr, r, lane, SC_V); continue; } r -= I_PV;
        { const float4* src = (const float4*)(p.pu + (size_t)r * DM) + lane; unsigned* dst = UB8 + (size_t)r * (DM / 4) + lane;
          float4 v[16];
#pragma unroll
          for (int j = 0; j < 16; ++j) v[j] = src[64 * j];
#pragma unroll
          for (int j = 0; j < 16; ++j) dst[64 * j] = pk4_fp8(v[j].x * SC_U, v[j].y * SC_U, v[j].z * SC_U, v[j].w * SC_U); }
    }
}

struct EpiProj {
    static constexpr bool PERM = true, AFTER_DRAIN = false;
    bf16_t* P; int coff; float sc;
    __device__ __forceinline__ void operator()(const f32x4 (&acc)[2][2][4][2], const Unit& u, int wr, int wc, int fr, int fq) const {
        const int row0 = u.pm * 256 + wr * 64 + fr, col0 = coff + u.pn * 256 + wc * 32 + 8 * fq;
#pragma unroll
        for (int ai = 0; ai < 2; ++ai)
#pragma unroll
            for (int m = 0; m < 4; ++m) { bf16_t* rowp = P + (size_t)(row0 + ai * 128 + m * 16) * PROJW + col0;
#pragma unroll
                for (int bj = 0; bj < 2; ++bj) { const f32x4 v0 = acc[ai][bj][m][0] * sc, v1 = acc[ai][bj][m][1] * sc;
                    uint4 o; o.x = cvt_pk_bf16(v0[0], v0[1]); o.y = cvt_pk_bf16(v0[2], v0[3]); o.z = cvt_pk_bf16(v1[0], v1[1]); o.w = cvt_pk_bf16(v1[2], v1[3]);
                    *(uint4*)(rowp + bj * 128) = o; } }
    }
};
struct EpiRes {
    static constexpr bool PERM = false, AFTER_DRAIN = false;
    float* C; const float* R; int ldc;
    __device__ __forceinline__ void operator()(const f32x4 (&acc)[2][2][4][2], const Unit& u, int wr, int wc, int fr, int fq) const {
        const int row0 = u.pm * 256 + wr * 64 + fr, col0 = u.pn * 256 + wc * 32 + 4 * fq;
#pragma unroll
        for (int ai = 0; ai < 2; ++ai)
#pragma unroll
            for (int m = 0; m < 4; ++m) { const size_t ro = (size_t)(row0 + ai * 128 + m * 16) * ldc + col0;
#pragma unroll
                for (int bj = 0; bj < 2; ++bj)
#pragma unroll
                    for (int n = 0; n < 2; ++n) { const f32x4 r = *(const f32x4*)(R + ro + bj * 128 + n * 16); *(f32x4*)(C + ro + bj * 128 + n * 16) = r + acc[ai][bj][m][n]; } }
    }
};
struct EpiF32 {
    static constexpr bool PERM = false, AFTER_DRAIN = false;
    float* C; int ldc;
    __device__ __forceinline__ void operator()(const f32x4 (&acc)[2][2][4][2], const Unit& u, int wr, int wc, int fr, int fq) const {
        const int row0 = u.pm * 256 + wr * 64 + fr, col0 = u.pn * 256 + wc * 32 + 4 * fq;
#pragma unroll
        for (int ai = 0; ai < 2; ++ai)
#pragma unroll
            for (int m = 0; m < 4; ++m) { float* rowp = C + (size_t)(row0 + ai * 128 + m * 16) * ldc + col0;
#pragma unroll
                for (int bj = 0; bj < 2; ++bj)
#pragma unroll
                    for (int n = 0; n < 2; ++n) *(f32x4*)(rowp + bj * 128 + n * 16) = acc[ai][bj][m][n]; }
    }
};
struct EpiResSc {
    static constexpr bool PERM = false, AFTER_DRAIN = false;
    float* C; const float* R; int ldc; float sc;
    __device__ __forceinline__ void operator()(const f32x4 (&acc)[2][2][4][2], const Unit& u, int wr, int wc, int fr, int fq) const {
        const int row0 = u.pm * 256 + wr * 64 + fr, col0 = u.pn * 256 + wc * 32 + 4 * fq;
#pragma unroll
        for (int ai = 0; ai < 2; ++ai)
#pragma unroll
            for (int m = 0; m < 4; ++m) { const size_t ro = (size_t)(row0 + ai * 128 + m * 16) * ldc + col0;
#pragma unroll
                for (int bj = 0; bj < 2; ++bj)
#pragma unroll
                    for (int n = 0; n < 2; ++n) { const f32x4 r = *(const f32x4*)(R + ro + bj * 128 + n * 16); *(f32x4*)(C + ro + bj * 128 + n * 16) = r + acc[ai][bj][m][n] * sc; } }
    }
};
constexpr float SC_G = 128.f;
struct EpiPeerW8 {
    static constexpr bool PERM = true, AFTER_DRAIN = false;
    const unsigned char* Gw; unsigned char* W8;
    __device__ __forceinline__ void operator()(const f32x4 (&acc)[2][2][4][2], const Unit& u, int wr, int wc, int fr, int fq) const {
        const int row0 = u.pm * 256 + wr * 64 + fr, col0 = u.pn * 256 + wc * 32 + 8 * fq; constexpr float isc = 1.f / (SC_X * SC_U), gsc = SC_W / SC_G;
#pragma unroll
        for (int ai = 0; ai < 2; ++ai)
#pragma unroll
            for (int m = 0; m < 4; ++m) { const size_t ro = (size_t)(row0 + ai * 128 + m * 16) * NEXP + col0;
#pragma unroll
                for (int bj = 0; bj < 2; ++bj) { const uint2 gv = *(const uint2*)(Gw + ro + bj * 128); uint2 o = make_uint2(0u, 0u);
                    if ((gv.x | gv.y) != 0u) {
                        const f32x4 v0 = acc[ai][bj][m][0] * isc, v1 = acc[ai][bj][m][1] * isc;
                        const f32x2 a = pg8::gelu_pk((f32x2){v0[0], v0[1]}), b = pg8::gelu_pk((f32x2){v0[2], v0[3]}), c = pg8::gelu_pk((f32x2){v1[0], v1[1]}), d = pg8::gelu_pk((f32x2){v1[2], v1[3]});
                        const int gx = (int)gv.x, gy = (int)gv.y;
                        o.x = pk4_fp8(a.x * __builtin_amdgcn_cvt_f32_fp8(gx, 0) * gsc, a.y * __builtin_amdgcn_cvt_f32_fp8(gx, 1) * gsc, b.x * __builtin_amdgcn_cvt_f32_fp8(gx, 2) * gsc, b.y * __builtin_amdgcn_cvt_f32_fp8(gx, 3) * gsc);
                        o.y = pk4_fp8(c.x * __builtin_amdgcn_cvt_f32_fp8(gy, 0) * gsc, c.y * __builtin_amdgcn_cvt_f32_fp8(gy, 1) * gsc, d.x * __builtin_amdgcn_cvt_f32_fp8(gy, 2) * gsc, d.y * __builtin_amdgcn_cvt_f32_fp8(gy, 3) * gsc); }
                    *(uint2*)(W8 + ro + bj * 128) = o; } }
    }
};

constexpr float QSCALE = 0.08838834764831845f * 1.4426950408889634f;
__device__ __forceinline__ void moba_prep_item(const Params& p, unsigned char* sm, int item) {
    const int tid = threadIdx.x, lane = tid & 63, w = tid >> 6;
    const int blk = item & 7, h = (item >> 3) & 15, b = item >> 7, bh = b * 16 + h;
    const bf16_t* proj = (const bf16_t*)(p.ws + WS_PROJ);
    bf16_t* QN = (bf16_t*)(p.ws + WS_QN); bf16_t* KN = (bf16_t*)(p.ws + WS_KN); bf16_t* VTM = (bf16_t*)(p.ws + WS_VTM); float* KM = (float*)(p.ws + WS_KM);
    bf16_t* VL = (bf16_t*)sm;
    float* KMS = (float*)(sm + 67584);
    const int d0 = 2 * lane;
    const float gq0 = p.qng[d0], gq1 = p.qng[d0 + 1], gk0 = p.kng[d0], gk1 = p.kng[d0 + 1];
    const int fi = d0 & 15;
    const float inv0 = exp2f(-(float)fi * (18.931568569324174f / 16.f)), inv1 = exp2f(-(float)(fi + 1) * (18.931568569324174f / 16.f));
    float km0 = 0.f, km1 = 0.f;
    __syncthreads();
    for (int t4 = 0; t4 < 32; t4 += 4) {
        unsigned qva[4], kva[4];
#pragma unroll
        for (int u = 0; u < 4; ++u) { const int tt = w + 8 * (t4 + u); const bf16_t* pr = proj + ((size_t)b * SEQL + blk * 256 + tt) * PROJW;
            qva[u] = *(const unsigned*)(pr + 6144 + h * 128 + d0); kva[u] = *(const unsigned*)(pr + 8192 + h * 128 + d0); }
#pragma unroll
        for (int u = 0; u < 4; ++u) { const int tt = w + 8 * (t4 + u); const int pos = blk * 256 + tt; const unsigned qv = qva[u], kv = kva[u];
        float q0 = bf2f(qv & 0xffff), q1 = bf2f(qv >> 16), k0 = bf2f(kv & 0xffff), k1 = bf2f(kv >> 16);
        const float rq = rsqrtf(wave_sum(q0 * q0 + q1 * q1) * (1.f / 128.f) + 1e-6f), rk = rsqrtf(wave_sum(k0 * k0 + k1 * k1) * (1.f / 128.f) + 1e-6f);
        q0 = (q0 * rq) * gq0; q1 = (q1 * rq) * gq1; k0 = (k0 * rk) * gk0; k1 = (k1 * rk) * gk1;
        const float pq0 = __shfl_xor(q0, 8), pq1 = __shfl_xor(q1, 8), pk0 = __shfl_xor(k0, 8), pk1 = __shfl_xor(k1, 8);
        if (lane < 16) {
            float a0 = (float)pos * inv0, a1 = (float)pos * inv1;
            float n0 = rintf(a0 * 0.15915494309189535f), n1 = rintf(a1 * 0.15915494309189535f);
            a0 = fmaf(-n0, 6.2831854820251465f, a0); a0 = fmaf(-n0, -1.7484555e-7f, a0);
            a1 = fmaf(-n1, 6.2831854820251465f, a1); a1 = fmaf(-n1, -1.7484555e-7f, a1);
            const float c0 = __cosf(a0), s0 = __sinf(a0), c1 = __cosf(a1), s1 = __sinf(a1);
            if (lane < 8) { q0 = q0 * c0 - pq0 * s0; q1 = q1 * c1 - pq1 * s1; k0 = k0 * c0 - pk0 * s0; k1 = k1 * c1 - pk1 * s1; }
            else          { q0 = q0 * c0 + pq0 * s0; q1 = q1 * c1 + pq1 * s1; k0 = k0 * c0 + pk0 * s0; k1 = k1 * c1 + pk1 * s1; }
        }
        km0 += k0; km1 += k1;
        const size_t o = ((size_t)bh * SEQL + pos) * 128 + d0;
        *(unsigned*)(QN + o) = cvt_pk_bf16(q0 * QSCALE, q1 * QSCALE);
        *(unsigned*)(KN + o) = cvt_pk_bf16(k0, k1);
        } }
    for (int c = tid; c < 4096; c += 512) { const int tt = c & 255, d8 = (c >> 8) * 8;
        const uint4 vv = *(const uint4*)(proj + ((size_t)b * SEQL + blk * 256 + tt) * PROJW + 10240 + h * 128 + d8);
        const unsigned va[4] = {vv.x, vv.y, vv.z, vv.w};
#pragma unroll
        for (int i = 0; i < 4; ++i) { VL[(d8 + 2 * i) * 264 + tt] = (bf16_t)(va[i] & 0xffff); VL[(d8 + 2 * i + 1) * 264 + tt] = (bf16_t)(va[i] >> 16); } }
    KMS[w * 128 + d0] = km0; KMS[w * 128 + d0 + 1] = km1;
    __syncthreads();
    if (tid < 128) { float s = 0.f;
#pragma unroll
        for (int i = 0; i < 8; ++i) s += KMS[i * 128 + tid];
        KM[((size_t)bh * 8 + blk) * 128 + tid] = s * (1.f / 256.f); }
    for (int c = tid; c < 128 * 32; c += 512) { const int d = c >> 5, c8 = (c & 31) * 8;
        *(uint4*)(VTM + ((size_t)bh * 128 + d) * SEQL + blk * 256 + c8) = *(const uint4*)(VL + d * 264 + c8); }
}

__device__ __forceinline__ void glr_job(const Params& p, int job, int lane) {
    const int fr = lane & 15, fq = lane >> 4;
    const bf16_t* a = (const bf16_t*)(p.ws + WS_HB) + (size_t)(job * 16 + fr) * DM + fq * 8;
    const bf16_t* b = (const bf16_t*)(p.ws + WS_WINT) + (size_t)(12288 + fr) * DM + fq * 8;
    f32x4 acc0 = (f32x4){0.f, 0.f, 0.f, 0.f}, acc1 = acc0;
#pragma unroll 4
    for (int ks = 0; ks < 128; ks += 2) { const bf16x8 a0 = *(const bf16x8*)(a + ks * 32), b0 = *(const bf16x8*)(b + ks * 32), a1 = *(const bf16x8*)(a + ks * 32 + 32), b1 = *(const bf16x8*)(b + ks * 32 + 32);
        acc0 = MFMA16(a0, b0, acc0); acc1 = MFMA16(a1, b1, acc1); }
    float* glr = (float*)(p.ws + WS_GLR);
#pragma unroll
    for (int j = 0; j < 4; ++j) glr[(size_t)(job * 16 + fq * 4 + j) * 16 + fr] = acc0[j] + acc1[j];
}

constexpr size_t WS_GQD = WS_VTB + 64 * MiB, WS_GKI = WS_GQD + 16 * MiB, WS_GKST = WS_GKI + 16 * MiB, WS_GDEC = WS_GKST + 16 * MiB, WS_GVT = WS_HB8;
constexpr int GP_BC = 0, GP_GLR = 32768, GP_TOT = 36864, GP_KST = 38912, GP_VT = 57344;
__device__ __forceinline__ void gla_prep_item(const Params& p, unsigned char* sm, int item) {
    const int tid = threadIdx.x;
    const int h = item & 7, ch = item >> 3, t0 = ch * 64;
    float* BC = (float*)(sm + GP_BC); float* GLR = (float*)(sm + GP_GLR); float* TOT = (float*)(sm + GP_TOT); bf16_t* KST = (bf16_t*)(sm + GP_KST); bf16_t* VT = (bf16_t*)(sm + GP_VT);
    const bf16_t* proj = (const bf16_t*)(p.ws + WS_PROJ); const float* glr = (const float*)(p.ws + WS_GLR);
    bf16_t* QDg = (bf16_t*)(p.ws + WS_GQD) + (size_t)item * 8192; bf16_t* KIg = (bf16_t*)(p.ws + WS_GKI) + (size_t)item * 8192;
    bf16_t* KSTg = (bf16_t*)(p.ws + WS_GKST) + (size_t)item * 8192; bf16_t* VTg = (bf16_t*)(p.ws + WS_GVT) + (size_t)item * 16384; float* DECg = (float*)(p.ws + WS_GDEC) + (size_t)item * 128;
    __syncthreads();
    if (tid < 256) ((float4*)GLR)[tid] = ((const float4*)(glr + (size_t)t0 * 16))[tid];
    float wcol[16];
#pragma unroll
    for (int r = 0; r < 16; ++r) wcol[r] = p.wgu[r * 1024 + h * 128 + (tid & 127)];
    const float bias = p.bg[h * 128 + (tid & 127)];
    __syncthreads();
    {   const int d = tid & 127, part = tid >> 7; float la[16]; float run = 0.f;
#pragma unroll
        for (int i = 0; i < 16; ++i) { const float* gr = GLR + (part * 16 + i) * 16; float z = bias;
#pragma unroll
            for (int r = 0; r < 16; ++r) z = fmaf(gr[r], wcol[r], z);
            const float ls = fminf(z, 0.f) - __logf(1.f + __expf(-fabsf(z)));
            run += ls * (1.f / 16.f); la[i] = run; }
        TOT[part * 128 + d] = run;
        __syncthreads();
        float off = 0.f;
        for (int pp = 0; pp < part; ++pp) off += TOT[pp * 128 + d];
#pragma unroll
        for (int i = 0; i < 16; ++i) BC[(part * 16 + i) * 128 + d] = la[i] + off;
    }
    __syncthreads();
    if (tid < 128) DECg[tid] = __expf(BC[63 * 128 + tid]);
    for (int c = tid; c < 1024; c += 512) { const int s = c >> 4, dd = (c & 15) * 8;
        const bf16_t* pr = proj + (size_t)(t0 + s) * PROJW + h * 128 + dd;
        const uint4 qv = *(const uint4*)pr, kv = *(const uint4*)(pr + 1024);
        const unsigned qa[4] = {qv.x, qv.y, qv.z, qv.w}, ka[4] = {kv.x, kv.y, kv.z, kv.w};
        unsigned qo[4], ko[4];
#pragma unroll
        for (int i = 0; i < 4; ++i) {
            const float bc0 = BC[s * 128 + dd + 2 * i], bc1 = BC[s * 128 + dd + 2 * i + 1], bl0 = BC[63 * 128 + dd + 2 * i], bl1 = BC[63 * 128 + dd + 2 * i + 1];
            const float q0 = bf2f(qa[i] & 0xffff), q1 = bf2f(qa[i] >> 16), k0 = bf2f(ka[i] & 0xffff), k1 = bf2f(ka[i] >> 16);
            qo[i] = cvt_pk_bf16(q0 * 0.08838834764831845f * __expf(bc0), q1 * 0.08838834764831845f * __expf(bc1));
            ko[i] = cvt_pk_bf16(k0 * __expf(-bc0), k1 * __expf(-bc1));
            KST[(dd + 2 * i) * 72 + s] = f2bf(k0 * __expf(bl0 - bc0)); KST[(dd + 2 * i + 1) * 72 + s] = f2bf(k1 * __expf(bl1 - bc1)); }
        *(uint4*)(QDg + s * 128 + dd) = make_uint4(qo[0], qo[1], qo[2], qo[3]); *(uint4*)(KIg + s * 128 + dd) = make_uint4(ko[0], ko[1], ko[2], ko[3]); }
    for (int c = tid; c < 2048; c += 512) { const int s = c & 63, e0 = (c >> 6) * 8;
        const uint4 vv = *(const uint4*)(proj + (size_t)(t0 + s) * PROJW + 2048 + h * 256 + e0);
        const unsigned va[4] = {vv.x, vv.y, vv.z, vv.w};
#pragma unroll
        for (int i = 0; i < 4; ++i) { VT[(e0 + 2 * i) * 72 + s] = (bf16_t)(va[i] & 0xffff); VT[(e0 + 2 * i + 1) * 72 + s] = (bf16_t)(va[i] >> 16); } }
    __syncthreads();
    for (int c = tid; c < 1024; c += 512) { const int d = c >> 3, c8 = (c & 7) * 8; *(uint4*)(KSTg + d * 64 + c8) = *(const uint4*)(KST + d * 72 + c8); }
    for (int c = tid; c < 2048; c += 512) { const int e = c >> 3, c8 = (c & 7) * 8; *(uint4*)(VTg + e * 64 + c8) = *(const uint4*)(VT + e * 72 + c8); }
}
constexpr int GL_QD = 0, GL_KI = 17408, GL_KST = 34816, GL_VT = 53248, GL_ATT = 62464, GL_ST = 71680;
__device__ __forceinline__ void gla_item(const Params& p, unsigned char* sm, int item) {
    const int tid = threadIdx.x, lane = tid & 63, w = tid >> 6, fr = lane & 15, fq = lane >> 4;
    const int dvs = item & 3, h = (item >> 2) & 7, b = item >> 5;
    bf16_t* QD = (bf16_t*)(sm + GL_QD); bf16_t* KI = (bf16_t*)(sm + GL_KI); bf16_t* KST = (bf16_t*)(sm + GL_KST); bf16_t* VT = (bf16_t*)(sm + GL_VT);
    bf16_t* ATT = (bf16_t*)(sm + GL_ATT); bf16_t* ST = (bf16_t*)(sm + GL_ST);
    float* OG = (float*)(p.ws + WS_OG);
    const bf16_t* QDg = (const bf16_t*)(p.ws + WS_GQD); const bf16_t* KIg = (const bf16_t*)(p.ws + WS_GKI); const bf16_t* KSTg = (const bf16_t*)(p.ws + WS_GKST);
    const bf16_t* VTg = (const bf16_t*)(p.ws + WS_GVT); const float* DECg = (const float*)(p.ws + WS_GDEC);
    __syncthreads();
    for (int i = tid; i < 64 * 136 / 2; i += 512) ((unsigned*)ST)[i] = 0u;
    f32x4 Sacc[4];
#pragma unroll
    for (int i = 0; i < 4; ++i) Sacc[i] = (f32x4){0.f, 0.f, 0.f, 0.f};
    uint4 rq0, rq1, rk0, rk1, rs0, rs1, rv; float rd0, rd1, rd2, rd3;
#define GLA_FETCH(n_) do { const size_t it_ = (size_t)((b * 32 + (n_)) * 8 + h); \
        rq0 = *(const uint4*)(QDg + it_ * 8192 + tid * 8); rq1 = *(const uint4*)(QDg + it_ * 8192 + (tid + 512) * 8); \
        rk0 = *(const uint4*)(KIg + it_ * 8192 + tid * 8); rk1 = *(const uint4*)(KIg + it_ * 8192 + (tid + 512) * 8); \
        rs0 = *(const uint4*)(KSTg + it_ * 8192 + tid * 8); rs1 = *(const uint4*)(KSTg + it_ * 8192 + (tid + 512) * 8); \
        rv = *(const uint4*)(VTg + it_ * 16384 + (size_t)(dvs * 64) * 64 + tid * 8); \
        const float* dp_ = DECg + it_ * 128 + w * 16 + fq * 4; rd0 = dp_[0]; rd1 = dp_[1]; rd2 = dp_[2]; rd3 = dp_[3]; } while (0)
    GLA_FETCH(0);
    for (int n = 0; n < 32; ++n) {
        const int t0 = b * SEQL + n * 64;
        __syncthreads();
        { const int c0 = tid, c1 = tid + 512;
          *(uint4*)(QD + (c0 >> 4) * 136 + (c0 & 15) * 8) = rq0; *(uint4*)(QD + (c1 >> 4) * 136 + (c1 & 15) * 8) = rq1;
          *(uint4*)(KI + (c0 >> 4) * 136 + (c0 & 15) * 8) = rk0; *(uint4*)(KI + (c1 >> 4) * 136 + (c1 & 15) * 8) = rk1;
          *(uint4*)(KST + (c0 >> 3) * 72 + (c0 & 7) * 8) = rs0; *(uint4*)(KST + (c1 >> 3) * 72 + (c1 & 7) * 8) = rs1;
          *(uint4*)(VT + (tid >> 3) * 72 + (tid & 7) * 8) = rv; }
        const float dec[4] = {rd0, rd1, rd2, rd3};
        __syncthreads();
        if (n + 1 < 32) GLA_FETCH(n + 1);
        f32x4 oacc[2];
#pragma unroll
        for (int ti = 0; ti < 2; ++ti) { const int tile = 2 * w + ti, qt = tile >> 2, xt = tile & 3;
            f32x4 a = (f32x4){0.f, 0.f, 0.f, 0.f}, o = (f32x4){0.f, 0.f, 0.f, 0.f};
#pragma unroll
            for (int ks = 0; ks < 4; ++ks) { const bf16x8 af = *(const bf16x8*)(QD + (qt * 16 + fr) * 136 + ks * 32 + fq * 8);
                const bf16x8 bk = *(const bf16x8*)(KI + (xt * 16 + fr) * 136 + ks * 32 + fq * 8), bs = *(const bf16x8*)(ST + (xt * 16 + fr) * 136 + ks * 32 + fq * 8);
                a = MFMA16(af, bk, a); o = MFMA16(af, bs, o); }
#pragma unroll
            for (int j = 0; j < 4; ++j) { const int qq = qt * 16 + fq * 4 + j, ss = xt * 16 + fr; ATT[qq * 72 + ss] = f2bf(ss <= qq ? a[j] : 0.f); }
            oacc[ti] = o; }
        __syncthreads();
#pragma unroll
        for (int ti = 0; ti < 2; ++ti) { const int tile = 2 * w + ti, qt = tile >> 2, et = tile & 3; f32x4 o = oacc[ti];
#pragma unroll
            for (int ks = 0; ks < 2; ++ks) { const bf16x8 af = *(const bf16x8*)(ATT + (qt * 16 + fr) * 72 + ks * 32 + fq * 8), bv = *(const bf16x8*)(VT + (et * 16 + fr) * 72 + ks * 32 + fq * 8); o = MFMA16(af, bv, o); }
#pragma unroll
            for (int j = 0; j < 4; ++j) OG[(size_t)(t0 + qt * 16 + fq * 4 + j) * 2048 + h * 256 + dvs * 64 + et * 16 + fr] = o[j]; }
#pragma unroll
        for (int et = 0; et < 4; ++et) { f32x4 sv = Sacc[et];
#pragma unroll
            for (int j = 0; j < 4; ++j) sv[j] *= dec[j];
#pragma unroll
            for (int ks = 0; ks < 2; ++ks) { const bf16x8 af = *(const bf16x8*)(KST + (w * 16 + fr) * 72 + ks * 32 + fq * 8), bv = *(const bf16x8*)(VT + (et * 16 + fr) * 72 + ks * 32 + fq * 8); sv = MFMA16(af, bv, sv); }
            Sacc[et] = sv;
            uint2 pk; pk.x = cvt_pk_bf16(sv[0], sv[1]); pk.y = cvt_pk_bf16(sv[2], sv[3]);
            *(uint2*)(ST + (et * 16 + fr) * 136 + w * 16 + fq * 4) = pk; }
    }
}

constexpr int MB_KT = 0, MB_VT = 17408, MB_P = 35840, MB_MISC = 54272;
__device__ __forceinline__ void moba_item(const Params& p, unsigned char* sm, int item) {
    const int tid = threadIdx.x, lane = tid & 63, w = tid >> 6, fr = lane & 15, fq = lane >> 4;
    const int qt = 15 - (item >> 6), bh = item & 63, b = bh >> 4, h = bh & 15, q0 = qt * 128, blk = qt >> 1;
    const bf16_t* QNp = (const bf16_t*)(p.ws + WS_QN) + (size_t)bh * SEQL * 128; const bf16_t* KNp = (const bf16_t*)(p.ws + WS_KN) + (size_t)bh * SEQL * 128;
    const bf16_t* VTp = (const bf16_t*)(p.ws + WS_VTM) + (size_t)bh * 128 * SEQL; const float* KMp = (const float*)(p.ws + WS_KM) + (size_t)bh * 8 * 128;
    bf16_t* MIX = (bf16_t*)(p.ws + WS_MIX);
    bf16_t* KT = (bf16_t*)(sm + MB_KT); bf16_t* VT = (bf16_t*)(sm + MB_VT); bf16_t* Pw = (bf16_t*)(sm + MB_P) + w * 16 * 72; unsigned* bm = (unsigned*)(sm + MB_MISC);
    float* KMS = (float*)(sm + MB_MISC + 1024);
    __syncthreads();
    if (tid < blk * 32) ((float4*)KMS)[tid] = ((const float4*)KMp)[tid];
    if (tid == 0) *bm = 0u;
    __syncthreads();
    bf16x8 qf[4];
    { const bf16_t* qrow = QNp + (size_t)(q0 + w * 16 + fr) * 128;
#pragma unroll
      for (int ks = 0; ks < 4; ++ks) qf[ks] = *(const bf16x8*)(qrow + ks * 32 + fq * 8); }
    unsigned mask = 0u;
    { float g1 = -INFINITY, g2 = -INFINITY, g3 = -INFINITY; int i1 = -1, i2 = -1, i3 = -1;
      for (int n = 0; n < blk; ++n) { float part = 0.f;
#pragma unroll
          for (int ks = 0; ks < 4; ++ks) { const float* km = KMS + n * 128 + ks * 32 + fq * 8;
#pragma unroll
              for (int i = 0; i < 8; ++i) part = fmaf(bf2f((unsigned short)qf[ks][i]), km[i], part); }
          part += __shfl_xor(part, 16); part += __shfl_xor(part, 32);
          if (part > g1) { g3 = g2; i3 = i2; g2 = g1; i2 = i1; g1 = part; i1 = n; } else if (part > g2) { g3 = g2; i3 = i2; g2 = part; i2 = n; } else if (part > g3) { g3 = part; i3 = n; } }
      if (i1 >= 0) mask |= 1u << i1; if (i2 >= 0) mask |= 1u << i2; if (i3 >= 0) mask |= 1u << i3; }
    unsigned rm[4];
#pragma unroll
    for (int j = 0; j < 4; ++j) rm[j] = (unsigned)__shfl((int)mask, fq * 4 + j);
    { unsigned wm = mask;
#pragma unroll
      for (int o = 1; o < 16; o <<= 1) wm |= (unsigned)__shfl_xor((int)wm, o);
      if (lane == 0) atomicOr(bm, wm); }
    __syncthreads();
    const unsigned anym = *bm;
    f32x4 oacc[8];
#pragma unroll
    for (int i = 0; i < 8; ++i) oacc[i] = (f32x4){0.f, 0.f, 0.f, 0.f};
    float mrow[4] = {-1e30f, -1e30f, -1e30f, -1e30f}, lrow[4] = {0.f, 0.f, 0.f, 0.f};
    const int ntile = (q0 + 128) >> 6;
#define MB_NEXT(k_) do { while ((k_) < ntile && ((k_) >> 2) < blk && !((anym >> ((k_) >> 2)) & 1u)) ++(k_); } while (0)
    uint4 rka, rkb, rva, rvb;
#define MB_FETCH(k_) do { const int c0 = tid, c1 = tid + 512; \
        rka = *(const uint4*)(KNp + (size_t)((k_) * 64 + (c0 >> 4)) * 128 + (c0 & 15) * 8); rkb = *(const uint4*)(KNp + (size_t)((k_) * 64 + (c1 >> 4)) * 128 + (c1 & 15) * 8); \
        rva = *(const uint4*)(VTp + (size_t)(c0 >> 3) * SEQL + (k_) * 64 + (c0 & 7) * 8); rvb = *(const uint4*)(VTp + (size_t)(c1 >> 3) * SEQL + (k_) * 64 + (c1 & 7) * 8); } while (0)
    int kt = 0; MB_NEXT(kt);
    MB_FETCH(kt);
    while (kt < ntile) {
        const int kb = kt >> 2;
        __syncthreads();
        { const int c0 = tid, c1 = tid + 512, r0 = c0 >> 4, r1 = c1 >> 4;
          *(uint4*)(KT + ((r0 & 3) * 16 + (r0 >> 2)) * 136 + (c0 & 15) * 8) = rka; *(uint4*)(KT + ((r1 & 3) * 16 + (r1 >> 2)) * 136 + (c1 & 15) * 8) = rkb;
          *(uint4*)(VT + (c0 >> 3) * 72 + (c0 & 7) * 8) = rva; *(uint4*)(VT + (c1 >> 3) * 72 + (c1 & 7) * 8) = rvb; }
        __syncthreads();
        int nk = kt + 1; MB_NEXT(nk);
        if (nk < ntile) MB_FETCH(nk);
        f32x4 s[4];
#pragma unroll
        for (int g = 0; g < 4; ++g) s[g] = (f32x4){0.f, 0.f, 0.f, 0.f};
#pragma unroll
        for (int ks = 0; ks < 4; ++ks)
#pragma unroll
            for (int g = 0; g < 4; ++g) { const bf16x8 bk = *(const bf16x8*)(KT + (g * 16 + fr) * 136 + ks * 32 + fq * 8); s[g] = MFMA16(qf[ks], bk, s[g]); }
        float alpha[4]; bool resc = false;
#pragma unroll
        for (int j = 0; j < 4; ++j) { const int qpos = q0 + w * 16 + fq * 4 + j; const bool past = kb < blk; const bool rowok = past ? (((rm[j] >> kb) & 1u) != 0u) : true;
            float mx = -1e30f;
#pragma unroll
            for (int g = 0; g < 4; ++g) { const int kpos = kt * 64 + 4 * fr + g; const bool ok = rowok && (past || kpos <= qpos); const float sv = ok ? s[g][j] : -1e30f; s[g][j] = sv; mx = fmaxf(mx, sv); }
            mx = row16_max(mx);
            const float mnew = fmaxf(mrow[j], mx); alpha[j] = __builtin_amdgcn_exp2f(mrow[j] - mnew); resc = resc || (mnew != mrow[j]); mrow[j] = mnew;
            float rs = 0.f;
#pragma unroll
            for (int g = 0; g < 4; ++g) { const float pv = __builtin_amdgcn_exp2f(s[g][j] - mnew); s[g][j] = pv; rs += pv; }
            lrow[j] = lrow[j] * alpha[j] + rs;
            uint2 pk; pk.x = cvt_pk_bf16(s[0][j], s[1][j]); pk.y = cvt_pk_bf16(s[2][j], s[3][j]);
            *(uint2*)(Pw + (fq * 4 + j) * 72 + 4 * fr) = pk; }
        if (__ballot(resc)) {
#pragma unroll
            for (int j = 0; j < 4; ++j)
#pragma unroll
                for (int dt = 0; dt < 8; ++dt) oacc[dt][j] *= alpha[j]; }
        LDS_WAIT();
        bf16x8 pf[2];
#pragma unroll
        for (int ks = 0; ks < 2; ++ks) pf[ks] = *(const bf16x8*)(Pw + fr * 72 + ks * 32 + fq * 8);
#pragma unroll
        for (int dt = 0; dt < 8; ++dt)
#pragma unroll
            for (int ks = 0; ks < 2; ++ks) { const bf16x8 bv = *(const bf16x8*)(VT + (dt * 16 + fr) * 72 + ks * 32 + fq * 8); oacc[dt] = MFMA16(pf[ks], bv, oacc[dt]); }
        kt = nk;
    }
    float inv[4];
#pragma unroll
    for (int j = 0; j < 4; ++j) inv[j] = 1.f / row16_sum(lrow[j]);
#pragma unroll
    for (int dt = 0; dt < 8; ++dt)
#pragma unroll
        for (int j = 0; j < 4; ++j) MIX[(size_t)(b * SEQL + q0 + w * 16 + fq * 4 + j) * DM + 2048 + h * 128 + dt * 16 + fr] = f2bf(oacc[dt][j] * inv[j]);
}

__device__ __forceinline__ void gla_final(const Params& p) {
    const int tid = threadIdx.x, lane = tid & 63, w = tid >> 6;
    const float* OG = (const float*)(p.ws + WS_OG); const bf16_t* proj = (const bf16_t*)(p.ws + WS_PROJ); bf16_t* MIX = (bf16_t*)(p.ws + WS_MIX);
    const float4 gn = ((const float4*)p.glang)[lane];
    for (int it = blockIdx.x * 8 + w; it < NTOK * 8; it += gridDim.x * 8) { const int t = it >> 3, h = it & 7;
        const float4 o = ((const float4*)(OG + (size_t)t * 2048 + h * 256))[lane];
        const float r = rsqrtf(wave_sum((o.x * o.x + o.y * o.y) + (o.z * o.z + o.w * o.w)) * (1.f / 256.f) + 1e-6f);
        const uint2 gv = ((const uint2*)(proj + (size_t)t * PROJW + 4096 + h * 256))[lane];
        const float g0 = bf2f(gv.x & 0xffff), g1 = bf2f(gv.x >> 16), g2 = bf2f(gv.y & 0xffff), g3 = bf2f(gv.y >> 16);
        const float y0 = ((o.x * r) * gn.x) * (g0 / (1.f + __expf(-g0))), y1 = ((o.y * r) * gn.y) * (g1 / (1.f + __expf(-g1)));
        const float y2 = ((o.z * r) * gn.z) * (g2 / (1.f + __expf(-g2))), y3 = ((o.w * r) * gn.w) * (g3 / (1.f + __expf(-g3)));
        uint2 ov; ov.x = cvt_pk_bf16(y0, y1); ov.y = cvt_pk_bf16(y2, y3);
        ((uint2*)(MIX + (size_t)t * DM + h * 256))[lane] = ov; }
}

template <int N> __device__ __forceinline__ void bitonic_desc(unsigned (&x)[N]) {
#pragma unroll
    for (int k = 2; k <= N; k <<= 1)
#pragma unroll
        for (int j = k >> 1; j > 0; j >>= 1)
#pragma unroll
            for (int i = 0; i < N; ++i) { const int l = i ^ j;
                if (l > i) { const unsigned a = x[i], b = x[l], mx = a > b ? a : b, mn = a > b ? b : a;
                    if ((i & k) == 0) { x[i] = mx; x[l] = mn; } else { x[i] = mn; x[l] = mx; } } }
}
__device__ __forceinline__ void merge16(unsigned (&x)[16], int mask) {
    unsigned y[16];
#pragma unroll
    for (int i = 0; i < 16; ++i) y[i] = (unsigned)__shfl_xor((int)x[15 - i], mask);
#pragma unroll
    for (int i = 0; i < 16; ++i) x[i] = x[i] > y[i] ? x[i] : y[i];
    bitonic_desc<16>(x);
}
__device__ __forceinline__ unsigned mono(float f) { const unsigned u = __float_as_uint(f); return (u & 0x80000000u) ? ~u : (u | 0x80000000u); }
__device__ __forceinline__ float unmono(unsigned k) { return __uint_as_float((k & 0x80000000u) ? (k & 0x7fffffffu) : ~k); }
__device__ __forceinline__ void split_bf16(const float4 a, const float4 b, bf16x8& hi, bf16x8& lo) {
    const float x[8] = {a.x, a.y, a.z, a.w, b.x, b.y, b.z, b.w}; unsigned h[4], l[4];
#pragma unroll
    for (int i = 0; i < 4; ++i) { h[i] = cvt_pk_bf16(x[2 * i], x[2 * i + 1]); l[i] = cvt_pk_bf16(x[2 * i] - bf2f(h[i] & 0xffff), x[2 * i + 1] - bf2f(h[i] >> 16)); }
    hi = __builtin_bit_cast(bf16x8, make_uint4(h[0], h[1], h[2], h[3])); lo = __builtin_bit_cast(bf16x8, make_uint4(l[0], l[1], l[2], l[3]));
}
struct PairTab { int n; int i[64], j[64]; };
constexpr PairTab make_pairs() { PairTab t{}; t.n = 0; for (int a = 0; a < 16; ++a) for (int b = 0; b < 16; ++b) if ((a + 1) * (b + 1) <= 16) { t.i[t.n] = a; t.j[t.n] = b; ++t.n; } return t; }
__device__ __forceinline__ void peer_head(const Params& p, unsigned char* sm, int t0, int h, int lane, unsigned char* ibuf, int* LE, float* LG) {
    const int fr = lane & 15, fq = lane >> 4;
    const float* Q = (const float*)(p.ws + WS_Q); const bf16_t* KH = (const bf16_t*)(p.ws + WS_KH); const bf16_t* KL = (const bf16_t*)(p.ws + WS_KL);
    unsigned kk[2][16];
#pragma unroll
    for (int pp = 0; pp < 2; ++pp) {
        bf16x8 qh[4], ql[4];
        { const float* qr = Q + (size_t)(t0 + fr) * 2048 + h * 256 + pp * 128 + fq * 8;
#pragma unroll
          for (int ks = 0; ks < 4; ++ks) split_bf16(*(const float4*)(qr + ks * 32), *(const float4*)(qr + ks * 32 + 4), qh[ks], ql[ks]); }
        unsigned x[32];
#pragma unroll
        for (int n = 0; n < 8; ++n) { const size_t ko = ((size_t)(h * 2 + pp) * 128 + n * 16 + fr) * 128 + fq * 8; f32x4 acc = (f32x4){0.f, 0.f, 0.f, 0.f};
#pragma unroll
            for (int ks = 0; ks < 4; ++ks) { const bf16x8 kh = *(const bf16x8*)(KH + ko + ks * 32), kl = *(const bf16x8*)(KL + ko + ks * 32);
                acc = MFMA16(kh, qh[ks], acc); acc = MFMA16(kl, qh[ks], acc); acc = MFMA16(kh, ql[ks], acc); }
#pragma unroll
            for (int j = 0; j < 4; ++j) x[n * 4 + j] = (mono(acc[j]) & ~0x7Fu) | (unsigned)(n * 16 + fq * 4 + j); }
        bitonic_desc<32>(x);
#pragma unroll
        for (int i = 0; i < 16; ++i) kk[pp][i] = x[i];
        merge16(kk[pp], 16); merge16(kk[pp], 32);
    }
    constexpr PairTab PT = make_pairs();
    float v1[16], v2[16];
#pragma unroll
    for (int i = 0; i < 16; ++i) { v1[i] = unmono(kk[0][i] & ~0x7Fu); v2[i] = unmono(kk[1][i] & ~0x7Fu); }
    unsigned y[16];
#pragma unroll
    for (int c = 0; c < 16; ++c) { unsigned cand = 0u;
#pragma unroll
        for (int q = 0; q < 4; ++q) { const int idx = 4 * c + q;
            if (idx < PT.n) { const unsigned key = (mono(v1[PT.i[idx]] + v2[PT.j[idx]]) & ~0xFFu) | (unsigned)(PT.i[idx] * 16 + PT.j[idx]); cand = (fq == q) ? key : cand; } }
        y[c] = cand; }
    bitonic_desc<16>(y); merge16(y, 16); merge16(y, 32);
    if (fq == 0) {
#pragma unroll
        for (int c4 = 0; c4 < 4; ++c4) { unsigned w1 = 0u, w2 = 0u;
#pragma unroll
            for (int b = 0; b < 4; ++b) { w1 |= (kk[0][c4 * 4 + b] & 0x7Fu) << (8 * b); w2 |= (kk[1][c4 * 4 + b] & 0x7Fu) << (8 * b); }
            ((unsigned*)ibuf)[fr * 8 + c4] = w1; ((unsigned*)ibuf)[fr * 8 + 4 + c4] = w2; }
    }
    LDS_WAIT();
    if (fq == 0) { const float s0 = unmono(y[0] & ~0xFFu); float ex[16], sum = 0.f;
#pragma unroll
        for (int c = 0; c < 16; ++c) { ex[c] = __expf(unmono(y[c] & ~0xFFu) - s0); sum += ex[c]; }
        const float inv = 1.f / sum;
#pragma unroll
        for (int c = 0; c < 16; ++c) { const unsigned code = y[c] & 0xFFu; const int e = (int)ibuf[fr * 32 + (code >> 4)] * 128 + (int)ibuf[fr * 32 + 16 + (code & 15u)];
            LE[fr * 128 + h * 16 + c] = e; LG[fr * 128 + h * 16 + c] = ex[c] * inv; }
    }
}
constexpr int PE_IB = 0, PE_LE = 4096, PE_LG = 12288;
__device__ __forceinline__ void peer_item(const Params& p, unsigned char* sm, int item) {
    const int tid = threadIdx.x, lane = tid & 63, w = tid >> 6;
    const int t0 = item * 16;
    int* LE = (int*)(sm + PE_LE); float* LG = (float*)(sm + PE_LG); unsigned char* W = p.ws + WS_W;
    __syncthreads();
    { uint4* gz = (uint4*)(W + (size_t)t0 * NEXP) + tid; const uint4 z = make_uint4(0u, 0u, 0u, 0u);
#pragma unroll 8
      for (int i = 0; i < 32; ++i) gz[i * 512] = z; }
    peer_head(p, sm, t0, w, lane, sm + PE_IB + w * 512, LE, LG);
    asm volatile("s_waitcnt vmcnt(0)" ::: "memory");
    __syncthreads();
#pragma unroll
    for (int ti = 0; ti < 2; ++ti) { const int t = w * 2 + ti; const int* le = LE + t * 128; const float* lg = LG + t * 128;
        const int e0 = le[lane], e1 = le[lane + 64]; float g0 = 0.f, g1 = 0.f; bool f0 = true, f1 = true;
#pragma unroll 4
        for (int j4 = 0; j4 < 128; j4 += 4) { const int4 ev = *(const int4*)(le + j4); const float4 gv = *(const float4*)(lg + j4);
            const int ea[4] = {ev.x, ev.y, ev.z, ev.w}; const float ga[4] = {gv.x, gv.y, gv.z, gv.w};
#pragma unroll
            for (int q = 0; q < 4; ++q) { const int j = j4 + q;
                if (ea[q] == e0) { g0 += ga[q]; f0 = f0 && (j >= lane); }
                if (ea[q] == e1) { g1 += ga[q]; f1 = f1 && (j >= lane + 64); } } }
        unsigned char* wr = W + (size_t)(t0 + t) * NEXP;
        if (f0) wr[e0] = (unsigned char)(pk4_fp8(g0 * SC_G, 0.f, 0.f, 0.f) & 0xffu);
        if (f1) wr[e1] = (unsigned char)(pk4_fp8(g1 * SC_G, 0.f, 0.f, 0.f) & 0xffu); }
}

#define XB_TMO      128
#define XB_XCNT(j)  (256  + 64 * (j))
#define XB_XSUB(j)  (1280 + 64 * (j))
#define XB_XGEN(j)  (2304 + 64 * (j))
#define XB_TOP      3328
#define XB_TOPGEN   3392
#define XCD_BAR_WORDS 3456
#define XB_SPIN_CAP (1u << 18)
#define LAS __attribute__((address_space(3)))

__device__ __forceinline__ unsigned xb_ld(unsigned* p)              { return __hip_atomic_load(p, __ATOMIC_RELAXED, __HIP_MEMORY_SCOPE_AGENT); }
__device__ __forceinline__ unsigned xb_add(unsigned* p, unsigned v) { return __hip_atomic_fetch_add(p, v, __ATOMIC_RELAXED, __HIP_MEMORY_SCOPE_AGENT); }
__device__ __forceinline__ unsigned xb_xcc_id() { return (unsigned)__builtin_amdgcn_s_getreg((3 << 11) | 20) & 0xFu; }
#define XB_SPIN(cond, bar) do { unsigned _sp = 0; while (cond) { __builtin_amdgcn_s_sleep(1); \
    if ((++_sp & 255u) == 0u) { if (xb_ld(&(bar)[XB_TMO])) break; if (_sp > XB_SPIN_CAP) { atomicAdd(&(bar)[XB_TMO], 1u); break; } } } } while (0)

struct XcdBarrier {
    unsigned* bar; unsigned x;
    volatile LAS unsigned* st;
};

__device__ __forceinline__ XcdBarrier xcd_barrier_post(unsigned* bar, volatile LAS unsigned* st) {
    XcdBarrier b; b.bar = bar; b.x = xb_xcc_id(); b.st = st;
    if (threadIdx.x == 0) (void)xb_add(&bar[XB_XCNT(b.x)], 1u);
    return b;
}
__device__ __forceinline__ void xcd_barrier_complete(unsigned* bar, unsigned x, unsigned& nloc, unsigned& nx) {
    const unsigned G = gridDim.x * gridDim.y * gridDim.z;
    unsigned sum, cnt, mine, sp = 0u;
    for (;;) {
        sum = 0u; cnt = 0u; mine = 0u;
#pragma unroll
        for (unsigned j = 0; j < 16; ++j) { const unsigned c = xb_ld(&bar[XB_XCNT(j)]); sum += c; cnt += (c > 0u) ? 1u : 0u; mine = (j == x) ? c : mine; }
        if (sum == G) break;
        __builtin_amdgcn_s_sleep(1);
        if ((++sp & 255u) == 0u) { if (xb_ld(&bar[XB_TMO])) break; if (sp > XB_SPIN_CAP) { atomicAdd(&bar[XB_TMO], 1u); break; } }
    }
    nloc = mine > 0u ? mine : 1u; nx = cnt > 0u ? cnt : 1u;
}

__device__ __forceinline__ void xcd_barrier(const XcdBarrier& b) {
    asm volatile("s_waitcnt vmcnt(0)" ::: "memory");
    __syncthreads();
    if (threadIdx.x == 0) {
        unsigned* bar = b.bar;
        __builtin_amdgcn_s_waitcnt(0);
        unsigned nloc = b.st[0], nx = b.st[1];
        if (nloc == 0u) { xcd_barrier_complete(bar, b.x, nloc, nx); b.st[0] = nloc; b.st[1] = nx; }
        const unsigned old = xb_add(&bar[XB_XSUB(b.x)], 1u);
        const unsigned gen = old / nloc;
        if (old + 1u == (gen + 1u) * nloc) {
            __builtin_amdgcn_fence(__ATOMIC_RELEASE, "agent");
            asm volatile("s_waitcnt vmcnt(0)" ::: "memory");
            const unsigned og = xb_add(&bar[XB_TOP], 1u);
            const unsigned tg = og / nx;
            if (og + 1u == (tg + 1u) * nx) xb_add(&bar[XB_TOPGEN], 1u);
            else XB_SPIN(xb_ld(&bar[XB_TOPGEN]) == tg, bar);
            __builtin_amdgcn_fence(__ATOMIC_ACQUIRE, "agent");
            xb_add(&bar[XB_XGEN(b.x)], 1u);
            asm volatile("s_waitcnt vmcnt(0)" ::: "memory");
        } else {
            XB_SPIN(xb_ld(&bar[XB_XGEN(b.x)]) == gen, bar);
            __builtin_amdgcn_fence(__ATOMIC_ACQUIRE, "agent");
            asm volatile("s_waitcnt vmcnt(0)" ::: "memory");
        }
    }
    __syncthreads();
}

__global__ void __launch_bounds__(512, 2) hymba_fwd(Params p) {
    extern __shared__ __attribute__((aligned(16))) unsigned char smem[];
    cg::grid_group grid = cg::this_grid();
    volatile int& s_item = *(volatile int*)(smem + 131072);
    volatile LAS unsigned* bst = (volatile LAS unsigned*)(smem + 131072 + 8);
    if (threadIdx.x == 0) { bst[0] = 0u; bst[1] = 0u; }
    __syncthreads();
    XcdBarrier xb; xb.bar = (unsigned*)(p.ws + WS_CTRL); xb.x = 0u; xb.st = bst;
    const int tid = threadIdx.x, lane = tid & 63, w = tid >> 6;
    const int G = gridDim.x, c = blockIdx.x;
    unsigned* ctrl = (unsigned*)(p.ws + WS_CTRL) + 3584;
#define PH_ON(n) (p.ph_lo <= (n) && (n) < p.ph_hi)
#define PH_SYNC(n) if ((n) > p.ph_lo && (n) < p.ph_hi) { if ((n) == 1) { grid.sync(); xb = xcd_barrier_post((unsigned*)(p.ws + WS_CTRL), bst); } else xcd_barrier(xb); }
    if (PH_ON(0)) { if (c == 0) for (int i = tid; i < 4096; i += 512) ((unsigned*)(p.ws + WS_CTRL))[i] = 0u;
        phase_prep(p, smem); }
    PH_SYNC(1);
    if (PH_ON(1)) {
        { pg8::Gemm g{(const bf16_t*)(p.ws + WS_HB), (const bf16_t*)(p.ws + WS_WINT), NTOK, 6144, DM}; pg8::StaticOrder S; S.init(NTOK, 6144, G, c);
          EpiProj E{(bf16_t*)(p.ws + WS_PROJ), 0, 1.f}; pg8::gemm_phase<EpiProj, pg8::StaticOrder, false>((PG8_LAS unsigned char*)smem, g, S, E, nullptr); }
        { pg8::Gemm g{(const bf16_t*)(p.ws + WS_HB8), (const bf16_t*)(p.ws + WS_WINT8), NTOK, 6144, DM / 2}; pg8::StaticOrder S; S.init(NTOK, 6144, G, c);
          EpiProj E{(bf16_t*)(p.ws + WS_PROJ), 6144, 1.f / (SC_X * SC_U)}; pg8::gemm_phase<EpiProj, pg8::StaticOrder, false, true>((PG8_LAS unsigned char*)smem, g, S, E, nullptr); }
        for (int j = c * 8 + w; j < NTOK / 16; j += G * 8) glr_job(p, j, lane); }
    PH_SYNC(2);
    if (PH_ON(2)) { for (int it = c; it < 512; it += G) moba_prep_item(p, smem, it);
        for (int it = c; it < 1024; it += G) gla_prep_item(p, smem, it); }
    PH_SYNC(3);
    if (PH_ON(3)) for (;;) { __syncthreads(); if (tid == 0) s_item = (int)atomicAdd(ctrl, 1u); __syncthreads(); const int it = s_item; if (it >= 128 + 1024) break;
        if (it < 128) gla_item(p, smem, it); else moba_item(p, smem, it - 128); }
    PH_SYNC(4);
    if (PH_ON(4)) gla_final(p);
    PH_SYNC(5);
    if (PH_ON(5)) { pg8::Gemm g{(const bf16_t*)(p.ws + WS_MIX), (const bf16_t*)(p.ws + WS_WOUTT), NTOK, DM, DM}; pg8::StaticOrder S; S.init(NTOK, DM, G, c);
        EpiRes E{p.out, p.x, DM}; pg8::gemm_phase<EpiRes, pg8::StaticOrder, false>((PG8_LAS unsigned char*)smem, g, S, E, nullptr); }
    PH_SYNC(6);
    if (PH_ON(6)) { bf16_t* HB = (bf16_t*)(p.ws + WS_HB);
        for (int r = c * 8 + w; r < NTOK; r += G * 8) rms_row<true>(p.out + (size_t)r * DM, p.g2, HB + (size_t)r * DM, (unsigned*)(p.ws + WS_HB8) + (size_t)r * (DM / 4), lane);
        (void)0; }
    PH_SYNC(7);
    if (PH_ON(7)) { pg8::Gemm g{(const bf16_t*)(p.ws + WS_HB), (const bf16_t*)(p.ws + WS_WPQT), NTOK, 2048, DM}; pg8::StaticOrder S; S.init(NTOK, 2048, G, c);
        EpiF32 E{(float*)(p.ws + WS_Q), 2048}; pg8::gemm_phase<EpiF32, pg8::StaticOrder, false>((PG8_LAS unsigned char*)smem, g, S, E, nullptr); }
    PH_SYNC(8);
    if (PH_ON(8)) for (int it = c; it < NTOK / 16; it += G) peer_item(p, smem, it);
    PH_SYNC(9);
    if (PH_ON(9)) { pg8::Gemm g{(const bf16_t*)(p.ws + WS_HB8), (const bf16_t*)(p.ws + WS_UB), NTOK, NEXP, DM / 2}; pg8::StaticOrder S; S.init(NTOK, NEXP, G, c);
        EpiPeerW8 E{p.ws + WS_W, p.ws + WS_W8}; pg8::gemm_phase<EpiPeerW8, pg8::StaticOrder, false, true>((PG8_LAS unsigned char*)smem, g, S, E, nullptr); }
    PH_SYNC(10);
    if (PH_ON(10)) { pg8::Gemm g{(const bf16_t*)(p.ws + WS_W8), (const bf16_t*)(p.ws + WS_VTB), NTOK, DM, NEXP / 2}; pg8::StaticOrder S; S.init(NTOK, DM, G, c);
        EpiResSc E{p.out, p.out, DM, 1.f / (SC_W * SC_V)}; pg8::gemm_phase<EpiResSc, pg8::StaticOrder, false, true>((PG8_LAS unsigned char*)smem, g, S, E, nullptr); }
}

#ifndef MK_PER_PHASE
#define MK_PER_PHASE 0
#endif
extern "C" void kernel_launch(void* const* d_in, const int* in_sizes, int n_in, void* d_out, int out_size, void* d_ws, size_t ws_size, hipStream_t stream) {
    static int grid = 0;
    if (grid == 0) {
        if (n_in != 14 || out_size != NTOK * DM || ws_size < WS_END) { fprintf(stderr, "kernel_launch: unexpected shapes (n_in %d out %d ws %zu)\n", n_in, out_size, ws_size); grid = -1; return; }
        int dev = 0, cus = 0, per_cu = 0;
        hipGetDevice(&dev); hipDeviceGetAttribute(&cus, hipDeviceAttributeMultiprocessorCount, dev);
        if (hipFuncSetAttribute((const void*)hymba_fwd, hipFuncAttributeMaxDynamicSharedMemorySize, LDS_BYTES) != hipSuccess) { fprintf(stderr, "kernel_launch: hipFuncSetAttribute failed\n"); grid = -1; return; }
        if (hipOccupancyMaxActiveBlocksPerMultiprocessor(&per_cu, (const void*)hymba_fwd, 512, LDS_BYTES) != hipSuccess || per_cu < 1) { fprintf(stderr, "kernel_launch: occupancy query failed (%d)\n", per_cu); grid = -1; return; }
        grid = cus * (per_cu > 1 ? 1 : per_cu);
        fprintf(stderr, "kernel_launch: %d CUs, %d blocks/CU by query, grid %d\n", cus, per_cu, grid);
    }
    if (grid < 0) return;
    Params p{};
    p.x = (const float*)d_in[0]; p.g1 = (const float*)d_in[1]; p.win = (const float*)d_in[2]; p.wgu = (const float*)d_in[3]; p.bg = (const float*)d_in[4]; p.glang = (const float*)d_in[5];
    p.qng = (const float*)d_in[6]; p.kng = (const float*)d_in[7]; p.wout = (const float*)d_in[8]; p.g2 = (const float*)d_in[9]; p.wpq = (const float*)d_in[10]; p.pkeys = (const float*)d_in[11];
    p.pu = (const float*)d_in[12]; p.pv = (const float*)d_in[13]; p.out = (float*)d_out; p.ws = (unsigned char*)d_ws;
#if MK_PER_PHASE
    for (int ph = 0; ph < NPHASE; ++ph) { p.ph_lo = ph; p.ph_hi = ph + 1; void* args[] = {&p};
        hipError_t e = hipLaunchCooperativeKernel((const void*)hymba_fwd, dim3(grid), dim3(512), args, LDS_BYTES, stream);
        if (e != hipSuccess) { fprintf(stderr, "cooperative launch failed: %s\n", hipGetErrorString(e)); break; } }
#else
    p.ph_lo = 0; p.ph_hi = NPHASE; void* args[] = {&p};
    hipError_t e = hipLaunchCooperativeKernel((const void*)hymba_fwd, dim3(grid), dim3(512), args, LDS_BYTES, stream);
    if (e != hipSuccess) fprintf(stderr, "cooperative launch failed: %s (grid %d)\n", hipGetErrorString(e), grid);
#endif
}
```
